# Optimizing an MI355X kernel written in HIP

```python
import math
import jax, jax.numpy as jnp
from jax import lax
import numpy as np

D_MODEL = 1024
BATCH = 4
SEQ = 8192
DEPTH = 1

D_MIX = D_MODEL
DA_HEADS = 4
DA_HEAD_DIM = 64
DA_V_DIM = 2 * DA_HEAD_DIM
DA_WIDTH = DA_HEADS * DA_V_DIM
RW_HEAD = 64
RW_WIDTH = D_MIX - DA_WIDTH
RW_HEADS = RW_WIDTH // RW_HEAD
DECAY_LORA = 64
AAA_LORA = 64
GATE_LORA = 128
DA_COLS = 3 * DA_WIDTH
RW_COLS = 3 * RW_WIDTH + DECAY_LORA + AAA_LORA + GATE_LORA
IN_COLS = DA_COLS + RW_COLS
ROPE_THETA = 10000.0
Q_BLOCK = 128
N_EXPERTS = 32
TOP_K = 4
D_FF = D_MODEL
SWIGLU_ALPHA = 1.702
SWIGLU_LIMIT = 7.0
MOE_BLOCK = 128
NORM_EPS = 1e-5
GN_EPS = 64e-5

kernel_name = "hybrid_diffattn_rwkv7_moe"

F32 = jnp.float32


def rmsnorm(x, w):
    x32 = x.astype(F32)
    y = x32 * lax.rsqrt(jnp.mean(x32 * x32, axis=-1, keepdims=True) + NORM_EPS)
    return (y * w.astype(F32)).astype(x.dtype)


def rope_tables(positions):
    inv = ROPE_THETA ** (-jnp.arange(0, DA_HEAD_DIM, 2, dtype=F32) / DA_HEAD_DIM)
    ang = positions.astype(F32)[..., None] * inv
    return jnp.cos(ang), jnp.sin(ang)


def apply_rope(x, cos, sin):
    c = cos[:, :, None, None, :]
    s = sin[:, :, None, None, :]
    x1, x2 = jnp.split(x.astype(F32), 2, axis=-1)
    return jnp.concatenate([x1 * c - x2 * s, x2 * c + x1 * s], axis=-1).astype(x.dtype)


def diff_attention(q, k, v, lam, lam_init, subln_w):
    B, S = q.shape[0], q.shape[1]
    nb = S // Q_BLOCK
    scale = DA_HEAD_DIM ** -0.5
    kt = jnp.transpose(k, (0, 2, 3, 1, 4))
    vt = jnp.transpose(v, (0, 2, 1, 3))
    qb = q.reshape(B, nb, Q_BLOCK, DA_HEADS, 2, DA_HEAD_DIM).transpose(1, 0, 3, 4, 2, 5)
    key_pos = jnp.arange(S)

    def block(args):
        qi, i = args
        s = jnp.einsum('bhcqd,bhckd->bhcqk', qi, kt, preferred_element_type=F32) * scale
        qpos = i * Q_BLOCK + jnp.arange(Q_BLOCK)
        s = jnp.where(key_pos[None, :] <= qpos[:, None], s, -jnp.inf)
        p = jax.nn.softmax(s, axis=-1)
        a = p[:, :, 0] - lam * p[:, :, 1]
        return jnp.einsum('bhqk,bhkd->bhqd', a.astype(vt.dtype), vt)

    o = lax.map(block, (qb, jnp.arange(nb)))
    o = o.transpose(1, 0, 3, 2, 4).reshape(B, S, DA_HEADS, DA_V_DIM)
    o = rmsnorm(o, subln_w) * (1.0 - lam_init)
    return o.reshape(B, S, DA_WIDTH)


def rwkv7_scan(r, w, k, v, kk, a):
    B, S_len, H, N = r.shape

    def step(st, inp):
        r_t, w_t, k_t, v_t, kk_t, a_t = inp
        sa = jnp.einsum('bhvk,bhk->bhv', st, kk_t)
        st = (st * w_t[:, :, None, :]
              - sa[..., None] * (kk_t * a_t)[:, :, None, :]
              + v_t[..., None] * k_t[:, :, None, :])
        y = jnp.einsum('bhvk,bhk->bhv', st, r_t)
        return st, y

    xs = tuple(jnp.moveaxis(t.astype(F32), 1, 0) for t in (r, w, k, v, kk, a))
    st0 = jnp.zeros((B, H, N, N), F32)
    _, y = lax.scan(step, st0, xs)
    return jnp.moveaxis(y, 0, 1)


def rwkv7_group(p, mu, w0, w2, a0, a2, g2, k_k, k_a, r_k, lnx_w, lnx_b):
    B, S = p.shape[0], p.shape[1]
    prev = jnp.pad(p, ((0, 0), (1, 0), (0, 0)))[:, :-1]
    p = p + mu * (prev - p)
    c0, c1, c2 = RW_WIDTH, 2 * RW_WIDTH, 3 * RW_WIDTH
    c3, c4 = c2 + DECAY_LORA, c2 + DECAY_LORA + AAA_LORA
    r, k, v, wd, ad, gd = jnp.split(p, [c0, c1, c2, c3, c4], axis=-1)
    wlog = -jax.nn.softplus(-(w0 + jnp.tanh(wd) @ w2).astype(F32)) - 0.5
    decay = jnp.exp(-jnp.exp(wlog))
    a = jax.nn.sigmoid((a0 + ad @ a2).astype(F32))
    g = jax.nn.sigmoid(gd) @ g2
    heads = lambda t: t.reshape(B, S, RW_HEADS, RW_HEAD)
    kk = heads((k * k_k).astype(F32))
    kk = kk / jnp.maximum(jnp.sqrt(jnp.sum(kk * kk, axis=-1, keepdims=True)), 1e-12)
    k = k.astype(F32) * (1.0 + (a - 1.0) * k_a.astype(F32))
    rh, kh, vh, ah = heads(r.astype(F32)), heads(k), heads(v.astype(F32)), heads(a)
    y = rwkv7_scan(rh, heads(decay), kh, vh, kk, ah)
    mean = jnp.mean(y, axis=-1, keepdims=True)
    var = jnp.mean(jnp.square(y - mean), axis=-1, keepdims=True)
    yn = ((y - mean) * lax.rsqrt(var + GN_EPS)).reshape(B, S, RW_WIDTH)
    yn = yn * lnx_w.astype(F32) + lnx_b.astype(F32)
    bonus = jnp.sum(rh * kh * r_k.astype(F32), axis=-1, keepdims=True) * vh
    out = (yn + bonus.reshape(B, S, RW_WIDTH)) * g.astype(F32)
    return out.astype(p.dtype)


def moe_ffn(h, router_w, router_b, mlp1_w, mlp1_b, mlp2_w, mlp2_b):
    B, S, D = h.shape
    T = B * S
    xf = h.reshape(T, D)
    logits = (xf @ router_w + router_b).astype(F32)
    top_val, top_idx = lax.top_k(logits, TOP_K)
    gates = jax.nn.softmax(top_val, axis=-1)
    M = T * TOP_K
    e_flat = top_idx.reshape(M)
    tok_flat = jnp.arange(M, dtype=jnp.int32) // TOP_K
    gate_flat = gates.reshape(M)
    order = jnp.argsort(e_flat)
    e_s, tok_s, gate_s = e_flat[order], tok_flat[order], gate_flat[order]
    counts = jnp.bincount(e_flat, length=N_EXPERTS)
    start = jnp.cumsum(counts) - counts
    padded = (counts + MOE_BLOCK - 1) // MOE_BLOCK * MOE_BLOCK
    pend = jnp.cumsum(padded)
    pstart = pend - padded
    dest = pstart[e_s] + (jnp.arange(M) - start[e_s])
    P = M + N_EXPERTS * MOE_BLOCK
    row_tok = jnp.full((P,), T, jnp.int32).at[dest].set(tok_s)
    row_gate = jnp.zeros((P,), F32).at[dest].set(gate_s)
    nblk = P // MOE_BLOCK
    blk_expert = jnp.minimum(jnp.searchsorted(pend, jnp.arange(nblk) * MOE_BLOCK, side='right'), N_EXPERTS - 1)
    x_pad = jnp.concatenate([xf, jnp.zeros((1, D), xf.dtype)], axis=0)

    def block(args):
        toks, e = args
        xb = x_pad[toks]
        gu = xb @ mlp1_w[e] + mlp1_b[e]
        gate, up = gu[..., ::2], gu[..., 1::2]
        gate = jnp.minimum(gate, SWIGLU_LIMIT)
        up = jnp.clip(up, -SWIGLU_LIMIT, SWIGLU_LIMIT)
        act = (up + 1.0) * gate * jax.nn.sigmoid(SWIGLU_ALPHA * gate)
        return act @ mlp2_w[e] + mlp2_b[e]

    y = lax.map(block, (row_tok.reshape(nblk, MOE_BLOCK), blk_expert)).reshape(P, D)
    y = (y.astype(F32) * row_gate[:, None]).astype(h.dtype)
    out = jnp.zeros((T + 1, D), h.dtype).at[row_tok].add(y)[:T]
    return out.reshape(B, S, D)


def setup_inputs(seed: int = 0) -> dict:
    key = jax.random.key(seed)
    ks = jax.random.split(key, 32)
    L = DEPTH
    nrm = lambda k, shape, scale: jax.random.normal(k, shape, F32) * scale
    uni = lambda k, shape, lo, hi: jax.random.uniform(k, shape, F32, lo, hi)
    return {
        'x': nrm(ks[0], (BATCH, SEQ, D_MODEL), 1.0),
        'positions': jnp.broadcast_to(jnp.arange(SEQ, dtype=jnp.int32), (BATCH, SEQ)),
        'attn_norm_w': 1.0 + nrm(ks[1], (L, D_MODEL), 0.02),
        'w_in': nrm(ks[2], (L, D_MODEL, IN_COLS), D_MODEL ** -0.5),
        'shift_mu': uni(ks[3], (L, RW_COLS), 0.0, 1.0),
        'lambda_q1': nrm(ks[4], (L, DA_HEAD_DIM), 0.1),
        'lambda_k1': nrm(ks[5], (L, DA_HEAD_DIM), 0.1),
        'lambda_q2': nrm(ks[6], (L, DA_HEAD_DIM), 0.1),
        'lambda_k2': nrm(ks[7], (L, DA_HEAD_DIM), 0.1),
        'subln_w': 1.0 + nrm(ks[8], (L, DA_V_DIM), 0.02),
        'rw_w0': uni(ks[9], (L, RW_WIDTH), -6.0, 0.0),
        'rw_w2': nrm(ks[10], (L, DECAY_LORA, RW_WIDTH), 0.1 * DECAY_LORA ** -0.5),
        'rw_a0': nrm(ks[11], (L, RW_WIDTH), 0.5),
        'rw_a2': nrm(ks[12], (L, AAA_LORA, RW_WIDTH), AAA_LORA ** -0.5),
        'rw_g2': nrm(ks[13], (L, GATE_LORA, RW_WIDTH), GATE_LORA ** -0.5),
        'rw_k_k': 0.85 + nrm(ks[14], (L, RW_WIDTH), 0.02),
        'rw_k_a': 1.0 + nrm(ks[15], (L, RW_WIDTH), 0.02),
        'rw_r_k': nrm(ks[16], (L, RW_HEADS, RW_HEAD), 0.1),
        'rw_lnx_w': 1.0 + nrm(ks[17], (L, RW_WIDTH), 0.02),
        'rw_lnx_b': nrm(ks[18], (L, RW_WIDTH), 0.01),
        'w_out': nrm(ks[19], (L, D_MIX, D_MODEL), D_MIX ** -0.5),
        'ffn_norm_w': 1.0 + nrm(ks[20], (L, D_MODEL), 0.02),
        'router_w': nrm(ks[21], (L, D_MODEL, N_EXPERTS), D_MODEL ** -0.5),
        'router_b': nrm(ks[22], (L, N_EXPERTS), 0.01),
        'mlp1_w': nrm(ks[23], (L, N_EXPERTS, D_MODEL, 2 * D_FF), D_MODEL ** -0.5),
        'mlp1_b': nrm(ks[24], (L, N_EXPERTS, 2 * D_FF), 0.01),
        'mlp2_w': nrm(ks[25], (L, N_EXPERTS, D_FF, D_MODEL), D_FF ** -0.5),
        'mlp2_b': nrm(ks[26], (L, N_EXPERTS, D_MODEL), 0.01),
        'final_norm_w': 1.0 + nrm(ks[27], (D_MODEL,), 0.02),
    }


def reference(x, positions, attn_norm_w, w_in, shift_mu, lambda_q1, lambda_k1, lambda_q2, lambda_k2,
              subln_w, rw_w0, rw_w2, rw_a0, rw_a2, rw_g2, rw_k_k, rw_k_a, rw_r_k, rw_lnx_w, rw_lnx_b,
              w_out, ffn_norm_w, router_w, router_b, mlp1_w, mlp1_b, mlp2_w, mlp2_b, final_norm_w):
    B, S = x.shape[0], x.shape[1]
    cos, sin = rope_tables(positions)
    for l in range(DEPTH):
        h = rmsnorm(x, attn_norm_w[l])
        p = h @ w_in[l]
        q, k, v, p_rw = jnp.split(p, [DA_WIDTH, 2 * DA_WIDTH, 3 * DA_WIDTH], axis=-1)
        q = apply_rope(q.reshape(B, S, DA_HEADS, 2, DA_HEAD_DIM), cos, sin)
        k = apply_rope(k.reshape(B, S, DA_HEADS, 2, DA_HEAD_DIM), cos, sin)
        v = v.reshape(B, S, DA_HEADS, DA_V_DIM)
        lam_init = 0.8 - 0.6 * math.exp(-0.3 * l)
        lam = (jnp.exp(jnp.sum(lambda_q1[l].astype(F32) * lambda_k1[l].astype(F32)))
               - jnp.exp(jnp.sum(lambda_q2[l].astype(F32) * lambda_k2[l].astype(F32))) + lam_init)
        o_da = diff_attention(q, k, v, lam, lam_init, subln_w[l])
        o_rw = rwkv7_group(p_rw, shift_mu[l], rw_w0[l], rw_w2[l], rw_a0[l], rw_a2[l], rw_g2[l],
                           rw_k_k[l], rw_k_a[l], rw_r_k[l], rw_lnx_w[l], rw_lnx_b[l])
        x = x + jnp.concatenate([o_da, o_rw.astype(o_da.dtype)], axis=-1) @ w_out[l]
        h = rmsnorm(x, ffn_norm_w[l])
        x = x + moe_ffn(h, router_w[l], router_b[l], mlp1_w[l], mlp1_b[l], mlp2_w[l], mlp2_b[l])
    return rmsnorm(x, final_norm_w)
```

```cpp
#include <hip/hip_runtime.h>
#include <cstdio>
#include <cstdint>
namespace pg8 {
#define PG8_LAS __attribute__((address_space(3)))
typedef unsigned short bf16_t;
typedef short bf16x8 __attribute__((ext_vector_type(8)));
typedef float f32x4 __attribute__((ext_vector_type(4)));
typedef unsigned u32x4 __attribute__((ext_vector_type(4)));
constexpr int BM = 256, BK = 64, HALF = 128, HTB = HALF * BK * 2  , STAGE_BYTES = 8 * HTB, NXCD = 8, WGM = 8;

__host__ __device__ __forceinline__ int lds_byte(int r, int c) { const int st = (r >> 4) * 2 + (c >> 5), rr = r & 15, cc = c & 31, ob = rr * 64 + cc * 2; return st * 1024 + (ob ^ (((ob >> 9) & 1) << 5)); }
__host__ __device__ __forceinline__ void stage_rc(int b, int& R, int& C) { const int st = b / 1024, sb = b % 1024, swz = sb ^ (((sb >> 9) & 1) << 5); R = (st >> 1) * 16 + swz / 64; C = (st & 1) * 32 + (swz % 64) / 2; }
__host__ __device__ __forceinline__ int perm32(int rho) { const int n = rho >> 4, i = rho & 15; return 8 * (i >> 2) + 4 * n + (i & 3); }

struct Unit { int pm, pn; };
struct Gemm { const bf16_t* A; const bf16_t* Bt; int M, N, K; };

struct StaticOrder {
    int nM, nN, nwg, G, c;
    __host__ __device__ void init(int M, int N, int G_, int c_) { nM = M / BM; nN = N / BM; nwg = nM * nN; G = G_; c = c_; }
    __host__ __device__ bool next(int i, Unit& u) const {
        const long L = (long)i * G + c; if (L >= nwg) return false;
        int wgid = (int)L; { const int q = nwg / NXCD, r = nwg % NXCD, xcd = wgid % NXCD, off = wgid / NXCD; wgid = (xcd < r ? xcd * (q + 1) : r * (q + 1) + (xcd - r) * q) + off; }
        const int nig = WGM * nN, gid = wgid / nig, fm = gid * WGM, gsz = (nM - fm) < WGM ? (nM - fm) : WGM;
        u.pm = fm + ((wgid % nig) % gsz); u.pn = (wgid % nig) / gsz; return true;
    }
    __device__ __forceinline__ void a_ready(const Unit&) const {}
    __device__ __forceinline__ void done(const Unit&) const {}
};

__device__ __forceinline__ unsigned cvt_pk_bf16(float lo, float hi) { unsigned r; asm volatile("v_cvt_pk_bf16_f32 %0, %1, %2" : "=v"(r) : "v"(lo), "v"(hi)); return r; }
typedef float f32x2 __attribute__((ext_vector_type(2)));
__device__ __forceinline__ f32x2 gelu_pk(f32x2 v) {
    const f32x2 av = __builtin_elementwise_abs(v), d = av * 0.2316418882f + 1.0f;
    f32x2 t; t.x = __builtin_amdgcn_rcpf(d.x); t.y = __builtin_amdgcn_rcpf(d.y);
    f32x2 q = t * 0.5307027145f + (-0.7265760135f); q = q * t + 0.7107068705f; q = q * t + (-0.142248368f); q = q * t + 0.127414796f; q = q * t;
    const f32x2 s = (v * v) * (-0.72134752044f);
    f32x2 e; e.x = __builtin_amdgcn_exp2f(s.x); e.y = __builtin_amdgcn_exp2f(s.y);
    const f32x2 m = v * (q * e), r = v - m;
    f32x2 o; o.x = v.x < 0.f ? m.x : r.x; o.y = v.y < 0.f ? m.y : r.y; return o;
}

template <int ACT  > struct EpiBf16 {
    static constexpr bool PERM = true, AFTER_DRAIN = false; static_assert(ACT == 0 || ACT == 1, "EpiBf16: ACT is 0 (none) or 1 (gelu_pk)");
    bf16_t* O; int ldc; const float* bias; int split_cols; size_t split_stride; float scale0;
    __device__ __forceinline__ void operator()(const f32x4 (&acc)[2][2][4][2], const Unit& u, int wr, int wc, int fr, int fq) const {
        const int row0 = u.pm * BM + wr * 64 + fr; int colt = u.pn * BM; bf16_t* base = O;
        float sc = 1.f; if (split_cols) { const int t = colt / split_cols; base += (size_t)t * split_stride; colt -= t * split_cols; if (t == 0) sc = scale0; }
        const int col0 = colt + wc * 32 + 8 * fq, bcol0 = u.pn * BM + wc * 32 + 8 * fq;
        f32x4 bv[2][2];
#pragma unroll
        for (int bj = 0; bj < 2; ++bj)
#pragma unroll
            for (int n = 0; n < 2; ++n) bv[bj][n] = bias ? *(const f32x4*)(bias + bcol0 + bj * HALF + 4 * n) : (f32x4){0.f, 0.f, 0.f, 0.f};
#pragma unroll
        for (int ai = 0; ai < 2; ++ai)
#pragma unroll
            for (int m = 0; m < 4; ++m) { bf16_t* rowp = base + (size_t)(row0 + ai * HALF + m * 16) * ldc + col0;
#pragma unroll
                for (int bj = 0; bj < 2; ++bj) { f32x4 v0 = acc[ai][bj][m][0] + bv[bj][0], v1 = acc[ai][bj][m][1] + bv[bj][1];
                    if (ACT == 1) { f32x2 a = gelu_pk((f32x2){v0[0], v0[1]}), b = gelu_pk((f32x2){v0[2], v0[3]}), c = gelu_pk((f32x2){v1[0], v1[1]}), d = gelu_pk((f32x2){v1[2], v1[3]});
                        v0 = (f32x4){a.x, a.y, b.x, b.y}; v1 = (f32x4){c.x, c.y, d.x, d.y}; }
                    v0 = v0 * sc; v1 = v1 * sc; u32x4 w; w.x = cvt_pk_bf16(v0[0], v0[1]); w.y = cvt_pk_bf16(v0[2], v0[3]); w.z = cvt_pk_bf16(v1[0], v1[1]); w.w = cvt_pk_bf16(v1[2], v1[3]);
                    *(u32x4*)(rowp + bj * HALF) = w; } }
    }
};
template <class Epi, class Sched, bool ALIGN_EPI = false, bool SP2 = false>
__device__ __forceinline__ void gemm_phase(PG8_LAS unsigned char* lds, const Gemm g, const Sched& S, const Epi& E) {
    const int tid = threadIdx.x, wid = __builtin_amdgcn_readfirstlane(tid >> 6), lane = tid & 63, wr = wid >> 2, wc = wid & 3, fr = lane & 15, fq = lane >> 4;
    const int K = g.K, nt = K / BK;
    unsigned voffA[2], voffB[2];
#pragma unroll
    for (int i = 0; i < 2; ++i) { int R, C; stage_rc(tid * 16 + i * 8192, R, C); const int Rb = Epi::PERM ? ((R & ~31) + perm32(R & 31)) : R;
        voffA[i] = (unsigned)(R * K + C) * 2u; voffB[i] = (unsigned)(Rb * K + C) * 2u; }
    const size_t kstep = (size_t)(BK * 2);
    const size_t hstep = (size_t)HALF * K * 2;
    const size_t tstep = 2 * hstep;
    const unsigned ldsw = (unsigned)wid * 1024u;
    const int aoff = lds_byte(wr * 64 + fr, fq * 8), boff = lds_byte(wc * 32 + fr, fq * 8);
#define PG8_SA(b, h) (((b) * 2 + (h)) * HTB)
#define PG8_SB(b, h) ((4 + (b) * 2 + (h)) * HTB)
#define PG8_STAGE(bufoff, gbase, voff) do { _Pragma("unroll") for (int _i = 0; _i < 2; ++_i) \
        __builtin_amdgcn_global_load_lds((const unsigned*)((const char*)(gbase) + (voff)[_i]), (PG8_LAS unsigned*)(lds + (bufoff) + ldsw + _i * 8192), 16, 0, 0); } while (0)
#define PG8_LDA(dst, b, h) do { _Pragma("unroll") for (int m = 0; m < 4; ++m) _Pragma("unroll") for (int k = 0; k < 2; ++k) dst[m][k] = *(const PG8_LAS bf16x8*)(lds + PG8_SA(b, h) + aoff + m * 2048 + k * 1024); } while (0)
#define PG8_LDB(dst, b, h) do { _Pragma("unroll") for (int n = 0; n < 2; ++n) _Pragma("unroll") for (int k = 0; k < 2; ++k) dst[n][k] = *(const PG8_LAS bf16x8*)(lds + PG8_SB(b, h) + boff + n * 2048 + k * 1024); } while (0)
#define PG8_MMA(ai, bj, At, Bt) do { __builtin_amdgcn_s_setprio(1); _Pragma("unroll") for (int m = 0; m < 4; ++m) _Pragma("unroll") for (int n = 0; n < 2; ++n) _Pragma("unroll") for (int k = 0; k < 2; ++k) \
        acc[ai][bj][m][n] = __builtin_amdgcn_mfma_f32_16x16x32_bf16(Bt[n][k], At[m][k], acc[ai][bj][m][n], 0, 0, 0); __builtin_amdgcn_s_setprio(0); } while (0)
#define PG8_WAIT_V(n) asm volatile("s_waitcnt vmcnt(" #n ")" ::: "memory")
#define PG8_WAIT_L(n) asm volatile("s_waitcnt lgkmcnt(" #n ")" ::: "memory")
#define PG8_BAR __builtin_amdgcn_s_barrier()
#define PG8_SCHED __builtin_amdgcn_sched_barrier(0)
    Unit cur, nxt; int ui = 0;
    if (!S.next(0, cur)) return;
    f32x4 acc[2][2][4][2];
#pragma unroll
    for (int a = 0; a < 2; ++a)
#pragma unroll
        for (int b = 0; b < 2; ++b)
#pragma unroll
            for (int m = 0; m < 4; ++m)
#pragma unroll
                for (int n = 0; n < 2; ++n) acc[a][b][m][n] = (f32x4){0.f, 0.f, 0.f, 0.f};
    bf16x8 At[4][2], B0[2][2], B1[2][2];
    const char* cA = (const char*)g.A + (size_t)cur.pm * tstep; const char* cB = (const char*)g.Bt + (size_t)cur.pn * tstep;
    S.a_ready(cur);
    if constexpr (SP2) {
        PG8_STAGE(PG8_SB(0, 0), cB, voffB); PG8_STAGE(PG8_SB(0, 1), cB + hstep, voffB); PG8_STAGE(PG8_SA(0, 0), cA, voffA); PG8_STAGE(PG8_SA(0, 1), cA + hstep, voffA);
        if (wr == 1) PG8_BAR;
        PG8_WAIT_V(2); PG8_BAR;
        PG8_STAGE(PG8_SB(1, 0), cB + kstep, voffB); PG8_STAGE(PG8_SA(1, 0), cA + kstep, voffA); PG8_STAGE(PG8_SB(1, 1), cB + hstep + kstep, voffB);
        PG8_WAIT_V(6); PG8_BAR;
    } else {
        PG8_STAGE(PG8_SB(0, 0), cB, voffB); PG8_STAGE(PG8_SA(0, 0), cA, voffA); PG8_STAGE(PG8_SB(0, 1), cB + hstep, voffB); PG8_STAGE(PG8_SA(0, 1), cA + hstep, voffA);
        if (wr == 1) PG8_BAR;
        PG8_WAIT_V(4); PG8_BAR;
        PG8_STAGE(PG8_SB(1, 0), cB + kstep, voffB); PG8_STAGE(PG8_SA(1, 0), cA + kstep, voffA); PG8_STAGE(PG8_SB(1, 1), cB + hstep + kstep, voffB);
        PG8_WAIT_V(6); PG8_BAR;
    }
    for (;;) {
        const bool has_next = S.next(ui + 1, nxt);
        const char* nA = has_next ? (const char*)g.A + (size_t)nxt.pm * tstep : cA; const char* nB = has_next ? (const char*)g.Bt + (size_t)nxt.pn * tstep : cB;
        for (int t = 0; t < nt; t += 2) {
            const bool last = (t == nt - 2);
            const char* a1 = cA + (size_t)(t + 1) * kstep;
            const char* a2 = last ? nA : cA + (size_t)(t + 2) * kstep; const char* b2 = last ? nB : cB + (size_t)(t + 2) * kstep;
            const char* a3 = a2 + kstep; const char* b3 = b2 + kstep;
            if (last && has_next) S.a_ready(nxt);
            if constexpr (SP2) {
            PG8_LDB(B0, 0, 0); PG8_LDB(B1, 0, 1); PG8_SCHED; PG8_LDA(At, 0, 0); PG8_STAGE(PG8_SA(1, 1), a1 + hstep, voffA);
            PG8_WAIT_V(8); PG8_WAIT_L(0); PG8_BAR; PG8_MMA(0, 0, At, B0); PG8_MMA(0, 1, At, B1); PG8_BAR; PG8_SCHED;
            PG8_LDA(At, 0, 1); PG8_STAGE(PG8_SB(0, 0), b2, voffB); PG8_STAGE(PG8_SB(0, 1), b2 + hstep, voffB); PG8_STAGE(PG8_SA(0, 0), a2, voffA);
            PG8_WAIT_V(8); PG8_WAIT_L(0); PG8_BAR; PG8_MMA(1, 0, At, B0); PG8_MMA(1, 1, At, B1); PG8_BAR; PG8_SCHED;
            PG8_LDB(B0, 1, 0); PG8_LDB(B1, 1, 1); PG8_SCHED; PG8_LDA(At, 1, 0); PG8_STAGE(PG8_SA(0, 1), a2 + hstep, voffA);
            PG8_WAIT_V(8); PG8_WAIT_L(0); PG8_BAR; PG8_MMA(0, 0, At, B0); PG8_MMA(0, 1, At, B1); PG8_BAR; PG8_SCHED;
            PG8_LDA(At, 1, 1); PG8_STAGE(PG8_SB(1, 0), b3, voffB); PG8_STAGE(PG8_SB(1, 1), b3 + hstep, voffB); PG8_STAGE(PG8_SA(1, 0), a3, voffA);
            PG8_WAIT_V(8); PG8_WAIT_L(0); PG8_BAR; PG8_MMA(1, 0, At, B0); PG8_MMA(1, 1, At, B1); PG8_BAR; PG8_SCHED;
            } else {
            PG8_LDB(B0, 0, 0); PG8_SCHED; PG8_LDA(At, 0, 0); PG8_STAGE(PG8_SA(1, 1), a1 + hstep, voffA);
            PG8_WAIT_L(8); PG8_BAR; PG8_WAIT_L(0); PG8_MMA(0, 0, At, B0); PG8_BAR; PG8_SCHED;
            PG8_LDB(B1, 0, 1); PG8_STAGE(PG8_SB(0, 0), b2, voffB);
            PG8_BAR; PG8_WAIT_L(0); PG8_MMA(0, 1, At, B1); PG8_BAR;
            PG8_LDA(At, 0, 1); PG8_STAGE(PG8_SA(0, 0), a2, voffA);
            PG8_BAR; PG8_WAIT_L(0); PG8_MMA(1, 0, At, B0); PG8_BAR; PG8_SCHED;
            PG8_STAGE(PG8_SB(0, 1), b2 + hstep, voffB);
            PG8_WAIT_V(6); PG8_BAR; PG8_MMA(1, 1, At, B1); PG8_BAR;
            PG8_LDB(B0, 1, 0); PG8_SCHED; PG8_LDA(At, 1, 0); PG8_STAGE(PG8_SA(0, 1), a2 + hstep, voffA);
            PG8_WAIT_L(8); PG8_BAR; PG8_WAIT_L(0); PG8_MMA(0, 0, At, B0); PG8_BAR; PG8_SCHED;
            PG8_LDB(B1, 1, 1); PG8_STAGE(PG8_SB(1, 0), b3, voffB);
            PG8_BAR; PG8_WAIT_L(0); PG8_MMA(0, 1, At, B1); PG8_BAR;
            PG8_LDA(At, 1, 1); PG8_STAGE(PG8_SA(1, 0), a3, voffA);
            PG8_BAR; PG8_WAIT_L(0); PG8_MMA(1, 0, At, B0); PG8_BAR; PG8_SCHED;
            PG8_STAGE(PG8_SB(1, 1), b3 + hstep, voffB);
            PG8_WAIT_V(6); PG8_BAR; PG8_MMA(1, 1, At, B1); PG8_BAR;
            }
        }
        if constexpr (ALIGN_EPI) { if (wr == 0) PG8_BAR; }
        if constexpr (!Epi::AFTER_DRAIN) { E(acc, cur, wr, wc, fr, fq); S.done(cur); }
        if (!has_next) break;
#pragma unroll
        for (int a = 0; a < 2; ++a)
#pragma unroll
            for (int b = 0; b < 2; ++b)
#pragma unroll
                for (int m = 0; m < 4; ++m)
#pragma unroll
                    for (int n = 0; n < 2; ++n) acc[a][b][m][n] = (f32x4){0.f, 0.f, 0.f, 0.f};
        cur = nxt; cA = nA; cB = nB; ++ui;
        if constexpr (ALIGN_EPI) { if (wr == 1) PG8_BAR; }
    }
    PG8_WAIT_V(0);
    if constexpr (!ALIGN_EPI) { if (wr == 0) PG8_BAR; }
    PG8_BAR;
    if constexpr (Epi::AFTER_DRAIN) { E.fused(acc, cur, wr, wc, fr, fq, lds, wid, lane); S.done(cur); }
#undef PG8_SA
#undef PG8_SB
#undef PG8_STAGE
#undef PG8_LDA
#undef PG8_LDB
#undef PG8_MMA
#undef PG8_WAIT_V
#undef PG8_WAIT_L
#undef PG8_BAR
#undef PG8_SCHED
}
}

#ifndef PG8_SP2
#define PG8_SP2 true
#endif
#ifndef PG8_ALIGN
#define PG8_ALIGN true
#endif
namespace pg8 {
struct EpiResF32 {
    static constexpr bool PERM = false, AFTER_DRAIN = false;
    const float* base; float* out; int ldc;
    __device__ __forceinline__ void operator()(const f32x4 (&acc)[2][2][4][2], const Unit& u, int wr, int wc, int fr, int fq) const {
        const int col0 = u.pn * BM + wc * 32 + 4 * fq;
#pragma unroll
        for (int ai = 0; ai < 2; ++ai)
#pragma unroll
            for (int m = 0; m < 4; ++m) { const size_t off = (size_t)(u.pm * BM + ai * HALF + wr * 64 + m * 16 + fr) * ldc + col0;
#pragma unroll
                for (int bj = 0; bj < 2; ++bj)
#pragma unroll
                    for (int n = 0; n < 2; ++n) { const f32x4 bs = *(const f32x4*)(base + off + bj * HALF + n * 16); *(f32x4*)(out + off + bj * HALF + n * 16) = bs + acc[ai][bj][m][n]; } }
    }
};
struct EpiSwiglu {
    static constexpr bool PERM = true, AFTER_DRAIN = false;
    bf16_t* O; const float* bias;
    __device__ __forceinline__ void operator()(const f32x4 (&acc)[2][2][4][2], const Unit& u, int wr, int wc, int fr, int fq) const {
        const int e = u.pn >> 3, pnl = u.pn & 7;
        const int row0 = u.pm * BM + wr * 64 + fr, bcol0 = pnl * BM + wc * 32 + 8 * fq;
        const float* bp = bias + (size_t)e * 2048 + bcol0;
        f32x4 bv[2][2];
#pragma unroll
        for (int bj = 0; bj < 2; ++bj)
#pragma unroll
            for (int n = 0; n < 2; ++n) bv[bj][n] = *(const f32x4*)(bp + bj * HALF + 4 * n);
#pragma unroll
        for (int ai = 0; ai < 2; ++ai)
#pragma unroll
            for (int m = 0; m < 4; ++m) { bf16_t* rowp = O + (size_t)(row0 + ai * HALF + m * 16) * 1024 + (bcol0 >> 1);
#pragma unroll
                for (int bj = 0; bj < 2; ++bj) { const f32x4 v0 = acc[ai][bj][m][0] + bv[bj][0], v1 = acc[ai][bj][m][1] + bv[bj][1];
                    float g[4] = {v0[0], v0[2], v1[0], v1[2]}, up[4] = {v0[1], v0[3], v1[1], v1[3]}, a[4];
#pragma unroll
                    for (int i = 0; i < 4; ++i) { const float gc = fminf(g[i], 7.0f), uc = fminf(fmaxf(up[i], -7.0f), 7.0f);
                        a[i] = (uc + 1.0f) * gc * __builtin_amdgcn_rcpf(1.0f + __builtin_amdgcn_exp2f(-1.702f * 1.4426950408889634f * gc)); }
                    typedef unsigned u32x2 __attribute__((ext_vector_type(2)));
                    u32x2 w; w.x = cvt_pk_bf16(a[0], a[1]); w.y = cvt_pk_bf16(a[2], a[3]);
                    *(u32x2*)(rowp + bj * 64) = w; } }
    }
};
struct EpiMoeOut {
    static constexpr bool PERM = true, AFTER_DRAIN = false;
    bf16_t* YS; const float* bias; const int* rdest; const float* rgate;
    __device__ __forceinline__ void operator()(const f32x4 (&acc)[2][2][4][2], const Unit& u, int wr, int wc, int fr, int fq) const {
        const int e = u.pn >> 2, pnl = u.pn & 3;
        const int row0 = u.pm * BM + wr * 64 + fr, col0 = pnl * BM + wc * 32 + 8 * fq;
        const float* bp = bias + (size_t)e * 1024 + col0;
        f32x4 bv[2][2];
#pragma unroll
        for (int bj = 0; bj < 2; ++bj)
#pragma unroll
            for (int n = 0; n < 2; ++n) bv[bj][n] = *(const f32x4*)(bp + bj * HALF + 4 * n);
#pragma unroll
        for (int ai = 0; ai < 2; ++ai)
#pragma unroll
            for (int m = 0; m < 4; ++m) { const int r = row0 + ai * HALF + m * 16; const int d = rdest[r];
                if (d >= 0) { const float gt = rgate[r]; bf16_t* rowp = YS + (size_t)d * 1024 + col0;
#pragma unroll
                    for (int bj = 0; bj < 2; ++bj) { const f32x4 v0 = (acc[ai][bj][m][0] + bv[bj][0]) * gt, v1 = (acc[ai][bj][m][1] + bv[bj][1]) * gt;
                        u32x4 w; w.x = cvt_pk_bf16(v0[0], v0[1]); w.y = cvt_pk_bf16(v0[2], v0[3]); w.z = cvt_pk_bf16(v1[0], v1[1]); w.w = cvt_pk_bf16(v1[2], v1[3]);
                        *(u32x4*)(rowp + bj * HALF) = w; } } }
    }
};
template <int NTN> struct MoeOrder {
    int ntiles, c, G; const PG8_LAS int* te;
    __device__ __forceinline__ bool next(int i, Unit& u) const {
        int pm, pnl; constexpr int RT = 32 / NTN;
        if (G == 256) { const int x = c & 7, j = c >> 3, gidx = i * 8 + x; pm = RT * gidx + (j % RT); pnl = j / RT; }
        else { const long L = (long)i * G + c; pm = (int)(L / NTN); pnl = (int)(L % NTN); }
        if (pm >= ntiles) return false;
        u.pm = pm; u.pn = te[pm] * NTN + pnl; return true;
    }
    __device__ __forceinline__ void a_ready(const Unit&) const {}
    __device__ __forceinline__ void done(const Unit&) const {}
};
}
#include <hip/hip_bf16.h>
#include <cmath>
namespace attn_body {
using bf16=__hip_bfloat16;
using bf16x8=__attribute__((ext_vector_type(8)))short;
using s16x4=__attribute__((ext_vector_type(4)))short;
using f32x16=__attribute__((ext_vector_type(16)))float;
using u32x4=__attribute__((ext_vector_type(4)))unsigned;
constexpr int SEQ=8192,D=64,PQ=3328,PO=1024;
constexpr int NW=8,QBLK=32,QB=QBLK*NW,KVBLK=64,NQB=SEQ/QB;
constexpr int ATTN_UNIT_ROWS=QB;
__device__ __forceinline__ int crow(int r,int hi){return (r&3)+8*(r>>2)+4*hi;}
#define SBAR() __builtin_amdgcn_sched_barrier(0)
__device__ __forceinline__ void cmask(f32x16&p0,f32x16&p1,int jb,int qrel,int hi){
  const float NEG=-INFINITY; int kb=64*jb+4*hi;
  #pragma unroll
  for(int r=0;r<16;++r){int kv=kb+(r&3)+8*(r>>2); if(kv>qrel)p0[r]=NEG; if(kv+32>qrel)p1[r]=NEG;}
}

constexpr int NSLOT=3, SLOTB=8192;
constexpr int LDS_K=0, LDS_V=NSLOT*SLOTB, LDS_WS=2*NSLOT*SLOTB, LDS_OST=LDS_WS+NW*64*4, LDS_BYTES=LDS_OST+NW*4096;
constexpr float C2=0.125f*1.4426950408889634f;
__device__ __forceinline__ void glds16(const void*gsrc,unsigned lds_dst){unsigned keep;
  asm volatile("s_mov_b32 %0, m0\n\ts_mov_b32 m0, %2\n\ts_nop 0\n\tglobal_load_lds_dwordx4 %1, off\n\ts_mov_b32 m0, %0":"=&s"(keep):"v"(gsrc),"s"(lds_dst):"memory");}
__device__ __forceinline__ float max3f(float a,float b,float c){float r;asm("v_max3_f32 %0, %1, %2, %3":"=v"(r):"v"(a),"v"(b),"v"(c));return r;}
__device__ __forceinline__ float max2f(float a,float b){float r;asm("v_max_f32_e32 %0, %1, %2":"=v"(r):"v"(a),"v"(b));return r;}
__device__ __forceinline__ float fadd_s(float a,float b){float r;asm("v_add_f32_e32 %0, %1, %2":"=v"(r):"v"(a),"v"(b));return r;}
__device__ __forceinline__ float fsub_s(float a,float b){float r;asm("v_sub_f32_e32 %0, %1, %2":"=v"(r):"v"(a),"v"(b));return r;}
typedef float f32x2_t __attribute__((ext_vector_type(2))); typedef __bf16 bf16x2_t __attribute__((ext_vector_type(2)));
__device__ __forceinline__ unsigned cvtpk_s(float lo,float hi){f32x2_t v={lo,hi};bf16x2_t b=__builtin_convertvector(v,bf16x2_t);return __builtin_bit_cast(unsigned,b);}
#define WAIT_BAR(N) asm volatile("s_waitcnt vmcnt(" #N ") lgkmcnt(0)\n\ts_barrier":::"memory")

__device__ __forceinline__ void qkt(f32x16&p0,f32x16&p1,const char*Kslot,const bf16x8*qr,const f32x16&negm,int r32,int hi){
  const char*kb=Kslot+hi*1024+r32*16;
  #pragma unroll
  for(int d0=0;d0<4;++d0){
    const bf16x8 b0=*reinterpret_cast<const bf16x8*>(kb+d0*2048);
    const bf16x8 b1=*reinterpret_cast<const bf16x8*>(kb+d0*2048+512);
    if(d0==0){p0=__builtin_amdgcn_mfma_f32_32x32x16_bf16(b0,qr[0],negm,0,0,0);p1=__builtin_amdgcn_mfma_f32_32x32x16_bf16(b1,qr[0],negm,0,0,0);}
    else{p0=__builtin_amdgcn_mfma_f32_32x32x16_bf16(b0,qr[d0],p0,0,0,0);p1=__builtin_amdgcn_mfma_f32_32x32x16_bf16(b1,qr[d0],p1,0,0,0);}}
}
typedef __attribute__((address_space(3))) const char* lds_cptr;
typedef short v4i16_t __attribute__((ext_vector_type(4)));
__device__ __forceinline__ void kload8(bf16x8*kf,lds_cptr kp){
  kf[0]=*(const __attribute__((address_space(3))) bf16x8*)(kp);      kf[1]=*(const __attribute__((address_space(3))) bf16x8*)(kp+512);
  kf[2]=*(const __attribute__((address_space(3))) bf16x8*)(kp+2048); kf[3]=*(const __attribute__((address_space(3))) bf16x8*)(kp+2560);
  kf[4]=*(const __attribute__((address_space(3))) bf16x8*)(kp+4096); kf[5]=*(const __attribute__((address_space(3))) bf16x8*)(kp+4608);
  kf[6]=*(const __attribute__((address_space(3))) bf16x8*)(kp+6144); kf[7]=*(const __attribute__((address_space(3))) bf16x8*)(kp+6656);
}
__device__ __forceinline__ void kload2(bf16x8*kf,lds_cptr kp,int j){ kf[2*j]=*(const __attribute__((address_space(3))) bf16x8*)(kp+j*2048); kf[2*j+1]=*(const __attribute__((address_space(3))) bf16x8*)(kp+j*2048+512); }
__device__ __forceinline__ s16x4 vtr(lds_cptr p){ return __builtin_bit_cast(s16x4,__builtin_amdgcn_ds_read_tr16_b64_v4i16((__attribute__((address_space(3))) v4i16_t*)p)); }
__device__ __forceinline__ float rowmax(const f32x16&p0,const f32x16&p1){
  float a=max3f(p0[0],p0[1],p1[0]),b=max3f(p0[2],p0[3],p1[1]);a=max3f(a,p1[2],p1[3]);
  #pragma unroll
  for(int r=4;r<16;r+=4){a=max3f(a,p0[r],p0[r+1]);b=max3f(b,p0[r+2],p0[r+3]);a=max3f(a,p1[r],p1[r+1]);b=max3f(b,p1[r+2],p1[r+3]);}
  const float m=max2f(a,b);
  auto rr=__builtin_amdgcn_permlane32_swap(__float_as_uint(m),__float_as_uint(m),false,false);
  return max2f(__uint_as_float(rr[0]),__uint_as_float(rr[1]));
}
__device__ __forceinline__ void pv(f32x16*o,int vb,bf16x8 pa0,bf16x8 pa1,bf16x8 pa2,bf16x8 pa3){
  #pragma unroll
  for(int d0=0;d0<2;++d0){s16x4 lo[4],hi[4];
    #pragma unroll
    for(int ks=0;ks<4;++ks){
      asm volatile("ds_read_b64_tr_b16 %0,%1 offset:%c2":"=&v"(lo[ks]):"v"(vb),"i"(d0*4096+ks*1024):"memory");
      asm volatile("ds_read_b64_tr_b16 %0,%1 offset:%c2":"=&v"(hi[ks]):"v"(vb),"i"(d0*4096+ks*1024+512):"memory");}
    asm volatile("s_waitcnt lgkmcnt(0)":::"memory");SBAR();
    #define PK(k) (bf16x8){lo[k][0],lo[k][1],lo[k][2],lo[k][3],hi[k][0],hi[k][1],hi[k][2],hi[k][3]}
    o[d0]=__builtin_amdgcn_mfma_f32_32x32x16_bf16(pa0,PK(0),o[d0],0,0,0);
    o[d0]=__builtin_amdgcn_mfma_f32_32x32x16_bf16(pa1,PK(1),o[d0],0,0,0);
    o[d0]=__builtin_amdgcn_mfma_f32_32x32x16_bf16(pa2,PK(2),o[d0],0,0,0);
    o[d0]=__builtin_amdgcn_mfma_f32_32x32x16_bf16(pa3,PK(3),o[d0],0,0,0);
    #undef PK
  }
}

#ifndef ATTN_STORE16
#define ATTN_STORE16(p,v) (*(u32x4*)(p)=(v))
#endif
template<int THRL> __device__ __forceinline__ void attn_unit(int b,int qb,const bf16*Q,const bf16*__restrict__ K,const bf16*__restrict__ V,bf16*O,char*shm){
  const int tid=threadIdx.x,lane=tid&63,r32=lane&31,hi=lane>>5; const int wid=__builtin_amdgcn_readfirstlane(tid>>6);
  const long rowbase=(long)b*SEQ; const int q0=qb*QB;
  const bf16*Qw=Q+(rowbase+q0+wid*QBLK)*PQ;
  const bf16*Kh=K+rowbase*PQ,*Vh=V+rowbase*PQ;
  const unsigned lds0=(unsigned)(uintptr_t)shm;
  float*wsf=(float*)(shm+LDS_WS)+wid*64;
  const bf16*ksrc=Kh+(long)lane*PQ+wid*8;
  const bf16*vsrc=Vh+(long)(16*(wid&3)+(lane>>2))*PQ+(wid>>2)*32+(lane&3)*8;
  const unsigned kdst=lds0+LDS_K+wid*1024, vdst=lds0+LDS_V+wid*1024;
  #define DMA_K(t,slot) glds16(ksrc+(long)(t)*KVBLK*PQ,(unsigned)__builtin_amdgcn_readfirstlane(kdst+(slot)))
  #define DMA_V(t,slot) glds16(vsrc+(long)(t)*KVBLK*PQ,(unsigned)__builtin_amdgcn_readfirstlane(vdst+(slot)))
  const int vb0=(int)(lds0+LDS_V)+((lane>>4)&1)*32+(lane&3)*8+(4*hi+((lane&15)>>2))*64;
  const char*Kbase=shm+LDS_K; bf16x8 kf[8];
  const lds_cptr shm3=(lds_cptr)shm; const lds_cptr kp0=shm3+LDS_K+hi*1024+r32*16; const lds_cptr vp0=shm3+LDS_V+((lane>>4)&1)*32+(lane&3)*8+(4*hi+((lane&15)>>2))*64;
  const int NT=(q0+QB)/KVBLK;
  DMA_K(0,0);DMA_V(0,0);DMA_K(1,SLOTB);
  bf16x8 qr[4];
  #pragma unroll
  for(int d0=0;d0<4;++d0)qr[d0]=*reinterpret_cast<const bf16x8*>(&Qw[(long)r32*PQ+d0*16+hi*8]);
  float mhat=0.f,l_reg=0.f;f32x16 o[2];o[0]=f32x16{};o[1]=f32x16{};f32x16 negm=f32x16{};asm volatile("":"+v"(negm));
  const int qrel=wid*QBLK+r32;
  #define CMASK(P0,P1,t) do{int jb_=(t)-(NT-4); if(jb_>=0)cmask(P0,P1,jb_,qrel,hi);}while(0)
  bool resc=false;
  #define START(P0,P1) do{ const float rm=rowmax(P0,P1); resc=false; \
    { const float dl=rm; mhat=fadd_s(mhat,dl); \
      _Pragma("unroll") for(int r=0;r<16;++r){P0[r]=fsub_s(P0[r],dl);P1[r]=fsub_s(P1[r],dl);} \
      _Pragma("unroll") for(int r=0;r<16;++r)negm[r]=-mhat; asm volatile("":"+v"(negm)); } \
    _Pragma("unroll") for(int r=0;r<16;++r)P0[r]=__builtin_amdgcn_exp2f(P0[r]); }while(0)
  #define RESC() do{ if(resc){ asm volatile("s_waitcnt lgkmcnt(0)":::"memory"); \
      _Pragma("unroll") for(int d_=0;d_<2;++d_) _Pragma("unroll") for(int r=0;r<16;++r)o[d_][r]*=wsf[crow(r,hi)]; } }while(0)
  f32x16 pA0,pA1,pB0,pB1;
  int sl_prev=0,sl_cur=0,sl_next=SLOTB;
  #define ROT() do{sl_prev=sl_cur;sl_cur=sl_next;sl_next=(sl_next==(NSLOT-1)*SLOTB)?0:sl_next+SLOTB;}while(0)
  DMA_K(2,2*SLOTB);
  WAIT_BAR(3);
  qkt(pA0,pA1,Kbase,qr,negm,r32,hi);asm volatile("s_nop 15\n\ts_nop 7":"+v"(pA0),"+v"(pA1));CMASK(pA0,pA1,0);
  START(pA0,pA1);
  _Pragma("unroll") for(int r=0;r<16;++r)pA1[r]=__builtin_amdgcn_exp2f(pA1[r]);
  WAIT_BAR(0);
  DMA_K(3,0);DMA_V(1,SLOTB);
  ROT();
  kload8(kf,kp0+sl_cur);
  WAIT_BAR(2);
  s16x4 vlo[8],vhi[8]; u32x4 pw0,pw1,pw2,pw3;
  #define PKW(P,B) cvtpk_s(P[B],P[B+1])
  #define PAF(k) __builtin_bit_cast(bf16x8,pw##k)
  #define VFR(i) (bf16x8){vlo[i][0],vlo[i][1],vlo[i][2],vlo[i][3],vhi[i][0],vhi[i][1],vhi[i][2],vhi[i][3]}
  #define PIN(x) asm volatile("":"+v"(x))
  #define MX3(a,b,c) __builtin_fmaxf(__builtin_fmaxf((a),(b)),(c))
  #define GAPA(MF,A0,A1,A2,A3,W0,W1,PW) do{ MF; sacc+=A0; sacc+=A1; sacc+=A2; sacc+=A3; PIN(sacc); W0; W1; PIN(PW); SBAR(); }while(0)
  #define EX(v) __builtin_amdgcn_exp2f(v)
  #define GAPB(MF,X,B) do{ MF; X[B]=EX(X[B]); X[B+1]=EX(X[B+1]); X[B+2]=EX(X[B+2]); X[B+3]=EX(X[B+3]); PIN(X); SBAR(); }while(0)
  #define VRD(i) do{ vlo[i]=vtr(vp_+(((i)>>2)*4096+((i)&3)*1024)); vhi[i]=vtr(vp_+(((i)>>2)*4096+((i)&3)*1024+512)); }while(0)
  #define KRD(G,j) do{ if(G){ kload2(kf,kp0+sl_next,j); SBAR(); } }while(0)
  #define STEP(C0,C1,P0,P1,t,GK,GV,GL) do{ SBAR(); \
    const lds_cptr vp_=vp0+sl_prev; \
    VRD(0); SBAR(); float sacc=(P0[0]+P0[1]); \
    GAPA(C0=__builtin_amdgcn_mfma_f32_32x32x16_bf16(kf[0],qr[0],negm,0,0,0), P0[2],P0[3],P0[4],P0[5],     pw0[0]=PKW(P0,0), pw0[1]=PKW(P0,2), pw0); \
    VRD(4); SBAR(); GAPA(C1=__builtin_amdgcn_mfma_f32_32x32x16_bf16(kf[1],qr[0],negm,0,0,0), P0[6],P0[7],P0[8],P0[9],     pw0[2]=PKW(P0,4), pw0[3]=PKW(P0,6), pw0); \
    VRD(1); SBAR(); GAPA(C0=__builtin_amdgcn_mfma_f32_32x32x16_bf16(kf[2],qr[1],C0,0,0,0),   P0[10],P0[11],P0[12],P0[13], pw1[0]=PKW(P0,8), pw1[1]=PKW(P0,10), pw1); \
    VRD(5); SBAR(); GAPA(C1=__builtin_amdgcn_mfma_f32_32x32x16_bf16(kf[3],qr[1],C1,0,0,0),   P0[14],P0[15],P1[0],P1[1],   pw1[2]=PKW(P0,12),pw1[3]=PKW(P0,14), pw1); \
    VRD(2); SBAR(); GAPA(C0=__builtin_amdgcn_mfma_f32_32x32x16_bf16(kf[4],qr[2],C0,0,0,0),   P1[2],P1[3],P1[4],P1[5],     pw2[0]=PKW(P1,0), pw2[1]=PKW(P1,2), pw2); \
    VRD(6); SBAR(); GAPA(C1=__builtin_amdgcn_mfma_f32_32x32x16_bf16(kf[5],qr[2],C1,0,0,0),   P1[6],P1[7],P1[8],P1[9],     pw2[2]=PKW(P1,4), pw2[3]=PKW(P1,6), pw2); \
    VRD(3); SBAR(); GAPA(C0=__builtin_amdgcn_mfma_f32_32x32x16_bf16(kf[6],qr[3],C0,0,0,0),   P1[10],P1[11],P1[12],P1[13], pw3[0]=PKW(P1,8), pw3[1]=PKW(P1,10), pw3); \
    VRD(7); SBAR(); GAPA(C1=__builtin_amdgcn_mfma_f32_32x32x16_bf16(kf[7],qr[3],C1,0,0,0),   P1[14],P1[15],0.f,0.f,       pw3[2]=PKW(P1,12),pw3[3]=PKW(P1,14), pw3); \
    l_reg+=sacc; \
    if(GK){DMA_K((t)+3,sl_cur);} if(GV){DMA_V((t)+1,sl_next);} \
    CMASK(C0,C1,t); \
    { float a=MX3(C0[0],C0[1],C1[0]),b=MX3(C0[2],C0[3],C1[1]); a=MX3(a,C1[2],C1[3]); \
      _Pragma("unroll") for(int r=4;r<16;r+=4){a=MX3(a,C0[r],C0[r+1]);b=MX3(b,C0[r+2],C0[r+3]);a=MX3(a,C1[r],C1[r+1]);b=MX3(b,C1[r+2],C1[r+3]);} \
      float rm=__builtin_fmaxf(a,b); { auto rr=__builtin_amdgcn_permlane32_swap(__float_as_uint(rm),__float_as_uint(rm),false,false); rm=__builtin_fmaxf(__uint_as_float(rr[0]),__uint_as_float(rr[1])); } \
      resc=false; \
      if(__builtin_expect(__any(rm>(float)THRL),0)){ const float dl=__builtin_fmaxf(rm,0.f); mhat+=dl; \
        _Pragma("unroll") for(int r=0;r<16;++r){C0[r]-=dl;C1[r]-=dl;} \
        _Pragma("unroll") for(int r=0;r<16;++r)negm[r]=-mhat; asm volatile("":"+v"(negm)); \
        const float f=__builtin_amdgcn_exp2f(-dl); l_reg*=f; if(hi==0)wsf[r32]=f; resc=true; } } \
    SBAR(); \
    GAPB(o[0]=__builtin_amdgcn_mfma_f32_32x32x16_bf16(PAF(0),VFR(0),o[0],0,0,0), C0,0); \
    GAPB(o[1]=__builtin_amdgcn_mfma_f32_32x32x16_bf16(PAF(0),VFR(4),o[1],0,0,0), C0,4); \
    KRD(GL,0); GAPB(o[0]=__builtin_amdgcn_mfma_f32_32x32x16_bf16(PAF(1),VFR(1),o[0],0,0,0), C0,8); \
    KRD(GL,1); GAPB(o[1]=__builtin_amdgcn_mfma_f32_32x32x16_bf16(PAF(1),VFR(5),o[1],0,0,0), C0,12); \
    KRD(GL,2); GAPB(o[0]=__builtin_amdgcn_mfma_f32_32x32x16_bf16(PAF(2),VFR(2),o[0],0,0,0), C1,0); \
    KRD(GL,3); GAPB(o[1]=__builtin_amdgcn_mfma_f32_32x32x16_bf16(PAF(2),VFR(6),o[1],0,0,0), C1,4); \
    GAPB(o[0]=__builtin_amdgcn_mfma_f32_32x32x16_bf16(PAF(3),VFR(3),o[0],0,0,0), C1,8); \
    GAPB(o[1]=__builtin_amdgcn_mfma_f32_32x32x16_bf16(PAF(3),VFR(7),o[1],0,0,0), C1,12); \
    }while(0)
  int t=1;
  #undef CMASK
  #define CMASK(P0,P1,t) do{}while(0)
  for(;t+5<NT;t+=2){
    STEP(pB0,pB1,pA0,pA1,t,true,true,true);     WAIT_BAR(2); RESC(); ROT();
    STEP(pA0,pA1,pB0,pB1,t+1,true,true,true);   WAIT_BAR(2); RESC(); ROT();
  }
  #undef CMASK
  #define CMASK(P0,P1,t) do{int jb_=(t)-(NT-4); if(jb_>=0)cmask(P0,P1,jb_,qrel,hi);}while(0)
  #define ENDW(tt) do{ if((tt)+3<NT){WAIT_BAR(2);} else if((tt)+2<NT){WAIT_BAR(1);} else {WAIT_BAR(0);} }while(0)
  for(;t+1<NT;t+=2){
    STEP(pB0,pB1,pA0,pA1,t,(t+3<NT),(t+1<NT),(t+1<NT));       ENDW(t);   RESC(); ROT();
    STEP(pA0,pA1,pB0,pB1,t+1,(t+4<NT),(t+2<NT),(t+2<NT));     ENDW(t+1); RESC(); ROT();
  }
  STEP(pB0,pB1,pA0,pA1,NT-1,false,false,false); RESC();
  { float sacc=pB0[0]+pB0[1]; _Pragma("unroll") for(int r=2;r<16;++r)sacc+=pB0[r]; _Pragma("unroll") for(int r=0;r<16;++r)sacc+=pB1[r]; l_reg+=sacc;
    pw0=(u32x4){PKW(pB0,0),PKW(pB0,2),PKW(pB0,4),PKW(pB0,6)};pw1=(u32x4){PKW(pB0,8),PKW(pB0,10),PKW(pB0,12),PKW(pB0,14)};pw2=(u32x4){PKW(pB1,0),PKW(pB1,2),PKW(pB1,4),PKW(pB1,6)};pw3=(u32x4){PKW(pB1,8),PKW(pB1,10),PKW(pB1,12),PKW(pB1,14)};
    SBAR(); pv(o,vb0+sl_cur,PAF(0),PAF(1),PAF(2),PAF(3)); }
  #undef PKW
  #undef PAF
  #undef VFR
  #undef PIN
  #undef MX3
  #undef GAPA
  #undef GAPB
  #undef EX
  #undef VRD
  #undef KRD
  #undef STEP
  #undef ENDW
  {auto rr=__builtin_amdgcn_permlane32_swap(__float_as_uint(l_reg),__float_as_uint(l_reg),false,false);l_reg=__uint_as_float(rr[0])+__uint_as_float(rr[1]);}
  if(hi==0)wsf[32+r32]=l_reg;asm volatile("s_waitcnt lgkmcnt(0)":::"memory");
  float rli[16];
  #pragma unroll
  for(int r=0;r<16;++r)rli[r]=__builtin_amdgcn_rcpf(wsf[32+crow(r,hi)]);
  bf16*Ow=O+(rowbase+q0+wid*QBLK)*PO;
  { bf16*stg=(bf16*)(shm+LDS_OST)+wid*2048;
    #pragma unroll
    for(int r=0;r<16;++r){const int orow=crow(r,hi);
      #pragma unroll
      for(int d0=0;d0<2;++d0)stg[orow*64+d0*32+r32]=__float2bfloat16(o[d0][r]*rli[r]);}
    asm volatile("s_waitcnt lgkmcnt(0)":::"memory");
    #pragma unroll
    for(int i=0;i<4;++i){const int row=i*8+(lane>>3),ch=lane&7; const u32x4 v=*(const u32x4*)(stg+row*64+ch*8); ATTN_STORE16(Ow+(long)row*PO+ch*8,v);} }
  asm volatile("s_waitcnt lgkmcnt(0)\n\ts_barrier":::"memory");
  #undef DMA_K
  #undef DMA_V
  #undef CMASK
  #undef START
  #undef RESC
  #undef ROT
}
constexpr int ATTN_LDS_BYTES=LDS_BYTES;
#undef SBAR
#undef WAIT_BAR
}
#define GAS __attribute__((address_space(1)))
#define LAS __attribute__((address_space(3)))
typedef unsigned short bf16;
typedef unsigned v4u __attribute__((ext_vector_type(4)));
typedef float f32x4 __attribute__((ext_vector_type(4)));
typedef short bf16x8 __attribute__((ext_vector_type(8)));
typedef GAS unsigned gu32;
typedef GAS unsigned long long gu64;
#define RLX_AGENT __ATOMIC_RELAXED, __HIP_MEMORY_SCOPE_AGENT
#define LDS_WAIT() asm volatile("s_waitcnt lgkmcnt(0)" ::: "memory")
#define VM_WAIT() asm volatile("s_waitcnt vmcnt(0)" ::: "memory")
__device__ __forceinline__ unsigned long long rt() { return __builtin_amdgcn_s_memrealtime(); }
__device__ __forceinline__ unsigned f2bf(float f) { unsigned u = __builtin_bit_cast(unsigned, f); return (u + 0x7fffu + ((u >> 16) & 1u)) >> 16; }
__device__ __forceinline__ unsigned pk2(float lo, float hi) { return f2bf(lo) | (f2bf(hi) << 16); }

#define XB_TMO      128
#define XB_XCNT(j)  (256  + 64 * (j))
#define XB_XSUB(j)  (1280 + 64 * (j))
#define XB_XGEN(j)  (2304 + 64 * (j))
#define XB_TOP      3328
#define XB_TOPGEN   3392
#define XCD_BAR_WORDS 3456
#define XB_SPIN_CAP (1u << 18)

__device__ __forceinline__ unsigned xb_ld(unsigned* p)              { return __hip_atomic_load(p, __ATOMIC_RELAXED, __HIP_MEMORY_SCOPE_AGENT); }
__device__ __forceinline__ unsigned xb_add(unsigned* p, unsigned v) { return __hip_atomic_fetch_add(p, v, __ATOMIC_RELAXED, __HIP_MEMORY_SCOPE_AGENT); }
__device__ __forceinline__ unsigned xb_xcc_id() { return (unsigned)__builtin_amdgcn_s_getreg((3 << 11) | 20) & 0xFu; }
#define XB_SPIN(cond, bar) do { unsigned _sp = 0; while (cond) { __builtin_amdgcn_s_sleep(1); \
    if ((++_sp & 255u) == 0u) { if (xb_ld(&(bar)[XB_TMO])) break; if (_sp > XB_SPIN_CAP) { atomicAdd(&(bar)[XB_TMO], 1u); break; } } } } while (0)

struct XcdBarrier {
    unsigned* bar; unsigned x;
    volatile LAS unsigned* st;
};

__device__ __forceinline__ XcdBarrier xcd_barrier_post(unsigned* bar, volatile LAS unsigned* st) {
    XcdBarrier b; b.bar = bar; b.x = xb_xcc_id(); b.st = st;
    if (threadIdx.x == 0) (void)xb_add(&bar[XB_XCNT(b.x)], 1u);
    return b;
}
__device__ __forceinline__ void xcd_barrier_complete(unsigned* bar, unsigned x, unsigned& nloc, unsigned& nx) {
    const unsigned G = gridDim.x * gridDim.y * gridDim.z;
    unsigned sum, cnt, mine, sp = 0u;
    for (;;) {
        sum = 0u; cnt = 0u; mine = 0u;
#pragma unroll
        for (unsigned j = 0; j < 16; ++j) { const unsigned c = xb_ld(&bar[XB_XCNT(j)]); sum += c; cnt += (c > 0u) ? 1u : 0u; mine = (j == x) ? c : mine; }
        if (sum == G) break;
        __builtin_amdgcn_s_sleep(1);
        if ((++sp & 255u) == 0u) { if (xb_ld(&bar[XB_TMO])) break; if (sp > XB_SPIN_CAP) { atomicAdd(&bar[XB_TMO], 1u); break; } }
    }
    nloc = mine > 0u ? mine : 1u; nx = cnt > 0u ? cnt : 1u;
}

__device__ __forceinline__ void xcd_barrier(const XcdBarrier& b) {
    asm volatile("s_waitcnt vmcnt(0)" ::: "memory");
    __syncthreads();
    if (threadIdx.x == 0) {
        unsigned* bar = b.bar;
        __builtin_amdgcn_s_waitcnt(0);
        unsigned nloc = b.st[0], nx = b.st[1];
        if (nloc == 0u) { xcd_barrier_complete(bar, b.x, nloc, nx); b.st[0] = nloc; b.st[1] = nx; }
        const unsigned old = xb_add(&bar[XB_XSUB(b.x)], 1u);
        const unsigned gen = old / nloc;
        if (old + 1u == (gen + 1u) * nloc) {
            __builtin_amdgcn_fence(__ATOMIC_RELEASE, "agent");
            asm volatile("s_waitcnt vmcnt(0)" ::: "memory");
            const unsigned og = xb_add(&bar[XB_TOP], 1u);
            const unsigned tg = og / nx;
            if (og + 1u == (tg + 1u) * nx) xb_add(&bar[XB_TOPGEN], 1u);
            else XB_SPIN(xb_ld(&bar[XB_TOPGEN]) == tg, bar);
            __builtin_amdgcn_fence(__ATOMIC_ACQUIRE, "agent");
            xb_add(&bar[XB_XGEN(b.x)], 1u);
            asm volatile("s_waitcnt vmcnt(0)" ::: "memory");
        } else {
            XB_SPIN(xb_ld(&bar[XB_XGEN(b.x)]) == gen, bar);
            __builtin_amdgcn_fence(__ATOMIC_ACQUIRE, "agent");
            asm volatile("s_waitcnt vmcnt(0)" ::: "memory");
        }
    }
    __syncthreads();
}
constexpr int NWAVES = 8;
constexpr int BATCH = 4, SEQ = 8192, T = BATCH * SEQ, D = 1024;
constexpr int IN_COLS = 3328, RW_OFF = 1536, RWW = 512;
constexpr int NEXP = 32, TOPK = 4;
constexpr int P_MAX = T * TOPK + NEXP * 256, MAX_TILES = P_MAX / 256;
constexpr float NORM_EPS = 1e-5f, GN_EPS = 64e-5f, LAM_INIT = 0.2f;
constexpr size_t MiB = 1u << 20;
constexpr size_t WS_CTL = 0, CTL_ZERO_BYTES = 1 * MiB;
constexpr size_t WS_BS = 1 * MiB;
constexpr size_t WS_TOPI = 2 * MiB, WS_GATE = 2 * MiB + 512 * 1024, WS_POS = 3 * MiB;
constexpr size_t WS_RDEST = 4 * MiB, WS_RGATE = 5 * MiB;
constexpr size_t WS_RWS = 6 * MiB;
constexpr size_t WS_WO = 8 * MiB, WS_WL = 10 * MiB, WS_WIN = 11 * MiB, WS_W1 = 18 * MiB, WS_W2 = 146 * MiB;
constexpr size_t WS_PB = 210 * MiB;
constexpr size_t WS_LW = 418 * MiB, WS_LA2 = 450 * MiB, WS_LG = 482 * MiB;
constexpr size_t WS_YB = 418 * MiB;
constexpr size_t WS_VEC = 514 * MiB;
constexpr size_t WS_AO = 514 * MiB;
constexpr size_t WS_XN = 898 * MiB;
constexpr size_t WS_X1 = 210 * MiB;
constexpr size_t WS_H2 = 338 * MiB;
constexpr size_t WS_XS = 402 * MiB;
constexpr size_t WS_ACT = 674 * MiB;
constexpr size_t WS_YS = 402 * MiB;
constexpr size_t WS_END = 1024 * MiB;
static_assert(WS_ACT + (size_t)P_MAX * 2048 <= WS_END && WS_XS + (size_t)P_MAX * 2048 <= WS_ACT && WS_XN + (size_t)T * 2048 <= WS_END && WS_VEC + 6 * (size_t)T * 2048 <= WS_XN, "ws map");
constexpr int CW_TMO = 0, CW_CNT = 64, CW_BAR = 4096;
constexpr int RING_OFF = 0, RING_BYTES = 131072;
constexpr int LDSCTL_OFF = RING_BYTES, MISC_OFF = LDSCTL_OFF + 320;
constexpr int HIST_OFF = LDSCTL_OFF + 512, HBASE_OFF = LDSCTL_OFF + 640, PST_OFF = LDSCTL_OFF + 768, TILE_OFF = LDSCTL_OFF + 1024;
constexpr int LDS_BYTES = 147456;
static_assert(TILE_OFF + 4 * (MAX_TILES + 32) <= LDS_BYTES, "LDS map");
struct Args {
    const float* x; const int* positions; const float* attn_norm_w; const float* w_in; const float* shift_mu;
    const float *lq1, *lk1, *lq2, *lk2; const float* subln_w;
    const float *rw_w0, *rw_w2, *rw_a0, *rw_a2, *rw_g2, *rw_k_k, *rw_k_a, *rw_r_k, *rw_lnx_w, *rw_lnx_b;
    const float* w_out; const float* ffn_norm_w; const float* router_w; const float* router_b;
    const float *mlp1_w, *mlp1_b, *mlp2_w, *mlp2_b; const float* final_norm_w;
    float* out; unsigned char* ws; int ph_lo, ph_hi;
};
struct Frame { LAS unsigned char* lds; int tid, lane, wave, vcu, G; };
typedef const __attribute__((address_space(4))) Args* KArgs;
__device__ __forceinline__ KArgs get_args() { unsigned long long p = (unsigned long long)__builtin_amdgcn_kernarg_segment_ptr(); asm volatile("" : "+s"(p)); return (KArgs)p; }

__device__ __forceinline__ float wave_sum(float v) {
#pragma unroll
    for (int o = 1; o < 64; o <<= 1) v += __shfl_xor(v, o);
    return v;
}
__device__ __forceinline__ float bf2f(unsigned short h) { return __builtin_bit_cast(float, (unsigned)h << 16); }
__device__ __forceinline__ float bflo(unsigned w) { return __builtin_bit_cast(float, w << 16); }
__device__ __forceinline__ float bfhi(unsigned w) { return __builtin_bit_cast(float, w & 0xffff0000u); }
__device__ __forceinline__ float sigmoidf_(float v) { return 1.0f / (1.0f + __expf(-v)); }
typedef unsigned u32x2 __attribute__((ext_vector_type(2)));
typedef float f32x16 __attribute__((ext_vector_type(16)));

__device__ __forceinline__ void p0_transpose_item(const float* W, int K, int N, bf16* WT, LAS float* scr, int item, int lane) {
    const int nblk = N / 32, kb = item / nblk, nb = item % nblk, k0 = 64 * kb, n0 = 32 * nb;
#pragma unroll 8
    for (int i = 0; i < 32; ++i) { const int kk = 2 * i + (lane >> 5); scr[kk * 33 + (lane & 31)] = W[(size_t)(k0 + kk) * N + n0 + (lane & 31)]; }
    LDS_WAIT(); asm volatile("" ::: "memory");
    const int c = lane & 7;
#pragma unroll
    for (int j = 0; j < 4; ++j) { const int n = (lane >> 3) + 8 * j; const LAS float* s = scr + (8 * c) * 33 + n;
        v4u o; o.x = pk2(s[0 * 33], s[1 * 33]); o.y = pk2(s[2 * 33], s[3 * 33]); o.z = pk2(s[4 * 33], s[5 * 33]); o.w = pk2(s[6 * 33], s[7 * 33]);
        *(GAS v4u*)(WT + (size_t)(n0 + n) * K + k0 + 8 * c) = o; }
    LDS_WAIT(); asm volatile("" ::: "memory");
}

__device__ __forceinline__ void p0_prologue(const Frame& F, KArgs A) {
    unsigned char* ws = A->ws;
    LAS float* scr = (LAS float*)(F.lds + RING_OFF + F.wave * 16384);
    const int gw = F.vcu * NWAVES + F.wave, NGW = F.G * NWAVES;
    bf16* Win_t = (bf16*)(ws + WS_WIN); bf16* Wo_t = (bf16*)(ws + WS_WO); bf16* W1_t = (bf16*)(ws + WS_W1); bf16* W2_t = (bf16*)(ws + WS_W2); bf16* Wl_t = (bf16*)(ws + WS_WL);
    constexpr int I_IN = (D / 64) * (IN_COLS / 32), I_O = (D / 64) * (D / 32), I_1E = (D / 64) * (2048 / 32), I_2E = (D / 64) * (D / 32);
    constexpr int NITEMS = I_IN + I_O + NEXP * I_1E + NEXP * I_2E;
    for (int it = gw; it < NITEMS; it += NGW) {
        int r = it;
        if (r < I_IN) { p0_transpose_item(A->w_in, D, IN_COLS, Win_t, scr, r, F.lane); continue; } r -= I_IN;
        if (r < I_O) { p0_transpose_item(A->w_out, D, D, Wo_t, scr, r, F.lane); continue; } r -= I_O;
        if (r < NEXP * I_1E) { const int e = r / I_1E; p0_transpose_item(A->mlp1_w + (size_t)e * D * 2048, D, 2048, W1_t + (size_t)e * 2048 * D, scr, r % I_1E, F.lane); continue; } r -= NEXP * I_1E;
        { const int e = r / I_2E; p0_transpose_item(A->mlp2_w + (size_t)e * D * D, D, D, W2_t + (size_t)e * D * D, scr, r % I_2E, F.lane); }
    }
    const int gt = F.vcu * (NWAVES * 64) + F.tid, NGT = F.G * NWAVES * 64;
    for (int idx = gt; idx < 1536 * 256; idx += NGT) { const int n = idx >> 8, k = idx & 255; float v = 0.f;
        if (n < 512) { if (k < 64) v = A->rw_w2[k * 512 + n]; }
        else if (n < 1024) { if (k >= 64 && k < 128) v = A->rw_a2[(k - 64) * 512 + (n - 512)]; }
        else { if (k >= 128) v = A->rw_g2[(k - 128) * 512 + (n - 1024)]; }
        Wl_t[idx] = (bf16)f2bf(v); }
    float* RWS = (float*)(ws + WS_RWS);
    for (int idx = gt; idx < D * NEXP; idx += NGT) RWS[idx] = A->router_w[idx] * A->ffn_norm_w[idx >> 5];
    int* RDEST = (int*)(ws + WS_RDEST);
    for (int idx = gt; idx < P_MAX; idx += NGT) RDEST[idx] = -1;
    bf16* XN = (bf16*)(ws + WS_XN);
    f32x4 nw[4];
#pragma unroll
    for (int j = 0; j < 4; ++j) nw[j] = *((const f32x4*)A->attn_norm_w + F.lane + 64 * j);
    for (int m = gw; m < T; m += NGW) {
        const GAS f32x4* xr = (const GAS f32x4*)(A->x + (size_t)m * D) + F.lane;
        f32x4 v[4]; float s2 = 0.f;
#pragma unroll
        for (int j = 0; j < 4; ++j) { v[j] = xr[64 * j]; s2 += (v[j].x * v[j].x + v[j].y * v[j].y) + (v[j].z * v[j].z + v[j].w * v[j].w); }
        const float rstd = 1.f / sqrtf(wave_sum(s2) * (1.f / D) + NORM_EPS);
        GAS unsigned long long* o8 = (GAS unsigned long long*)(XN + (size_t)m * D) + F.lane;
#pragma unroll
        for (int j = 0; j < 4; ++j) o8[64 * j] = (unsigned long long)pk2(v[j].x * rstd * nw[j].x, v[j].y * rstd * nw[j].y) | ((unsigned long long)pk2(v[j].z * rstd * nw[j].z, v[j].w * rstd * nw[j].w) << 32);
    }
}

__device__ __forceinline__ void p2_prep(const Frame& F, KArgs A) {
    unsigned char* ws = A->ws;
    bf16* PB = (bf16*)(ws + WS_PB); bf16* LA = (bf16*)(ws + WS_XN);
    float* VEC = (float*)(ws + WS_VEC);
    float* V_R = VEC, * V_K = VEC + 2 * (size_t)T * RWW, * V_V = VEC + 5 * (size_t)T * RWW;
    const int gw = F.vcu * NWAVES + F.wave, NGW = F.G * NWAVES, lane = F.lane;
    const int g = lane & 7, i0 = 4 * g;
    float invf[4];
#pragma unroll
    for (int i = 0; i < 4; ++i) invf[i] = exp2f(-(float)(i0 + i) * (13.287712379549449f / 32.0f));
    for (int t = gw; t < T; t += NGW) {
        const int s = t & (SEQ - 1);
        const float pos = (float)A->positions[t];
        bf16* row = PB + (size_t)t * IN_COLS;
        float cs[4], sn[4];
#pragma unroll
        for (int i = 0; i < 4; ++i) { const float ang = pos * invf[i]; double rev = (double)ang * 0.15915494309189535; rev -= floor(rev); const float rf = (float)rev;
            sn[i] = __builtin_amdgcn_sinf(rf); cs[i] = __builtin_amdgcn_cosf(rf); }
#pragma unroll
        for (int j = 0; j < 2; ++j) { const int blk = (lane >> 3) + 8 * j; bf16* p1 = row + blk * 64 + i0; bf16* p2 = p1 + 32;
            const u32x2 a = *(const u32x2*)p1, b = *(const u32x2*)p2; const float sc = blk < 8 ? attn_body::C2 : 1.0f;
            const float x1[4] = {bflo(a.x), bfhi(a.x), bflo(a.y), bfhi(a.y)}, x2[4] = {bflo(b.x), bfhi(b.x), bflo(b.y), bfhi(b.y)};
            float o1[4], o2[4];
#pragma unroll
            for (int i = 0; i < 4; ++i) { o1[i] = (x1[i] * cs[i] - x2[i] * sn[i]) * sc; o2[i] = (x2[i] * cs[i] + x1[i] * sn[i]) * sc; }
            u32x2 wa, wb; wa.x = pk2(o1[0], o1[1]); wa.y = pk2(o1[2], o1[3]); wb.x = pk2(o2[0], o2[1]); wb.y = pk2(o2[2], o2[3]);
            *(u32x2*)p1 = wa; *(u32x2*)p2 = wb; }
#pragma unroll
        for (int j = 0; j < 7; ++j) { const int c4 = (lane + 64 * j) * 4; const bf16* pc = row + RW_OFF + c4;
            const u32x2 cu = *(const u32x2*)pc; u32x2 pu; pu.x = 0u; pu.y = 0u; if (s > 0) pu = *(const u32x2*)(pc - IN_COLS);
            const f32x4 mu = *(const f32x4*)(A->shift_mu + c4);
            const float cur[4] = {bflo(cu.x), bfhi(cu.x), bflo(cu.y), bfhi(cu.y)}, prv[4] = {bflo(pu.x), bfhi(pu.x), bflo(pu.y), bfhi(pu.y)};
            f32x4 v;
#pragma unroll
            for (int i = 0; i < 4; ++i) v[i] = cur[i] + mu[i] * (prv[i] - cur[i]);
            if (c4 < 512) *(f32x4*)(V_R + (size_t)t * RWW + c4) = v;
            else if (c4 < 1024) *(f32x4*)(V_K + (size_t)t * RWW + (c4 - 512)) = v;
            else if (c4 < 1536) *(f32x4*)(V_V + (size_t)t * RWW + (c4 - 1024)) = v;
            else { f32x4 o;
                if (c4 < 1600) { for (int i = 0; i < 4; ++i) o[i] = tanhf(v[i]); }
                else if (c4 < 1664) o = v;
                else { for (int i = 0; i < 4; ++i) o[i] = sigmoidf_(v[i]); }
                u32x2 w; w.x = pk2(o[0], o[1]); w.y = pk2(o[2], o[3]);
                *(u32x2*)(LA + (size_t)t * 256 + (c4 - 1536)) = w; }
        }
    }
}

__device__ __forceinline__ void p4_prep(const Frame& F, KArgs A) {
    unsigned char* ws = A->ws;
    const bf16* LW = (const bf16*)(ws + WS_LW); const bf16* LA2 = (const bf16*)(ws + WS_LA2);
    float* VEC = (float*)(ws + WS_VEC); float* BS = (float*)(ws + WS_BS);
    const size_t SL = (size_t)T * RWW;
    const int gw = F.vcu * NWAVES + F.wave, NGW = F.G * NWAVES, lane = F.lane, c8 = lane * 8;
    float w0[8], a0[8], kkw[8], kaw[8], rkw[8];
#pragma unroll
    for (int i = 0; i < 8; ++i) { w0[i] = A->rw_w0[c8 + i]; a0[i] = A->rw_a0[c8 + i]; kkw[i] = A->rw_k_k[c8 + i]; kaw[i] = A->rw_k_a[c8 + i]; rkw[i] = A->rw_r_k[c8 + i]; }
    for (int t = gw; t < T; t += NGW) {
        const size_t o = (size_t)t * RWW + c8;
        const v4u lwp = *(const v4u*)(LW + o), lap = *(const v4u*)(LA2 + o);
        const float lw[8] = {bflo(lwp.x), bfhi(lwp.x), bflo(lwp.y), bfhi(lwp.y), bflo(lwp.z), bfhi(lwp.z), bflo(lwp.w), bfhi(lwp.w)};
        const float la[8] = {bflo(lap.x), bfhi(lap.x), bflo(lap.y), bfhi(lap.y), bflo(lap.z), bfhi(lap.z), bflo(lap.w), bfhi(lap.w)};
        const f32x4 k0 = *(const f32x4*)(VEC + 2 * SL + o), k1 = *(const f32x4*)(VEC + 2 * SL + o + 4);
        const f32x4 r0 = *(const f32x4*)(VEC + o), r1 = *(const f32x4*)(VEC + o + 4);
        const float ks[8] = {k0[0], k0[1], k0[2], k0[3], k1[0], k1[1], k1[2], k1[3]}, rr[8] = {r0[0], r0[1], r0[2], r0[3], r1[0], r1[1], r1[2], r1[3]};
        float dec[8], av[8], kk[8], km[8]; float ss = 0.f, bsum = 0.f;
#pragma unroll
        for (int i = 0; i < 8; ++i) {
            const float u = -(w0[i] + lw[i]);
            const float sp = fmaxf(u, 0.f) + log1pf(__expf(-fabsf(u)));
            dec[i] = __expf(-__expf(-sp - 0.5f));
            av[i] = sigmoidf_(a0[i] + la[i]);
            kk[i] = ks[i] * kkw[i]; ss += kk[i] * kk[i];
            km[i] = ks[i] * (1.0f + (av[i] - 1.0f) * kaw[i]);
            bsum += rr[i] * km[i] * rkw[i];
        }
        ss += __shfl_xor(ss, 1); ss += __shfl_xor(ss, 2); ss += __shfl_xor(ss, 4);
        bsum += __shfl_xor(bsum, 1); bsum += __shfl_xor(bsum, 2); bsum += __shfl_xor(bsum, 4);
        const float rn = 1.0f / fmaxf(sqrtf(ss), 1e-12f);
        f32x4 o0, o1;
#pragma unroll
        for (int i = 0; i < 8; ++i) kk[i] *= rn;
        o0 = (f32x4){dec[0], dec[1], dec[2], dec[3]}; o1 = (f32x4){dec[4], dec[5], dec[6], dec[7]}; *(f32x4*)(VEC + 1 * SL + o) = o0; *(f32x4*)(VEC + 1 * SL + o + 4) = o1;
        o0 = (f32x4){km[0], km[1], km[2], km[3]}; o1 = (f32x4){km[4], km[5], km[6], km[7]}; *(f32x4*)(VEC + 2 * SL + o) = o0; *(f32x4*)(VEC + 2 * SL + o + 4) = o1;
        o0 = (f32x4){kk[0], kk[1], kk[2], kk[3]}; o1 = (f32x4){kk[4], kk[5], kk[6], kk[7]}; *(f32x4*)(VEC + 3 * SL + o) = o0; *(f32x4*)(VEC + 3 * SL + o + 4) = o1;
        o0 = (f32x4){kk[0] * av[0], kk[1] * av[1], kk[2] * av[2], kk[3] * av[3]}; o1 = (f32x4){kk[4] * av[4], kk[5] * av[5], kk[6] * av[6], kk[7] * av[7]}; *(f32x4*)(VEC + 4 * SL + o) = o0; *(f32x4*)(VEC + 4 * SL + o + 4) = o1;
        if ((lane & 7) == 0) BS[(size_t)t * 8 + (lane >> 3)] = bsum;
    }
}

__device__ __forceinline__ float quad_xor1(float v) { return __builtin_bit_cast(float, __builtin_amdgcn_update_dpp(0, __builtin_bit_cast(int, v), 0xB1, 0xF, 0xF, true)); }
__device__ __forceinline__ float quad_xor2(float v) { return __builtin_bit_cast(float, __builtin_amdgcn_update_dpp(0, __builtin_bit_cast(int, v), 0x4E, 0xF, 0xF, true)); }
__device__ __forceinline__ void scan_phase(const Frame& F, KArgs A, int bh) {
    constexpr int TC = 64;
    LAS float* L = (LAS float*)(F.lds + RING_OFF);
    LAS float* yb = L + 6 * TC * 64;
    const float* VEC = (const float*)(A->ws + WS_VEC); float* YB = (float*)(A->ws + WS_YB);
    const size_t SL = (size_t)T * RWW;
    const int b = bh >> 3, h = bh & 7, tid = F.tid, row = tid >> 2, q = tid & 3;
    const size_t rowbase = (size_t)b * SEQ;
    float S[16];
#pragma unroll
    for (int j = 0; j < 16; ++j) S[j] = 0.f;
    for (int ch = 0; ch < SEQ / TC; ++ch) {
#pragma unroll
        for (int i = 0; i < 12; ++i) { const int idx4 = tid + 512 * i, vi = idx4 >> 10, rem = idx4 & 1023, ts = rem >> 4, k4 = rem & 15;
            const f32x4 v = *(const f32x4*)(VEC + vi * SL + (rowbase + ch * TC + ts) * RWW + h * 64 + k4 * 4);
            *(LAS f32x4*)(L + vi * TC * 64 + ts * 64 + k4 * 4) = v; }
        __syncthreads();
        if (tid < 256) {
            for (int ts = 0; ts < TC; ++ts) {
                const LAS float* base = L + ts * 64 + q * 16;
                float sa = 0.f;
#pragma unroll
                for (int j = 0; j < 4; ++j) { const f32x4 kk = *(const LAS f32x4*)(base + 3 * TC * 64 + 4 * j);
                    sa += S[4 * j] * kk[0]; sa += S[4 * j + 1] * kk[1]; sa += S[4 * j + 2] * kk[2]; sa += S[4 * j + 3] * kk[3]; }
                sa += quad_xor1(sa); sa += quad_xor2(sa);
                const float vt = L[5 * TC * 64 + ts * 64 + row];
                float y = 0.f;
#pragma unroll
                for (int j = 0; j < 4; ++j) {
                    const f32x4 w = *(const LAS f32x4*)(base + 1 * TC * 64 + 4 * j), km = *(const LAS f32x4*)(base + 2 * TC * 64 + 4 * j);
                    const f32x4 ka = *(const LAS f32x4*)(base + 4 * TC * 64 + 4 * j), rr = *(const LAS f32x4*)(base + 4 * j);
#pragma unroll
                    for (int i = 0; i < 4; ++i) { const float sn = S[4 * j + i] * w[i] + (vt * km[i] - sa * ka[i]); S[4 * j + i] = sn; y += sn * rr[i]; }
                }
                y += quad_xor1(y); y += quad_xor2(y);
                if (q == 0) yb[ts * 64 + row] = y;
            }
        }
        __syncthreads();
#pragma unroll
        for (int i = 0; i < 2; ++i) { const int idx4 = tid + 512 * i, ts = idx4 >> 4, k4 = idx4 & 15;
            *(f32x4*)(YB + (rowbase + ch * TC + ts) * RWW + h * 64 + k4 * 4) = *(const LAS f32x4*)(yb + ts * 64 + k4 * 4); }
    }
    __syncthreads();
}
__device__ __forceinline__ void attn_cu(const Frame& F, KArgs A, int a, int NA) {
    const attn_body::bf16* PB = (const attn_body::bf16*)(A->ws + WS_PB); attn_body::bf16* OA = (attn_body::bf16*)(A->ws + WS_XN);
    char* shm = (char*)(F.lds + RING_OFF);
    for (int i = 0; ; ++i) {
        const int p = a + NA * (i >> 1); if (p >= 1024) break;
        const int cb = p >> 4, s = p & 15, b = cb >> 4, h = (cb >> 2) & 3, c = (cb >> 1) & 1, vh = cb & 1, qb = (i & 1) ? s : 31 - s;
        const attn_body::bf16* Q = PB + h * 128 + c * 64; const attn_body::bf16* K = PB + 512 + h * 128 + c * 64; const attn_body::bf16* V = PB + 1024 + h * 128 + vh * 64;
        attn_body::bf16* O = OA + h * 256 + c * 128 + vh * 64;
        attn_body::attn_unit<8>(b, qb, Q, K, V, O, shm);
    }
}

__device__ __forceinline__ void p6_combine(const Frame& F, KArgs A) {
    unsigned char* ws = A->ws;
    const bf16* OA = (const bf16*)(ws + WS_XN); const float* YB = (const float*)(ws + WS_YB); const bf16* LG = (const bf16*)(ws + WS_LG);
    const float* V_V = (const float*)(ws + WS_VEC) + 5 * (size_t)T * RWW; const float* BS = (const float*)(ws + WS_BS);
    bf16* AO = (bf16*)(ws + WS_AO);
    const int gw = F.vcu * NWAVES + F.wave, NGW = F.G * NWAVES, lane = F.lane;
    const float lam = __expf(wave_sum(A->lq1[lane] * A->lk1[lane])) - __expf(wave_sum(A->lq2[lane] * A->lk2[lane])) + LAM_INIT;
    const int hd = lane >> 4, dv = (lane & 15) * 8, c8 = lane * 8, hr = lane >> 3;
    float sw[8], lw[8], lb[8];
#pragma unroll
    for (int i = 0; i < 8; ++i) { sw[i] = A->subln_w[dv + i] * (1.0f - LAM_INIT); lw[i] = A->rw_lnx_w[c8 + i]; lb[i] = A->rw_lnx_b[c8 + i]; }
    for (int t = gw; t < T; t += NGW) {
        const v4u p0 = *(const v4u*)(OA + (size_t)t * 1024 + hd * 256 + dv), p1 = *(const v4u*)(OA + (size_t)t * 1024 + hd * 256 + 128 + dv);
        const float o0[8] = {bflo(p0.x), bfhi(p0.x), bflo(p0.y), bfhi(p0.y), bflo(p0.z), bfhi(p0.z), bflo(p0.w), bfhi(p0.w)};
        const float o1[8] = {bflo(p1.x), bfhi(p1.x), bflo(p1.y), bfhi(p1.y), bflo(p1.z), bfhi(p1.z), bflo(p1.w), bfhi(p1.w)};
        float d[8]; float ss = 0.f;
#pragma unroll
        for (int i = 0; i < 8; ++i) { d[i] = o0[i] - lam * o1[i]; ss += d[i] * d[i]; }
        ss += __shfl_xor(ss, 1); ss += __shfl_xor(ss, 2); ss += __shfl_xor(ss, 4); ss += __shfl_xor(ss, 8);
        const float rs = 1.0f / sqrtf(ss * (1.0f / 128.0f) + NORM_EPS);
        v4u w; w.x = pk2(d[0] * rs * sw[0], d[1] * rs * sw[1]); w.y = pk2(d[2] * rs * sw[2], d[3] * rs * sw[3]); w.z = pk2(d[4] * rs * sw[4], d[5] * rs * sw[5]); w.w = pk2(d[6] * rs * sw[6], d[7] * rs * sw[7]);
        *(v4u*)(AO + (size_t)t * 1024 + hd * 128 + dv) = w;
        const size_t o = (size_t)t * RWW + c8;
        const f32x4 y0 = *(const f32x4*)(YB + o), y1 = *(const f32x4*)(YB + o + 4), v0 = *(const f32x4*)(V_V + o), v1 = *(const f32x4*)(V_V + o + 4);
        const v4u gp = *(const v4u*)(LG + o);
        const float g[8] = {bflo(gp.x), bfhi(gp.x), bflo(gp.y), bfhi(gp.y), bflo(gp.z), bfhi(gp.z), bflo(gp.w), bfhi(gp.w)};
        const float y[8] = {y0[0], y0[1], y0[2], y0[3], y1[0], y1[1], y1[2], y1[3]}, vv[8] = {v0[0], v0[1], v0[2], v0[3], v1[0], v1[1], v1[2], v1[3]};
        float sm = 0.f;
#pragma unroll
        for (int i = 0; i < 8; ++i) sm += y[i];
        sm += __shfl_xor(sm, 1); sm += __shfl_xor(sm, 2); sm += __shfl_xor(sm, 4);
        const float mean = sm * (1.0f / 64.0f); float sq = 0.f;
#pragma unroll
        for (int i = 0; i < 8; ++i) { const float dd = y[i] - mean; sq += dd * dd; }
        sq += __shfl_xor(sq, 1); sq += __shfl_xor(sq, 2); sq += __shfl_xor(sq, 4);
        const float rg = 1.0f / sqrtf(sq * (1.0f / 64.0f) + GN_EPS), bsc = BS[(size_t)t * 8 + hr];
        float r[8];
#pragma unroll
        for (int i = 0; i < 8; ++i) r[i] = ((y[i] - mean) * rg * lw[i] + lb[i] + bsc * vv[i]) * g[i];
        w.x = pk2(r[0], r[1]); w.y = pk2(r[2], r[3]); w.z = pk2(r[4], r[5]); w.w = pk2(r[6], r[7]);
        *(v4u*)(AO + (size_t)t * 1024 + 512 + c8) = w;
    }
}

__device__ __forceinline__ void p8_router(const Frame& F, KArgs A, gu32* ctl) {
    unsigned char* ws = A->ws;
    const float* X1 = (const float*)(ws + WS_X1); const float* RWS = (const float*)(ws + WS_RWS); bf16* H2 = (bf16*)(ws + WS_H2);
    int* TOPI = (int*)(ws + WS_TOPI); int* POS = (int*)(ws + WS_POS); float* GATE = (float*)(ws + WS_GATE);
    LAS int* hist = (LAS int*)(F.lds + HIST_OFF); LAS int* hbase = (LAS int*)(F.lds + HBASE_OFF);
    const int lane = F.lane, tile = F.wave * F.G + F.vcu;
    const bool has = tile < T / 32;
    const int r0 = tile * 32, hi = lane >> 5, l31 = lane & 31;
    int sel[4] = {0, 0, 0, 0}, lr[4] = {0, 0, 0, 0}; float gate[4] = {0.f, 0.f, 0.f, 0.f}; float rstd = 0.f;
    if (has) {
        f32x16 acc;
#pragma unroll
        for (int r = 0; r < 16; ++r) acc[r] = 0.f;
        float ssq = 0.f;
        const float* xa = X1 + (size_t)(r0 + l31) * D + 4 * hi; const float* wb = RWS + hi * 128 + l31;
#pragma unroll 2
        for (int m = 0; m < 128; ++m) {
            const f32x4 a = *(const f32x4*)(xa + 8 * m);
            const float b0 = wb[(8 * m) * 32], b1 = wb[(8 * m + 1) * 32], b2 = wb[(8 * m + 2) * 32], b3 = wb[(8 * m + 3) * 32];
            ssq += (a[0] * a[0] + a[1] * a[1]) + (a[2] * a[2] + a[3] * a[3]);
            acc = __builtin_amdgcn_mfma_f32_32x32x2f32(a[0], b0, acc, 0, 0, 0); acc = __builtin_amdgcn_mfma_f32_32x32x2f32(a[1], b1, acc, 0, 0, 0);
            acc = __builtin_amdgcn_mfma_f32_32x32x2f32(a[2], b2, acc, 0, 0, 0); acc = __builtin_amdgcn_mfma_f32_32x32x2f32(a[3], b3, acc, 0, 0, 0);
        }
        ssq += __shfl_xor(ssq, 32);
        rstd = 1.0f / sqrtf(ssq * (1.0f / D) + NORM_EPS);
        LAS float* Lw = (LAS float*)(F.lds + RING_OFF + F.wave * 4608);
#pragma unroll
        for (int r = 0; r < 16; ++r) Lw[((r & 3) + 8 * (r >> 2) + 4 * hi) * 36 + l31] = acc[r];
        LDS_WAIT(); asm volatile("" ::: "memory");
        if (lane < 32) {
            float val[32];
#pragma unroll
            for (int j = 0; j < 8; ++j) { const f32x4 q = *(const LAS f32x4*)(Lw + lane * 36 + 4 * j); const f32x4 bb = *(const f32x4*)(A->router_b + 4 * j);
                val[4 * j] = q[0] * rstd + bb[0]; val[4 * j + 1] = q[1] * rstd + bb[1]; val[4 * j + 2] = q[2] * rstd + bb[2]; val[4 * j + 3] = q[3] * rstd + bb[3]; }
            unsigned used = 0u; float sv[4];
#pragma unroll
            for (int s = 0; s < 4; ++s) { float best = -INFINITY; int bi = 0;
#pragma unroll
                for (int e = 0; e < 32; ++e) { const bool ok = (((used >> e) & 1u) == 0u) && (val[e] > best); best = ok ? val[e] : best; bi = ok ? e : bi; }
                used |= 1u << bi; sel[s] = bi; sv[s] = best; }
            float ex[4], se = 0.f;
#pragma unroll
            for (int s = 0; s < 4; ++s) { ex[s] = __expf(sv[s] - sv[0]); se += ex[s]; }
            const float inv = 1.0f / se;
#pragma unroll
            for (int s = 0; s < 4; ++s) { gate[s] = ex[s] * inv; lr[s] = __hip_atomic_fetch_add(hist + sel[s], 1, __ATOMIC_RELAXED, __HIP_MEMORY_SCOPE_WORKGROUP); }
        }
    }
    __syncthreads();
    if (F.tid < NEXP) hbase[F.tid] = (int)__hip_atomic_fetch_add(ctl + CW_CNT + F.tid, (unsigned)hist[F.tid], __ATOMIC_RELAXED, __HIP_MEMORY_SCOPE_AGENT);
    __syncthreads();
    if (has) {
        if (lane < 32) { const size_t t4 = (size_t)(r0 + lane) * 4;
#pragma unroll
            for (int s = 0; s < 4; ++s) { TOPI[t4 + s] = sel[s]; POS[t4 + s] = hbase[sel[s]] + lr[s]; GATE[t4 + s] = gate[s]; } }
        f32x4 nw[4];
#pragma unroll
        for (int j = 0; j < 4; ++j) nw[j] = *((const f32x4*)A->ffn_norm_w + lane + 64 * j);
        for (int rr = 0; rr < 32; ++rr) {
            const float rs = __builtin_bit_cast(float, __builtin_amdgcn_readlane(__builtin_bit_cast(int, rstd), rr));
            const f32x4* xr = (const f32x4*)(X1 + (size_t)(r0 + rr) * D) + lane;
            unsigned long long* o8 = (unsigned long long*)(H2 + (size_t)(r0 + rr) * D) + lane;
#pragma unroll
            for (int j = 0; j < 4; ++j) { const f32x4 v = xr[64 * j];
                o8[64 * j] = (unsigned long long)pk2(v[0] * rs * nw[j][0], v[1] * rs * nw[j][1]) | ((unsigned long long)pk2(v[2] * rs * nw[j][2], v[3] * rs * nw[j][3]) << 32); }
        }
    }
}

__device__ __forceinline__ void moe_tables(const Frame& F, gu32* ctl) {
    LAS int* pst = (LAS int*)(F.lds + PST_OFF); LAS int* te = (LAS int*)(F.lds + TILE_OFF);
    __syncthreads();
    if (F.tid == 0) { int acc = 0;
        for (int e = 0; e < NEXP; ++e) { pst[e] = acc; const int c = (int)__hip_atomic_load(ctl + CW_CNT + e, __ATOMIC_RELAXED, __HIP_MEMORY_SCOPE_AGENT); acc += ((c + 255) >> 8) << 8; }
        pst[32] = acc; pst[33] = acc >> 8; }
    __syncthreads();
    if (F.tid < NEXP) { for (int tl = pst[F.tid] >> 8; tl < (pst[F.tid + 1] >> 8); ++tl) te[tl] = F.tid; }
    __syncthreads();
}

__device__ __forceinline__ void p9_gather(const Frame& F, KArgs A) {
    unsigned char* ws = A->ws;
    const bf16* H2 = (const bf16*)(ws + WS_H2); bf16* XS = (bf16*)(ws + WS_XS);
    const int* TOPI = (const int*)(ws + WS_TOPI); const int* POS = (const int*)(ws + WS_POS); const float* GATE = (const float*)(ws + WS_GATE);
    int* RDEST = (int*)(ws + WS_RDEST); float* RGATE = (float*)(ws + WS_RGATE);
    const LAS int* pst = (const LAS int*)(F.lds + PST_OFF);
    const int gw = F.vcu * NWAVES + F.wave, NGW = F.G * NWAVES, lane = F.lane;
    for (int idx = gw; idx < T * TOPK; idx += NGW) {
        const int t = idx >> 2, e = TOPI[idx], dest = pst[e] + POS[idx];
        const v4u* src = (const v4u*)(H2 + (size_t)t * D); v4u* dst = (v4u*)(XS + (size_t)dest * D);
        const v4u a = src[lane], b = src[lane + 64]; dst[lane] = a; dst[lane + 64] = b;
        if (lane == 0) { RDEST[dest] = idx; RGATE[dest] = GATE[idx]; }
    }
}

__device__ __forceinline__ void p12_final(const Frame& F, KArgs A) {
    unsigned char* ws = A->ws;
    const float* X1 = (const float*)(ws + WS_X1); const bf16* YS = (const bf16*)(ws + WS_YS);
    const int gw = F.vcu * NWAVES + F.wave, NGW = F.G * NWAVES, lane = F.lane;
    f32x4 nw[4];
#pragma unroll
    for (int j = 0; j < 4; ++j) nw[j] = *((const f32x4*)A->final_norm_w + lane + 64 * j);
    for (int t = gw; t < T; t += NGW) {
        f32x4 v[4]; float ss = 0.f;
#pragma unroll
        for (int j = 0; j < 4; ++j) v[j] = *((const f32x4*)(X1 + (size_t)t * D) + lane + 64 * j);
#pragma unroll
        for (int s = 0; s < 4; ++s) { const u32x2* yr = (const u32x2*)(YS + ((size_t)t * 4 + s) * D) + lane;
#pragma unroll
            for (int j = 0; j < 4; ++j) { const u32x2 p = yr[64 * j]; v[j][0] += bflo(p.x); v[j][1] += bfhi(p.x); v[j][2] += bflo(p.y); v[j][3] += bfhi(p.y); } }
#pragma unroll
        for (int j = 0; j < 4; ++j) ss += (v[j][0] * v[j][0] + v[j][1] * v[j][1]) + (v[j][2] * v[j][2] + v[j][3] * v[j][3]);
        const float rs = 1.0f / sqrtf(wave_sum(ss) * (1.0f / D) + NORM_EPS);
#pragma unroll
        for (int j = 0; j < 4; ++j) *((f32x4*)(A->out + (size_t)t * D) + lane + 64 * j) = v[j] * rs * nw[j];
    }
}
#ifndef MK_N_LAUNCHES
#define MK_N_LAUNCHES 1
#endif
constexpr int N_PHASES = 13;
__global__ void __launch_bounds__(NWAVES * 64, 2) mk_fwd(Args A_by_value_unused) {
    extern __shared__ __attribute__((aligned(16))) unsigned char lds[];
    Frame F;
    F.lds = (LAS unsigned char*)lds;
    volatile LAS unsigned* MISC = (volatile LAS unsigned*)(F.lds + MISC_OFF);
    F.tid = threadIdx.x; F.lane = F.tid & 63; F.wave = __builtin_amdgcn_readfirstlane(F.tid >> 6);
    F.G = gridDim.x; { const int bx = blockIdx.x; F.vcu = (F.G % 8 == 0) ? (bx % 8) * (F.G / 8) + bx / 8 : bx; }
    unsigned char* ws = get_args()->ws;
    gu32* ctl = (gu32*)(ws + WS_CTL);
    for (int u = F.tid; u < (LDS_BYTES - LDSCTL_OFF) / 4; u += NWAVES * 64) ((LAS unsigned*)(F.lds + LDSCTL_OFF))[u] = 0u;
    __syncthreads();
    XcdBarrier bar = xcd_barrier_post((unsigned*)(ctl + CW_BAR), MISC + 8);
    const int lo = get_args()->ph_lo, hi = get_args()->ph_hi;
#define IN(k) (lo <= (k) && (k) < hi)
#define SEAM(k) do { if (IN(k) && IN((k) + 1)) xcd_barrier(bar); } while (0)
    bf16* XN = (bf16*)(ws + WS_XN); bf16* PB = (bf16*)(ws + WS_PB);

    if (IN(0)) { p0_prologue(F, get_args()); SEAM(0); }
    if (IN(1)) {
        pg8::Gemm g{XN, (const bf16*)(ws + WS_WIN), T, IN_COLS, D}; pg8::StaticOrder S; S.init(T, IN_COLS, F.G, (int)blockIdx.x);
        pg8::EpiBf16<0> E{PB, IN_COLS, nullptr, 0, 0, 1.f};
        pg8::gemm_phase<pg8::EpiBf16<0>, pg8::StaticOrder, PG8_ALIGN, PG8_SP2>(F.lds + RING_OFF, g, S, E);
        SEAM(1);
    }
    if (IN(2)) { p2_prep(F, get_args()); SEAM(2); }
    if (IN(3)) {
        pg8::Gemm g{(const bf16*)(ws + WS_XN), (const bf16*)(ws + WS_WL), T, 1536, 256}; pg8::StaticOrder S; S.init(T, 1536, F.G, (int)blockIdx.x);
        pg8::EpiBf16<0> E{(bf16*)(ws + WS_LW), RWW, nullptr, RWW, (size_t)T * RWW, 1.f};
        pg8::gemm_phase<pg8::EpiBf16<0>, pg8::StaticOrder, PG8_ALIGN, PG8_SP2>(F.lds + RING_OFF, g, S, E);
        SEAM(3);
    }
    if (IN(4)) { p4_prep(F, get_args()); SEAM(4); }
    if (IN(5)) {
        constexpr int NS = BATCH * 8;
        if ((F.vcu & 7) == 0 && (F.vcu >> 3) < NS) scan_phase(F, get_args(), F.vcu >> 3);
        else { const int below = ((F.vcu + 7) >> 3) < NS ? ((F.vcu + 7) >> 3) : NS; attn_cu(F, get_args(), F.vcu - below, F.G - NS); }
        SEAM(5);
    }
    if (IN(6)) { p6_combine(F, get_args()); SEAM(6); }
    if (IN(7)) {
        pg8::Gemm g{(const bf16*)(ws + WS_AO), (const bf16*)(ws + WS_WO), T, D, D}; pg8::StaticOrder S; S.init(T, D, F.G, (int)blockIdx.x);
        pg8::EpiResF32 E{get_args()->x, (float*)(ws + WS_X1), D};
        pg8::gemm_phase<pg8::EpiResF32, pg8::StaticOrder, PG8_ALIGN, PG8_SP2>(F.lds + RING_OFF, g, S, E);
        SEAM(7);
    }
    if (IN(8)) { p8_router(F, get_args(), ctl); SEAM(8); }
    if (IN(9)) { moe_tables(F, ctl); p9_gather(F, get_args()); SEAM(9); }
    if (IN(10)) {
        moe_tables(F, ctl);
        const LAS int* pst = (const LAS int*)(F.lds + PST_OFF);
        pg8::Gemm g{(const bf16*)(ws + WS_XS), (const bf16*)(ws + WS_W1), P_MAX, NEXP * 2048, D};
        pg8::MoeOrder<8> S{pst[33], (int)blockIdx.x, F.G, (const LAS int*)(F.lds + TILE_OFF)};
        pg8::EpiSwiglu E{(bf16*)(ws + WS_ACT), get_args()->mlp1_b};
        pg8::gemm_phase<pg8::EpiSwiglu, pg8::MoeOrder<8>, PG8_ALIGN, PG8_SP2>(F.lds + RING_OFF, g, S, E);
        SEAM(10);
    }
    if (IN(11)) {
        moe_tables(F, ctl);
        const LAS int* pst = (const LAS int*)(F.lds + PST_OFF);
        pg8::Gemm g{(const bf16*)(ws + WS_ACT), (const bf16*)(ws + WS_W2), P_MAX, NEXP * D, D};
        pg8::MoeOrder<4> S{pst[33], (int)blockIdx.x, F.G, (const LAS int*)(F.lds + TILE_OFF)};
        pg8::EpiMoeOut E{(bf16*)(ws + WS_YS), get_args()->mlp2_b, (const int*)(ws + WS_RDEST), (const float*)(ws + WS_RGATE)};
        pg8::gemm_phase<pg8::EpiMoeOut, pg8::MoeOrder<4>, PG8_ALIGN, PG8_SP2>(F.lds + RING_OFF, g, S, E);
        SEAM(11);
    }
    if (IN(12)) { p12_final(F, get_args()); }
#undef IN
#undef SEAM
}

extern "C" void kernel_launch(void* const* d_in, const int* in_sizes, int n_in, void* d_out, int out_size, void* d_ws, size_t ws_size, hipStream_t stream) {
    static int grid = 0;
    if (grid == 0) {
        if (n_in != 29 || in_sizes[0] != T * D || out_size != T * D || ws_size < WS_END) { fprintf(stderr, "kernel_launch: built for 29 inputs, x/out of %d floats, >= %zu bytes of workspace; got n_in %d, in0 %d, out %d, ws %zu; nothing launched\n", T * D, (size_t)WS_END, n_in, n_in > 0 ? in_sizes[0] : -1, out_size, ws_size); grid = -1; return; }
        int dev = 0, cus = 0, per_cu = 0;
        if (hipGetDevice(&dev) != hipSuccess || hipDeviceGetAttribute(&cus, hipDeviceAttributeMultiprocessorCount, dev) != hipSuccess) { fprintf(stderr, "kernel_launch: device query failed\n"); grid = -1; return; }
        if (hipFuncSetAttribute((const void*)mk_fwd, hipFuncAttributeMaxDynamicSharedMemorySize, LDS_BYTES) != hipSuccess) { fprintf(stderr, "kernel_launch: hipFuncSetAttribute failed\n"); grid = -1; return; }
        if (hipOccupancyMaxActiveBlocksPerMultiprocessor(&per_cu, (const void*)mk_fwd, NWAVES * 64, LDS_BYTES) != hipSuccess || per_cu < 1)
            fprintf(stderr, "kernel_launch: note: occupancy query reports %d workgroups per CU\n", per_cu);
        (void)hipGetLastError();
        grid = cus;
        if (grid != 256) { fprintf(stderr, "kernel_launch: %d CUs; this kernel is built for 256; nothing launched\n", grid); grid = -1; return; }
    }
    if (grid < 0) return;
    if (hipMemsetAsync((char*)d_ws + WS_CTL, 0, CTL_ZERO_BYTES, stream) != hipSuccess) { fprintf(stderr, "kernel_launch: hipMemsetAsync failed\n"); return; }
    Args a{};
    a.x = (const float*)d_in[0]; a.positions = (const int*)d_in[1]; a.attn_norm_w = (const float*)d_in[2]; a.w_in = (const float*)d_in[3]; a.shift_mu = (const float*)d_in[4];
    a.lq1 = (const float*)d_in[5]; a.lk1 = (const float*)d_in[6]; a.lq2 = (const float*)d_in[7]; a.lk2 = (const float*)d_in[8]; a.subln_w = (const float*)d_in[9];
    a.rw_w0 = (const float*)d_in[10]; a.rw_w2 = (const float*)d_in[11]; a.rw_a0 = (const float*)d_in[12]; a.rw_a2 = (const float*)d_in[13]; a.rw_g2 = (const float*)d_in[14];
    a.rw_k_k = (const float*)d_in[15]; a.rw_k_a = (const float*)d_in[16]; a.rw_r_k = (const float*)d_in[17]; a.rw_lnx_w = (const float*)d_in[18]; a.rw_lnx_b = (const float*)d_in[19];
    a.w_out = (const float*)d_in[20]; a.ffn_norm_w = (const float*)d_in[21]; a.router_w = (const float*)d_in[22]; a.router_b = (const float*)d_in[23];
    a.mlp1_w = (const float*)d_in[24]; a.mlp1_b = (const float*)d_in[25]; a.mlp2_w = (const float*)d_in[26]; a.mlp2_b = (const float*)d_in[27]; a.final_norm_w = (const float*)d_in[28];
    a.out = (float*)d_out; a.ws = (unsigned char*)d_ws;
    if (MK_N_LAUNCHES == 1) { a.ph_lo = 0; a.ph_hi = N_PHASES; hipLaunchKernelGGL(mk_fwd, dim3(grid), dim3(NWAVES * 64), LDS_BYTES, stream, a); }
    else for (int p = 0; p < N_PHASES; ++p) { a.ph_lo = p; a.ph_hi = p + 1; hipLaunchKernelGGL(mk_fwd, dim3(grid), dim3(NWAVES * 64), LDS_BYTES, stream, a); }
    const hipError_t le = hipPeekAtLastError();
    if (le != hipSuccess) fprintf(stderr, "kernel_launch: launch failed: %s\n", hipGetErrorName(le));
}
```

```cpp
#include <hip/hip_runtime.h>
#include <cstdio>
#include <cstdint>
namespace pg8 {
#define PG8_LAS __attribute__((address_space(3)))
typedef unsigned short bf16_t;
typedef short bf16x8 __attribute__((ext_vector_type(8)));
typedef float f32x4 __attribute__((ext_vector_type(4)));
typedef unsigned u32x4 __attribute__((ext_vector_type(4)));
typedef int i32x4 __attribute__((ext_vector_type(4)));
typedef int i32x8 __attribute__((ext_vector_type(8)));
constexpr int BM = 256, BK = 64, HALF = 128, HTB = HALF * BK * 2  , STAGE_BYTES = 8 * HTB, NXCD = 8, WGM = 8;

__host__ __device__ __forceinline__ int lds_byte(int r, int c) { const int st = (r >> 4) * 2 + (c >> 5), rr = r & 15, cc = c & 31, ob = rr * 64 + cc * 2; return st * 1024 + (ob ^ (((ob >> 9) & 1) << 5)); }
__host__ __device__ __forceinline__ void stage_rc(int b, int& R, int& C) { const int st = b / 1024, sb = b % 1024, swz = sb ^ (((sb >> 9) & 1) << 5); R = (st >> 1) * 16 + swz / 64; C = (st & 1) * 32 + (swz % 64) / 2; }
__host__ __device__ __forceinline__ int perm32(int rho) { const int n = rho >> 4, i = rho & 15; return 8 * (i >> 2) + 4 * n + (i & 3); }

struct Unit { int pm, pn; };
struct Gemm { const bf16_t* A; const bf16_t* Bt; int M, N, K; const int* rows; };

struct StaticOrder {
    int nM, nN, nwg, G, c;
    __host__ __device__ void init(int M, int N, int G_, int c_) { nM = M / BM; nN = N / BM; nwg = nM * nN; G = G_; c = c_; }
    __host__ __device__ bool next(int i, Unit& u) const {
        const long L = (long)i * G + c; if (L >= nwg) return false;
        int wgid = (int)L; { const int q = nwg / NXCD, r = nwg % NXCD, xcd = wgid % NXCD, off = wgid / NXCD; wgid = (xcd < r ? xcd * (q + 1) : r * (q + 1) + (xcd - r) * q) + off; }
        const int nig = WGM * nN, gid = wgid / nig, fm = gid * WGM, gsz = (nM - fm) < WGM ? (nM - fm) : WGM;
        u.pm = fm + ((wgid % nig) % gsz); u.pn = (wgid % nig) / gsz; return true;
    }
    __device__ __forceinline__ void a_ready(const Unit&) const {}
    __device__ __forceinline__ void done(const Unit&) const {}
};

__device__ __forceinline__ unsigned pk_fp8x4(float a, float b, float c, float d) { int w = __builtin_amdgcn_cvt_pk_fp8_f32(a, b, 0, false); w = __builtin_amdgcn_cvt_pk_fp8_f32(c, d, w, true); return (unsigned)w; }
constexpr float MOE_WSCALE = 32.0f, MOE_WSCALE_INV = 1.0f / 32.0f;
constexpr float MOE_YSCALE = 16.0f, MOE_YSCALE_INV = 1.0f / 16.0f;
__device__ __forceinline__ unsigned cvt_pk_bf16(float lo, float hi) { unsigned r; asm volatile("v_cvt_pk_bf16_f32 %0, %1, %2" : "=v"(r) : "v"(lo), "v"(hi)); return r; }
typedef float f32x2 __attribute__((ext_vector_type(2)));
__device__ __forceinline__ f32x2 gelu_pk(f32x2 v) {
    const f32x2 av = __builtin_elementwise_abs(v), d = av * 0.2316418882f + 1.0f;
    f32x2 t; t.x = __builtin_amdgcn_rcpf(d.x); t.y = __builtin_amdgcn_rcpf(d.y);
    f32x2 q = t * 0.5307027145f + (-0.7265760135f); q = q * t + 0.7107068705f; q = q * t + (-0.142248368f); q = q * t + 0.127414796f; q = q * t;
    const f32x2 s = (v * v) * (-0.72134752044f);
    f32x2 e; e.x = __builtin_amdgcn_exp2f(s.x); e.y = __builtin_amdgcn_exp2f(s.y);
    const f32x2 m = v * (q * e), r = v - m;
    f32x2 o; o.x = v.x < 0.f ? m.x : r.x; o.y = v.y < 0.f ? m.y : r.y; return o;
}

template <int ACT  > struct EpiBf16 {
    static constexpr bool PERM = true, AFTER_DRAIN = false, PERM16 = false, HAS_PRE = false; static_assert(ACT == 0 || ACT == 1, "EpiBf16: ACT is 0 (none) or 1 (gelu_pk)");
    bf16_t* O; int ldc; const float* bias; int split_cols; size_t split_stride; float scale0;
    __device__ __forceinline__ void operator()(const f32x4 (&acc)[2][2][4][2], const Unit& u, int wr, int wc, int fr, int fq) const {
        const int row0 = u.pm * BM + wr * 64 + fr; int colt = u.pn * BM; bf16_t* base = O;
        float sc = 1.f; if (split_cols) { const int t = colt / split_cols; base += (size_t)t * split_stride; colt -= t * split_cols; if (t == 0) sc = scale0; }
        const int col0 = colt + wc * 32 + 8 * fq, bcol0 = u.pn * BM + wc * 32 + 8 * fq;
        f32x4 bv[2][2];
#pragma unroll
        for (int bj = 0; bj < 2; ++bj)
#pragma unroll
            for (int n = 0; n < 2; ++n) bv[bj][n] = bias ? *(const f32x4*)(bias + bcol0 + bj * HALF + 4 * n) : (f32x4){0.f, 0.f, 0.f, 0.f};
#pragma unroll
        for (int ai = 0; ai < 2; ++ai)
#pragma unroll
            for (int m = 0; m < 4; ++m) { bf16_t* rowp = base + (size_t)(row0 + ai * HALF + m * 16) * ldc + col0;
#pragma unroll
                for (int bj = 0; bj < 2; ++bj) { f32x4 v0 = acc[ai][bj][m][0] + bv[bj][0], v1 = acc[ai][bj][m][1] + bv[bj][1];
                    if (ACT == 1) { f32x2 a = gelu_pk((f32x2){v0[0], v0[1]}), b = gelu_pk((f32x2){v0[2], v0[3]}), c = gelu_pk((f32x2){v1[0], v1[1]}), d = gelu_pk((f32x2){v1[2], v1[3]});
                        v0 = (f32x4){a.x, a.y, b.x, b.y}; v1 = (f32x4){c.x, c.y, d.x, d.y}; }
                    v0 = v0 * sc; v1 = v1 * sc; u32x4 w; w.x = cvt_pk_bf16(v0[0], v0[1]); w.y = cvt_pk_bf16(v0[2], v0[3]); w.z = cvt_pk_bf16(v1[0], v1[1]); w.w = cvt_pk_bf16(v1[2], v1[3]);
                    *(u32x4*)(rowp + bj * HALF) = w; } }
    }
};
__device__ __forceinline__ void pg8_glds16s(const void* gbase, unsigned voff, unsigned lds_dst) { unsigned keep;
    asm volatile("s_mov_b32 %0, m0\n\ts_mov_b32 m0, %2\n\ts_nop 0\n\tglobal_load_lds_dwordx4 %1, %3\n\ts_mov_b32 m0, %0" : "=&s"(keep) : "v"(voff), "s"(lds_dst), "s"(gbase) : "memory"); }
template <class E, bool H> struct PreOf { struct type {}; };
template <class E> struct PreOf<E, true> { using type = typename E::Pre; };
template <class Epi, class Sched, bool ALIGN_EPI = false, bool SP2 = false, bool GATHER = false, bool FP8 = false>
__device__ __forceinline__ void gemm_phase(PG8_LAS unsigned char* lds, const Gemm g, const Sched& S, const Epi& E) {
    const int tid = threadIdx.x, wid = __builtin_amdgcn_readfirstlane(tid >> 6), lane = tid & 63, wr = wid >> 2, wc = wid & 3, fr = lane & 15, fq = lane >> 4;
    constexpr int EB = FP8 ? 1 : 2;
    int K = g.K; asm volatile("" : "+s"(K));
    const int nt = (K * EB) / (BK * 2);
    unsigned voffA[2], voffB[2]; int Rl[2]; unsigned Cb[2];
#pragma unroll
    for (int i = 0; i < 2; ++i) { int R, C; stage_rc(tid * 16 + i * 8192, R, C); const int Rb = Epi::PERM ? ((R & ~31) + perm32(R & 31)) : R;
        voffA[i] = (unsigned)(R * K) * EB + (unsigned)C * 2u; voffB[i] = (unsigned)(Rb * K) * EB + (unsigned)C * 2u; Rl[i] = R; Cb[i] = (unsigned)C * 2u; }
    unsigned voffB16[2][2];
#pragma unroll
    for (int h_ = 0; h_ < 2; ++h_)
#pragma unroll
        for (int i_ = 0; i_ < 2; ++i_) { const int R = Rl[i_]; voffB16[h_][i_] = (unsigned)((64 * (R >> 5) + 16 * ((R >> 2) & 3) + 8 * h_ + 4 * ((R >> 4) & 1) + (R & 3)) * K) * EB + Cb[i_]; }
#define PG8_STAGE_B(bufoff, kptr, h) do { if constexpr (Epi::PERM16) { PG8_STAGE(bufoff, kptr, voffB16[h]); } else { PG8_STAGE(bufoff, (kptr) + (h) * hstep, voffB); } } while (0)
    unsigned gcur[2][2], gnxt[2][2];
#define PG8_GATH(dst, u) do { _Pragma("unroll") for (int h_ = 0; h_ < 2; ++h_) _Pragma("unroll") for (int i_ = 0; i_ < 2; ++i_) \
        dst[h_][i_] = (unsigned)g.rows[(u).pm * BM + h_ * HALF + Rl[i_]] * (unsigned)(K * EB) + Cb[i_]; } while (0)
#define PG8_STAGE_A(bufoff, kptr, h, GA) do { if constexpr (GATHER) { PG8_STAGE(bufoff, kptr, GA[h]); } else { PG8_STAGE(bufoff, (kptr) + (h) * hstep, voffA); } } while (0)
#define PG8_STAGE_A2(bufoff, kptr, h) do { if constexpr (GATHER) { const unsigned gs_[2] = {lastsel ? gnxt[h][0] : gcur[h][0], lastsel ? gnxt[h][1] : gcur[h][1]}; PG8_STAGE(bufoff, kptr, gs_); } else { PG8_STAGE(bufoff, (kptr) + (h) * hstep, voffA); } } while (0)
    const size_t kstep = (size_t)(BK * 2);
    const size_t hstep = (size_t)HALF * K * EB;
    const size_t tstep = 2 * hstep;
    const unsigned lds0 = (unsigned)(uintptr_t)lds;
    const unsigned ldsw = (unsigned)wid * 1024u;
    const int aoff = lds_byte(wr * 64 + fr, fq * 8), boff = lds_byte(wc * 32 + fr, fq * 8);
#define PG8_SA(b, h) (((b) * 2 + (h)) * HTB)
#define PG8_SB(b, h) ((4 + (b) * 2 + (h)) * HTB)
#define PG8_STAGE(bufoff, gbase, voff) do { _Pragma("unroll") for (int _i = 0; _i < 2; ++_i) { \
        if constexpr (FP8) pg8_glds16s((const char*)(gbase), (voff)[_i], (unsigned)__builtin_amdgcn_readfirstlane((int)(lds0 + (unsigned)(bufoff) + ldsw + _i * 8192))); \
        else __builtin_amdgcn_global_load_lds((const unsigned*)((const char*)(gbase) + (voff)[_i]), (PG8_LAS unsigned*)(lds + (bufoff) + ldsw + _i * 8192), 16, 0, 0); } } while (0)
#define PG8_CAT(x, y) __builtin_shufflevector(__builtin_bit_cast(i32x4, x), __builtin_bit_cast(i32x4, y), 0, 1, 2, 3, 4, 5, 6, 7)
#define PG8_LDA(dst, b, h) do { if constexpr (FP8) { _Pragma("unroll") for (int m = 0; m < 4; ++m) dst##8[m] = PG8_CAT(*(const PG8_LAS bf16x8*)(lds + PG8_SA(b, h) + aoff + m * 2048), *(const PG8_LAS bf16x8*)(lds + PG8_SA(b, h) + aoff + m * 2048 + 1024)); } \
        else { _Pragma("unroll") for (int m = 0; m < 4; ++m) _Pragma("unroll") for (int k = 0; k < 2; ++k) dst[m][k] = *(const PG8_LAS bf16x8*)(lds + PG8_SA(b, h) + aoff + m * 2048 + k * 1024); } } while (0)
#define PG8_LDB(dst, b, h) do { if constexpr (FP8) { _Pragma("unroll") for (int n = 0; n < 2; ++n) dst##8[n] = PG8_CAT(*(const PG8_LAS bf16x8*)(lds + PG8_SB(b, h) + boff + n * 2048), *(const PG8_LAS bf16x8*)(lds + PG8_SB(b, h) + boff + n * 2048 + 1024)); } \
        else { _Pragma("unroll") for (int n = 0; n < 2; ++n) _Pragma("unroll") for (int k = 0; k < 2; ++k) dst[n][k] = *(const PG8_LAS bf16x8*)(lds + PG8_SB(b, h) + boff + n * 2048 + k * 1024); } } while (0)
#define PG8_MMA(ai, bj, At, Bt) do { __builtin_amdgcn_s_setprio(1); _Pragma("unroll") for (int m = 0; m < 4; ++m) _Pragma("unroll") for (int n = 0; n < 2; ++n) { \
        if constexpr (FP8) asm volatile("v_mfma_f32_16x16x128_f8f6f4 %0, %1, %2, %0" : "+v"(acc[ai][bj][m][n]) : "v"(Bt##8[n]), "v"(At##8[m])); \
        else { _Pragma("unroll") for (int k = 0; k < 2; ++k) acc[ai][bj][m][n] = __builtin_amdgcn_mfma_f32_16x16x32_bf16(Bt[n][k], At[m][k], acc[ai][bj][m][n], 0, 0, 0); } } \
        __builtin_amdgcn_s_setprio(0); } while (0)
#define PG8_WAIT_V(n) asm volatile("s_waitcnt vmcnt(" #n ")" ::: "memory")
#define PG8_WAIT_L(n) asm volatile("s_waitcnt lgkmcnt(" #n ")" ::: "memory")
#define PG8_BAR __builtin_amdgcn_s_barrier()
#define PG8_SCHED __builtin_amdgcn_sched_barrier(0)
    Unit cur, nxt; int ui = 0;
    if (!S.next(0, cur)) return;
    typename PreOf<Epi, Epi::HAS_PRE>::type pre;
    f32x4 acc[2][2][4][2];
#pragma unroll
    for (int a = 0; a < 2; ++a)
#pragma unroll
        for (int b = 0; b < 2; ++b)
#pragma unroll
            for (int m = 0; m < 4; ++m)
#pragma unroll
                for (int n = 0; n < 2; ++n) acc[a][b][m][n] = (f32x4){0.f, 0.f, 0.f, 0.f};
    bf16x8 At[4][2], B0[2][2], B1[2][2];
    i32x8 At8[4], B08[2], B18[2];
    const char* cA = (const char*)g.A + (GATHER ? (size_t)0 : (size_t)cur.pm * tstep); const char* cB = (const char*)g.Bt + (size_t)cur.pn * tstep;
    if constexpr (GATHER) PG8_GATH(gcur, cur);
    S.a_ready(cur);
    if constexpr (SP2) {
        PG8_STAGE_B(PG8_SB(0, 0), cB, 0); PG8_STAGE_B(PG8_SB(0, 1), cB, 1); PG8_STAGE_A(PG8_SA(0, 0), cA, 0, gcur); PG8_STAGE_A(PG8_SA(0, 1), cA, 1, gcur);
        if (wr == 1) PG8_BAR;
        PG8_WAIT_V(2); PG8_BAR;
        PG8_STAGE_B(PG8_SB(1, 0), cB + kstep, 0); PG8_STAGE_A(PG8_SA(1, 0), cA + kstep, 0, gcur); PG8_STAGE_B(PG8_SB(1, 1), cB + kstep, 1);
        PG8_WAIT_V(6); PG8_BAR;
    } else {
        PG8_STAGE_B(PG8_SB(0, 0), cB, 0); PG8_STAGE_A(PG8_SA(0, 0), cA, 0, gcur); PG8_STAGE_B(PG8_SB(0, 1), cB, 1); PG8_STAGE_A(PG8_SA(0, 1), cA, 1, gcur);
        if (wr == 1) PG8_BAR;
        PG8_WAIT_V(4); PG8_BAR;
        PG8_STAGE_B(PG8_SB(1, 0), cB + kstep, 0); PG8_STAGE_A(PG8_SA(1, 0), cA + kstep, 0, gcur); PG8_STAGE_B(PG8_SB(1, 1), cB + kstep, 1);
        PG8_WAIT_V(6); PG8_BAR;
    }
    for (;;) {
        const bool has_next = S.next(ui + 1, nxt);
        if constexpr (Epi::HAS_PRE) E.prefetch(pre, cur, wr, fr);
        if constexpr (GATHER) { if (has_next) { PG8_GATH(gnxt, nxt); } else { _Pragma("unroll") for (int h_ = 0; h_ < 2; ++h_) _Pragma("unroll") for (int i_ = 0; i_ < 2; ++i_) gnxt[h_][i_] = gcur[h_][i_]; } }
        const char* nA = (has_next && !GATHER) ? (const char*)g.A + (size_t)nxt.pm * tstep : cA; const char* nB = has_next ? (const char*)g.Bt + (size_t)nxt.pn * tstep : cB;
        for (int t = 0; t < nt; t += 2) {
            const bool last = (t == nt - 2);
            const bool lastsel = last;
            const char* a1 = cA + (size_t)(t + 1) * kstep;
            const char* a2 = last ? nA : cA + (size_t)(t + 2) * kstep; const char* b2 = last ? nB : cB + (size_t)(t + 2) * kstep;
            const char* a3 = a2 + kstep; const char* b3 = b2 + kstep;
            if (last && has_next) S.a_ready(nxt);
            if constexpr (SP2) {
            PG8_LDB(B0, 0, 0); PG8_LDB(B1, 0, 1); PG8_SCHED; PG8_LDA(At, 0, 0); PG8_STAGE_A(PG8_SA(1, 1), a1, 1, gcur);
            PG8_WAIT_V(8); PG8_WAIT_L(0); PG8_BAR; PG8_MMA(0, 0, At, B0); PG8_MMA(0, 1, At, B1); PG8_BAR; PG8_SCHED;
            PG8_LDA(At, 0, 1); PG8_STAGE_B(PG8_SB(0, 0), b2, 0); PG8_STAGE_B(PG8_SB(0, 1), b2, 1); PG8_STAGE_A2(PG8_SA(0, 0), a2, 0);
            PG8_WAIT_V(8); PG8_WAIT_L(0); PG8_BAR; PG8_MMA(1, 0, At, B0); PG8_MMA(1, 1, At, B1); PG8_BAR; PG8_SCHED;
            PG8_LDB(B0, 1, 0); PG8_LDB(B1, 1, 1); PG8_SCHED; PG8_LDA(At, 1, 0); PG8_STAGE_A2(PG8_SA(0, 1), a2, 1);
            PG8_WAIT_V(8); PG8_WAIT_L(0); PG8_BAR; PG8_MMA(0, 0, At, B0); PG8_MMA(0, 1, At, B1); PG8_BAR; PG8_SCHED;
            PG8_LDA(At, 1, 1); PG8_STAGE_B(PG8_SB(1, 0), b3, 0); PG8_STAGE_B(PG8_SB(1, 1), b3, 1); PG8_STAGE_A2(PG8_SA(1, 0), a3, 0);
            PG8_WAIT_V(8); PG8_WAIT_L(0); PG8_BAR; PG8_MMA(1, 0, At, B0); PG8_MMA(1, 1, At, B1); PG8_BAR; PG8_SCHED;
            } else {
            PG8_LDB(B0, 0, 0); PG8_SCHED; PG8_LDA(At, 0, 0); PG8_STAGE_A(PG8_SA(1, 1), a1, 1, gcur);
            PG8_WAIT_L(8); PG8_BAR; PG8_WAIT_L(0); PG8_MMA(0, 0, At, B0); PG8_BAR; PG8_SCHED;
            PG8_LDB(B1, 0, 1); PG8_STAGE_B(PG8_SB(0, 0), b2, 0);
            PG8_BAR; PG8_WAIT_L(0); PG8_MMA(0, 1, At, B1); PG8_BAR;
            PG8_LDA(At, 0, 1); PG8_STAGE_A2(PG8_SA(0, 0), a2, 0);
            PG8_BAR; PG8_WAIT_L(0); PG8_MMA(1, 0, At, B0); PG8_BAR; PG8_SCHED;
            PG8_STAGE_B(PG8_SB(0, 1), b2, 1);
            PG8_WAIT_V(6); PG8_BAR; PG8_MMA(1, 1, At, B1); PG8_BAR;
            PG8_LDB(B0, 1, 0); PG8_SCHED; PG8_LDA(At, 1, 0); PG8_STAGE_A2(PG8_SA(0, 1), a2, 1);
            PG8_WAIT_L(8); PG8_BAR; PG8_WAIT_L(0); PG8_MMA(0, 0, At, B0); PG8_BAR; PG8_SCHED;
            PG8_LDB(B1, 1, 1); PG8_STAGE_B(PG8_SB(1, 0), b3, 0);
            PG8_BAR; PG8_WAIT_L(0); PG8_MMA(0, 1, At, B1); PG8_BAR;
            PG8_LDA(At, 1, 1); PG8_STAGE_A2(PG8_SA(1, 0), a3, 0);
            PG8_BAR; PG8_WAIT_L(0); PG8_MMA(1, 0, At, B0); PG8_BAR; PG8_SCHED;
            PG8_STAGE_B(PG8_SB(1, 1), b3, 1);
            PG8_WAIT_V(6); PG8_BAR; PG8_MMA(1, 1, At, B1); PG8_BAR;
            }
        }
        if constexpr (FP8) {
            _Pragma("unroll") for (int a = 0; a < 2; ++a) _Pragma("unroll") for (int b = 0; b < 2; ++b) _Pragma("unroll") for (int m = 0; m < 4; ++m)
                { if (a == 0 && b == 0 && m == 0) asm volatile("s_nop 15\n\ts_nop 7" : "+v"(acc[a][b][m][0]), "+v"(acc[a][b][m][1])); else asm volatile("" : "+v"(acc[a][b][m][0]), "+v"(acc[a][b][m][1])); }
        }
        if constexpr (ALIGN_EPI) { if (wr == 0) PG8_BAR; }
        if constexpr (!Epi::AFTER_DRAIN) { if constexpr (Epi::HAS_PRE) E(acc, cur, wr, wc, fr, fq, pre); else E(acc, cur, wr, wc, fr, fq); S.done(cur); }
        if (!has_next) break;
#pragma unroll
        for (int a = 0; a < 2; ++a)
#pragma unroll
            for (int b = 0; b < 2; ++b)
#pragma unroll
                for (int m = 0; m < 4; ++m)
#pragma unroll
                    for (int n = 0; n < 2; ++n) acc[a][b][m][n] = (f32x4){0.f, 0.f, 0.f, 0.f};
        cur = nxt; cA = nA; cB = nB; ++ui;
        if constexpr (GATHER) { _Pragma("unroll") for (int h_ = 0; h_ < 2; ++h_) _Pragma("unroll") for (int i_ = 0; i_ < 2; ++i_) gcur[h_][i_] = gnxt[h_][i_]; }
        if constexpr (ALIGN_EPI) { if (wr == 1) PG8_BAR; }
    }
    PG8_WAIT_V(0);
    if constexpr (!ALIGN_EPI) { if (wr == 0) PG8_BAR; }
    PG8_BAR;
    if constexpr (Epi::AFTER_DRAIN) { E.fused(acc, cur, wr, wc, fr, fq, lds, wid, lane); S.done(cur); }
#undef PG8_SA
#undef PG8_SB
#undef PG8_STAGE
#undef PG8_STAGE_A
#undef PG8_STAGE_A2
#undef PG8_STAGE_B
#undef PG8_GATH
#undef PG8_LDA
#undef PG8_LDB
#undef PG8_MMA
#undef PG8_CAT
#undef PG8_WAIT_V
#undef PG8_WAIT_L
#undef PG8_BAR
#undef PG8_SCHED
}
}

#ifndef PG8_SP2
#define PG8_SP2 true
#endif
#ifndef PG8_ALIGN
#define PG8_ALIGN true
#endif
namespace pg8 {
struct EpiResF32 {
    static constexpr bool PERM = false, AFTER_DRAIN = false, PERM16 = false, HAS_PRE = false;
    const float* base; float* out; int ldc;
    __device__ __forceinline__ void operator()(const f32x4 (&acc)[2][2][4][2], const Unit& u, int wr, int wc, int fr, int fq) const {
        const int col0 = u.pn * BM + wc * 32 + 4 * fq;
        const size_t off0 = (size_t)(u.pm * BM + wr * 64 + fr) * ldc + col0;
        f32x4 bs[8][2][2];
#define PG8_RES_LD(g) do { const size_t off_ = off0 + (size_t)(((g) >> 2) * HALF + ((g) & 3) * 16) * ldc; _Pragma("unroll") for (int bj = 0; bj < 2; ++bj) _Pragma("unroll") for (int n = 0; n < 2; ++n) \
            bs[g][bj][n] = *(const f32x4*)(base + off_ + bj * HALF + n * 16); } while (0)
        PG8_RES_LD(0); PG8_RES_LD(1); PG8_RES_LD(2);
#pragma unroll
        for (int g = 0; g < 8; ++g) { const int ai = g >> 2, m = g & 3; const size_t off = off0 + (size_t)(ai * HALF + m * 16) * ldc;
            if (g + 3 < 8) PG8_RES_LD(g + 3);
#pragma unroll
            for (int bj = 0; bj < 2; ++bj)
#pragma unroll
                for (int n = 0; n < 2; ++n) *(f32x4*)(out + off + bj * HALF + n * 16) = bs[g][bj][n] + acc[ai][bj][m][n]; }
#undef PG8_RES_LD
    }
};
struct EpiSwiglu {
    static constexpr bool PERM = true, AFTER_DRAIN = false, PERM16 = true, HAS_PRE = true;
    unsigned char* O; const float* bias;
    struct Pre { f32x4 bv[2][2]; };
    __device__ __forceinline__ void prefetch(Pre& p, const Unit& u, int wr, int fr) const {
        const int tid = threadIdx.x, wc = __builtin_amdgcn_readfirstlane(tid >> 6) & 3, fq = (tid & 63) >> 4;
        const int e = u.pn >> 3, pnl = u.pn & 7, bcol0 = pnl * BM + wc * 64 + 16 * fq;
        const float* bp = bias + (size_t)e * 2048 + bcol0;
#pragma unroll
        for (int bj = 0; bj < 2; ++bj)
#pragma unroll
            for (int n = 0; n < 2; ++n) p.bv[bj][n] = *(const f32x4*)(bp + 8 * bj + 4 * n);
    }
    __device__ __forceinline__ void operator()(const f32x4 (&acc)[2][2][4][2], const Unit& u, int wr, int wc, int fr, int fq, const Pre& p) const {
        const int pnl = u.pn & 7;
        const int row0 = u.pm * BM + wr * 64 + fr, bcol0 = pnl * BM + wc * 64 + 16 * fq;
        const f32x4 (&bv)[2][2] = p.bv;
#pragma unroll
        for (int ai = 0; ai < 2; ++ai)
#pragma unroll
            for (int m = 0; m < 4; ++m) { unsigned char* rowp = O + (size_t)(row0 + ai * HALF + m * 16) * 1024 + (bcol0 >> 1);
                float a[8];
#pragma unroll
                for (int bj = 0; bj < 2; ++bj) { const f32x4 v0 = acc[ai][bj][m][0] * MOE_WSCALE_INV + bv[bj][0], v1 = acc[ai][bj][m][1] * MOE_WSCALE_INV + bv[bj][1];
                    const float g[4] = {v0[0], v0[2], v1[0], v1[2]}, up[4] = {v0[1], v0[3], v1[1], v1[3]};
#pragma unroll
                    for (int i = 0; i < 4; ++i) { const float gc = fminf(g[i], 7.0f), uc = fminf(fmaxf(up[i], -7.0f), 7.0f);
                        a[4 * bj + i] = (uc + 1.0f) * gc * __builtin_amdgcn_rcpf(1.0f + __builtin_amdgcn_exp2f(-1.702f * 1.4426950408889634f * gc)); } }
                typedef unsigned u32x2 __attribute__((ext_vector_type(2)));
                u32x2 w; w.x = pk_fp8x4(a[0], a[1], a[2], a[3]); w.y = pk_fp8x4(a[4], a[5], a[6], a[7]);
                *(u32x2*)rowp = w; }
    }
};
struct EpiMoeOut {
    static constexpr bool PERM = true, AFTER_DRAIN = false, PERM16 = true, HAS_PRE = true;
    unsigned char* YS; const float* bias; const float* rgate;
    struct Pre { float g[8]; f32x4 bv[2][2]; };
    __device__ __forceinline__ void prefetch(Pre& p, const Unit& u, int wr, int fr) const {
        const int row0 = u.pm * BM + wr * 64 + fr;
#pragma unroll
        for (int ai = 0; ai < 2; ++ai)
#pragma unroll
            for (int m = 0; m < 4; ++m) p.g[ai * 4 + m] = rgate[row0 + ai * HALF + m * 16];
        const int tid = threadIdx.x, wc = __builtin_amdgcn_readfirstlane(tid >> 6) & 3, fq = (tid & 63) >> 4;
        const float* bp = bias + (size_t)(u.pn >> 2) * 1024 + (u.pn & 3) * BM + wc * 64 + 16 * fq;
#pragma unroll
        for (int bj = 0; bj < 2; ++bj)
#pragma unroll
            for (int n = 0; n < 2; ++n) p.bv[bj][n] = *(const f32x4*)(bp + 8 * bj + 4 * n);
    }
    __device__ __forceinline__ void operator()(const f32x4 (&acc)[2][2][4][2], const Unit& u, int wr, int wc, int fr, int fq, const Pre& p) const {
        const int pnl = u.pn & 3;
        const int col0 = pnl * BM + wc * 64 + 16 * fq;
        const int row0 = u.pm * BM + wr * 64 + fr;
        const f32x4 (&bv)[2][2] = p.bv;
#pragma unroll
        for (int ai = 0; ai < 2; ++ai)
#pragma unroll
            for (int m = 0; m < 4; ++m) { const float gt = p.g[ai * 4 + m] * MOE_YSCALE; u32x4 w;
                { const f32x4 v0 = (acc[ai][0][m][0] * MOE_WSCALE_INV + bv[0][0]) * gt, v1 = (acc[ai][0][m][1] * MOE_WSCALE_INV + bv[0][1]) * gt; w.x = pk_fp8x4(v0[0], v0[1], v0[2], v0[3]); w.y = pk_fp8x4(v1[0], v1[1], v1[2], v1[3]); }
                { const f32x4 v0 = (acc[ai][1][m][0] * MOE_WSCALE_INV + bv[1][0]) * gt, v1 = (acc[ai][1][m][1] * MOE_WSCALE_INV + bv[1][1]) * gt; w.z = pk_fp8x4(v0[0], v0[1], v0[2], v0[3]); w.w = pk_fp8x4(v1[0], v1[1], v1[2], v1[3]); }
                *(u32x4*)(YS + (size_t)(row0 + ai * HALF + m * 16) * 1024 + col0) = w; }
    }
};
template <int NTN> struct MoeOrder {
    int ntiles, c, G; const PG8_LAS int* te;
    __device__ __forceinline__ bool next(int i, Unit& u) const {
        int pm, pnl; constexpr int RT = 32 / NTN;
        if (G == 256) { const int x = c & 7, j = c >> 3, gidx = i * 8 + x; pm = RT * gidx + (j % RT); pnl = j / RT; }
        else { const long L = (long)i * G + c; pm = (int)(L / NTN); pnl = (int)(L % NTN); }
        if (pm >= ntiles) return false;
        u.pm = pm; u.pn = te[pm] * NTN + pnl; return true;
    }
    __device__ __forceinline__ void a_ready(const Unit&) const {}
    __device__ __forceinline__ void done(const Unit&) const {}
};
}
#include <hip/hip_bf16.h>
#include <cmath>
namespace attn_body {
using bf16=__hip_bfloat16;
using bf16x8=__attribute__((ext_vector_type(8)))short;
using s16x4=__attribute__((ext_vector_type(4)))short;
using f32x16=__attribute__((ext_vector_type(16)))float;
using u32x4=__attribute__((ext_vector_type(4)))unsigned;
constexpr int SEQ=8192,D=64,PQ=3328,PO=1024;
constexpr int NW=8,QBLK=32,QB=QBLK*NW,KVBLK=64,NQB=SEQ/QB;
constexpr int ATTN_UNIT_ROWS=QB;
__device__ __forceinline__ int crow(int r,int hi){return (r&3)+8*(r>>2)+4*hi;}
#define SBAR() __builtin_amdgcn_sched_barrier(0)
__device__ __forceinline__ void cmask(f32x16&p0,f32x16&p1,int jb,int qrel,int hi){
  const float NEG=-INFINITY; int kb=64*jb+4*hi;
  #pragma unroll
  for(int r=0;r<16;++r){int kv=kb+(r&3)+8*(r>>2); if(kv>qrel)p0[r]=NEG; if(kv+32>qrel)p1[r]=NEG;}
}

constexpr int NSLOT=3, SLOTB=8192;
constexpr int LDS_K=0, LDS_V=NSLOT*SLOTB, LDS_WS=2*NSLOT*SLOTB, LDS_OST=LDS_WS+NW*64*4, LDS_BYTES=LDS_OST+NW*4096;
constexpr float C2=0.125f*1.4426950408889634f;
__device__ __forceinline__ void glds16(const void*gsrc,unsigned lds_dst){unsigned keep;
  asm volatile("s_mov_b32 %0, m0\n\ts_mov_b32 m0, %2\n\ts_nop 0\n\tglobal_load_lds_dwordx4 %1, off\n\ts_mov_b32 m0, %0":"=&s"(keep):"v"(gsrc),"s"(lds_dst):"memory");}
__device__ __forceinline__ void glds16s(const void*gbase,unsigned voff,unsigned lds_dst){unsigned keep;
  asm volatile("s_mov_b32 %0, m0\n\ts_mov_b32 m0, %2\n\ts_nop 0\n\tglobal_load_lds_dwordx4 %1, %3\n\ts_mov_b32 m0, %0":"=&s"(keep):"v"(voff),"s"(lds_dst),"s"(gbase):"memory");}
__device__ __forceinline__ float max3f(float a,float b,float c){float r;asm("v_max3_f32 %0, %1, %2, %3":"=v"(r):"v"(a),"v"(b),"v"(c));return r;}
__device__ __forceinline__ float max2f(float a,float b){float r;asm("v_max_f32_e32 %0, %1, %2":"=v"(r):"v"(a),"v"(b));return r;}
__device__ __forceinline__ float fadd_s(float a,float b){float r;asm("v_add_f32_e32 %0, %1, %2":"=v"(r):"v"(a),"v"(b));return r;}
__device__ __forceinline__ float fsub_s(float a,float b){float r;asm("v_sub_f32_e32 %0, %1, %2":"=v"(r):"v"(a),"v"(b));return r;}
typedef float f32x2_t __attribute__((ext_vector_type(2))); typedef __bf16 bf16x2_t __attribute__((ext_vector_type(2)));
__device__ __forceinline__ unsigned cvtpk_s(float lo,float hi){f32x2_t v={lo,hi};bf16x2_t b=__builtin_convertvector(v,bf16x2_t);return __builtin_bit_cast(unsigned,b);}
#define WAIT_BAR(N) asm volatile("s_waitcnt vmcnt(" #N ") lgkmcnt(0)\n\ts_barrier":::"memory")

__device__ __forceinline__ void qkt(f32x16&p0,f32x16&p1,const char*Kslot,const bf16x8*qr,const f32x16&negm,int r32,int hi){
  const char*kb=Kslot+hi*1024+r32*16;
  #pragma unroll
  for(int d0=0;d0<4;++d0){
    const bf16x8 b0=*reinterpret_cast<const bf16x8*>(kb+d0*2048);
    const bf16x8 b1=*reinterpret_cast<const bf16x8*>(kb+d0*2048+512);
    if(d0==0){p0=__builtin_amdgcn_mfma_f32_32x32x16_bf16(b0,qr[0],negm,0,0,0);p1=__builtin_amdgcn_mfma_f32_32x32x16_bf16(b1,qr[0],negm,0,0,0);}
    else{p0=__builtin_amdgcn_mfma_f32_32x32x16_bf16(b0,qr[d0],p0,0,0,0);p1=__builtin_amdgcn_mfma_f32_32x32x16_bf16(b1,qr[d0],p1,0,0,0);}}
}
typedef __attribute__((address_space(3))) const char* lds_cptr;
typedef short v4i16_t __attribute__((ext_vector_type(4)));
__device__ __forceinline__ void kload8(bf16x8*kf,lds_cptr kp){
  kf[0]=*(const __attribute__((address_space(3))) bf16x8*)(kp);      kf[1]=*(const __attribute__((address_space(3))) bf16x8*)(kp+512);
  kf[2]=*(const __attribute__((address_space(3))) bf16x8*)(kp+2048); kf[3]=*(const __attribute__((address_space(3))) bf16x8*)(kp+2560);
  kf[4]=*(const __attribute__((address_space(3))) bf16x8*)(kp+4096); kf[5]=*(const __attribute__((address_space(3))) bf16x8*)(kp+4608);
  kf[6]=*(const __attribute__((address_space(3))) bf16x8*)(kp+6144); kf[7]=*(const __attribute__((address_space(3))) bf16x8*)(kp+6656);
}
__device__ __forceinline__ void kload2(bf16x8*kf,lds_cptr kp,int j){ kf[2*j]=*(const __attribute__((address_space(3))) bf16x8*)(kp+j*2048); kf[2*j+1]=*(const __attribute__((address_space(3))) bf16x8*)(kp+j*2048+512); }
__device__ __forceinline__ s16x4 vtr(lds_cptr p){ return __builtin_bit_cast(s16x4,__builtin_amdgcn_ds_read_tr16_b64_v4i16((__attribute__((address_space(3))) v4i16_t*)p)); }
__device__ __forceinline__ float rowmax(const f32x16&p0,const f32x16&p1){
  float a=max3f(p0[0],p0[1],p1[0]),b=max3f(p0[2],p0[3],p1[1]);a=max3f(a,p1[2],p1[3]);
  #pragma unroll
  for(int r=4;r<16;r+=4){a=max3f(a,p0[r],p0[r+1]);b=max3f(b,p0[r+2],p0[r+3]);a=max3f(a,p1[r],p1[r+1]);b=max3f(b,p1[r+2],p1[r+3]);}
  const float m=max2f(a,b);
  auto rr=__builtin_amdgcn_permlane32_swap(__float_as_uint(m),__float_as_uint(m),false,false);
  return max2f(__uint_as_float(rr[0]),__uint_as_float(rr[1]));
}
#ifndef ATTN_STORE16
#define ATTN_STORE16(p,v) (*(u32x4*)(p)=(v))
#endif
constexpr int VSLOTB=16384, LDS2_V=NSLOT*SLOTB, LDS2_WS=LDS2_V+NSLOT*VSLOTB, LDS2_OST=LDS2_WS+NW*64*4, LDS2_BYTES=LDS2_OST+NW*8192;
__device__ __forceinline__ void pv128(f32x16*o,int vb,bf16x8 pa0,bf16x8 pa1,bf16x8 pa2,bf16x8 pa3){
  #pragma unroll
  for(int d0=0;d0<4;++d0){s16x4 lo[4],hi[4];
    #pragma unroll
    for(int ks=0;ks<4;++ks){
      asm volatile("ds_read_b64_tr_b16 %0,%1 offset:%c2":"=&v"(lo[ks]):"v"(vb),"i"(d0*4096+ks*1024):"memory");
      asm volatile("ds_read_b64_tr_b16 %0,%1 offset:%c2":"=&v"(hi[ks]):"v"(vb),"i"(d0*4096+ks*1024+512):"memory");}
    asm volatile("s_waitcnt lgkmcnt(0)":::"memory");SBAR();
    #define PK(k) (bf16x8){lo[k][0],lo[k][1],lo[k][2],lo[k][3],hi[k][0],hi[k][1],hi[k][2],hi[k][3]}
    o[d0]=__builtin_amdgcn_mfma_f32_32x32x16_bf16(pa0,PK(0),o[d0],0,0,0);
    o[d0]=__builtin_amdgcn_mfma_f32_32x32x16_bf16(pa1,PK(1),o[d0],0,0,0);
    o[d0]=__builtin_amdgcn_mfma_f32_32x32x16_bf16(pa2,PK(2),o[d0],0,0,0);
    o[d0]=__builtin_amdgcn_mfma_f32_32x32x16_bf16(pa3,PK(3),o[d0],0,0,0);
    #undef PK
  }
}
template<int THRL> __device__ __forceinline__ void attn_unit128(int b,int qb,const bf16*Q,const bf16*__restrict__ K,const bf16*__restrict__ V,bf16*O,char*shm){
  const int tid=threadIdx.x,lane=tid&63,r32=lane&31,hi=lane>>5; const int wid=__builtin_amdgcn_readfirstlane(tid>>6);
  const long rowbase=(long)b*SEQ; const int q0=qb*QB;
  const bf16*Qw=Q+(rowbase+q0+wid*QBLK)*PQ;
  const bf16*Kh=K+rowbase*PQ,*Vh=V+rowbase*PQ;
  const unsigned lds0=(unsigned)(uintptr_t)shm;
  float*wsf=(float*)(shm+LDS2_WS)+wid*64;
  const bf16*ksrc=Kh+wid*8; const unsigned koff=(unsigned)lane*(PQ*2);
  const bf16*vsrc=Vh+(long)(16*(wid&3))*PQ+(wid>>2)*32; const unsigned voff=(unsigned)(lane>>2)*(PQ*2)+(unsigned)(lane&3)*16;
  const unsigned kdst=lds0+LDS_K+wid*1024, vdst=lds0+LDS2_V+wid*1024;
  #define DMA_K(t,slot) glds16s(ksrc+(long)(t)*KVBLK*PQ,koff,(unsigned)__builtin_amdgcn_readfirstlane(kdst+(slot)))
  #define DMA_V(t,slot) do{ glds16s(vsrc+(long)(t)*KVBLK*PQ,voff,(unsigned)__builtin_amdgcn_readfirstlane(vdst+2*(slot))); glds16s(vsrc+(long)(t)*KVBLK*PQ+64,voff,(unsigned)__builtin_amdgcn_readfirstlane(vdst+2*(slot)+8192)); }while(0)
  const char*Kbase=shm+LDS_K; bf16x8 kf[8];
  const lds_cptr shm3=(lds_cptr)shm; const lds_cptr kp0=shm3+LDS_K+hi*1024+r32*16; const lds_cptr vp0=shm3+LDS2_V+((lane>>4)&1)*32+(lane&3)*8+(4*hi+((lane&15)>>2))*64;
  const int NT=(q0+QB)/KVBLK;
  DMA_K(0,0);DMA_V(0,0);DMA_K(1,SLOTB);
  bf16x8 qr[4];
  #pragma unroll
  for(int d0=0;d0<4;++d0)qr[d0]=*reinterpret_cast<const bf16x8*>(&Qw[(long)r32*PQ+d0*16+hi*8]);
  float mhat=0.f,l_reg=0.f;f32x16 o[4];o[0]=f32x16{};o[1]=f32x16{};o[2]=f32x16{};o[3]=f32x16{};const f32x16 zz=f32x16{};
  const int qrel=wid*QBLK+r32;
  #define CMASK(P0,P1,t) do{int jb_=(t)-(NT-4); if(jb_>=0)cmask(P0,P1,jb_,qrel,hi);}while(0)
  bool resc=false;
  #define START(P0,P1) do{ const float rm=rowmax(P0,P1); resc=false; \
    mhat=rm; \
    _Pragma("unroll") for(int r=0;r<16;++r)P0[r]=__builtin_amdgcn_exp2f(P0[r]-mhat); }while(0)
  #define RESC() do{ if(resc){ asm volatile("s_waitcnt lgkmcnt(0)":::"memory"); \
      _Pragma("unroll") for(int d_=0;d_<4;++d_) _Pragma("unroll") for(int r=0;r<16;++r)o[d_][r]*=wsf[crow(r,hi)]; } }while(0)
  f32x16 pA0,pA1,pB0,pB1;
  int sl_prev=0,sl_cur=0,sl_next=SLOTB;
  #define ROT() do{sl_prev=sl_cur;sl_cur=sl_next;sl_next=(sl_next==(NSLOT-1)*SLOTB)?0:sl_next+SLOTB;}while(0)
  DMA_K(2,2*SLOTB);
  WAIT_BAR(3);
  qkt(pA0,pA1,Kbase,qr,zz,r32,hi);asm volatile("s_nop 15\n\ts_nop 7":"+v"(pA0),"+v"(pA1));CMASK(pA0,pA1,0);
  START(pA0,pA1);
  _Pragma("unroll") for(int r=0;r<16;++r)pA1[r]=__builtin_amdgcn_exp2f(pA1[r]-mhat);
  WAIT_BAR(0);
  DMA_K(3,0);DMA_V(1,SLOTB);
  ROT();
  kload8(kf,kp0+sl_cur);
  WAIT_BAR(3);
  s16x4 vlo[4],vhi[4]; u32x4 pw0,pw1,pw2,pw3;
  #define PKW(P,B) cvtpk_s(P[B],P[B+1])
  #define PAF(k) __builtin_bit_cast(bf16x8,pw##k)
  #define FIDX(j) ((((j)&7)>>1)+4*((j)&1)+8*((j)>>3))
  #define VOFF(f) (((f)>>2)*4096+((f)&3)*1024)
  #define VRDJ(j) do{ vlo[(j)&3]=vtr(vp_+VOFF(FIDX(j))); vhi[(j)&3]=vtr(vp_+(VOFF(FIDX(j))+512)); SBAR(); }while(0)
  #define VFJ(j) (bf16x8){vlo[(j)&3][0],vlo[(j)&3][1],vlo[(j)&3][2],vlo[(j)&3][3],vhi[(j)&3][0],vhi[(j)&3][1],vhi[(j)&3][2],vhi[(j)&3][3]}
  #define PIN(x) asm volatile("":"+v"(x))
  #define MX3(a,b,c) __builtin_fmaxf(__builtin_fmaxf((a),(b)),(c))
  #define GAPA(MF,A0,A1,A2,A3,W0,W1,PW) do{ MF; sacc+=A0; sacc+=A1; sacc+=A2; sacc+=A3; PIN(sacc); W0; W1; PIN(PW); SBAR(); }while(0)
  #define EX(v) __builtin_amdgcn_exp2f(v)
  #define GAPB2(MF,X,B) do{ MF; X[B]=EX(X[B]-mhat); X[B+1]=EX(X[B+1]-mhat); PIN(X); SBAR(); }while(0)
  #define KRD(G,j) do{ if(G){ kload2(kf,kp0+sl_next,j); SBAR(); } }while(0)
  #define STEP(C0,C1,P0,P1,t,GK,GV,GL) do{ SBAR(); \
    const lds_cptr vp_=vp0+2*sl_prev; \
    float sacc=(P0[0]+P0[1]); \
    GAPA(C0=__builtin_amdgcn_mfma_f32_32x32x16_bf16(kf[0],qr[0],zz,0,0,0), P0[2],P0[3],P0[4],P0[5], pw0[0]=PKW(P0,0), pw0[1]=PKW(P0,2), pw0); \
    GAPA(C1=__builtin_amdgcn_mfma_f32_32x32x16_bf16(kf[1],qr[0],zz,0,0,0), P0[6],P0[7],P0[8],P0[9], pw0[2]=PKW(P0,4), pw0[3]=PKW(P0,6), pw0); \
    GAPA(C0=__builtin_amdgcn_mfma_f32_32x32x16_bf16(kf[2],qr[1],C0,0,0,0), P0[10],P0[11],P0[12],P0[13], pw1[0]=PKW(P0,8), pw1[1]=PKW(P0,10), pw1); \
    GAPA(C1=__builtin_amdgcn_mfma_f32_32x32x16_bf16(kf[3],qr[1],C1,0,0,0), P0[14],P0[15],P1[0],P1[1], pw1[2]=PKW(P0,12),pw1[3]=PKW(P0,14), pw1); \
    GAPA(C0=__builtin_amdgcn_mfma_f32_32x32x16_bf16(kf[4],qr[2],C0,0,0,0), P1[2],P1[3],P1[4],P1[5], pw2[0]=PKW(P1,0), pw2[1]=PKW(P1,2), pw2); \
    GAPA(C1=__builtin_amdgcn_mfma_f32_32x32x16_bf16(kf[5],qr[2],C1,0,0,0), P1[6],P1[7],P1[8],P1[9], pw2[2]=PKW(P1,4), pw2[3]=PKW(P1,6), pw2); \
    GAPA(C0=__builtin_amdgcn_mfma_f32_32x32x16_bf16(kf[6],qr[3],C0,0,0,0), P1[10],P1[11],P1[12],P1[13], pw3[0]=PKW(P1,8), pw3[1]=PKW(P1,10), pw3); \
    GAPA(C1=__builtin_amdgcn_mfma_f32_32x32x16_bf16(kf[7],qr[3],C1,0,0,0), P1[14],P1[15],0.f,0.f, pw3[2]=PKW(P1,12),pw3[3]=PKW(P1,14), pw3); \
    l_reg+=sacc; \
    if(GK){DMA_K((t)+3,sl_cur);} if(GV){DMA_V((t)+1,sl_next);} \
    VRDJ(0); VRDJ(1); VRDJ(2); \
    CMASK(C0,C1,t); \
    { float a=MX3(C0[0],C0[1],C1[0]),b=MX3(C0[2],C0[3],C1[1]); a=MX3(a,C1[2],C1[3]); \
      _Pragma("unroll") for(int r=4;r<16;r+=4){a=MX3(a,C0[r],C0[r+1]);b=MX3(b,C0[r+2],C0[r+3]);a=MX3(a,C1[r],C1[r+1]);b=MX3(b,C1[r+2],C1[r+3]);} \
      float rm=__builtin_fmaxf(a,b); { auto rr=__builtin_amdgcn_permlane32_swap(__float_as_uint(rm),__float_as_uint(rm),false,false); rm=__builtin_fmaxf(__uint_as_float(rr[0]),__uint_as_float(rr[1])); } \
      resc=false; \
      rm-=mhat; \
      if(__builtin_expect(__any(rm>(float)THRL),0)){ const float dl=__builtin_fmaxf(rm,0.f); mhat+=dl; \
        const float f=__builtin_amdgcn_exp2f(-dl); l_reg*=f; if(hi==0)wsf[r32]=f; resc=true; } } \
    SBAR(); \
    GAPB2(o[0]=__builtin_amdgcn_mfma_f32_32x32x16_bf16(PAF(0),VFJ(0),o[0],0,0,0), C0,0); VRDJ(3); \
    GAPB2(o[1]=__builtin_amdgcn_mfma_f32_32x32x16_bf16(PAF(0),VFJ(1),o[1],0,0,0), C0,2); VRDJ(4); \
    KRD(GL,0); GAPB2(o[0]=__builtin_amdgcn_mfma_f32_32x32x16_bf16(PAF(1),VFJ(2),o[0],0,0,0), C0,4); VRDJ(5); \
    KRD(GL,1); GAPB2(o[1]=__builtin_amdgcn_mfma_f32_32x32x16_bf16(PAF(1),VFJ(3),o[1],0,0,0), C0,6); VRDJ(6); \
    KRD(GL,2); GAPB2(o[0]=__builtin_amdgcn_mfma_f32_32x32x16_bf16(PAF(2),VFJ(4),o[0],0,0,0), C0,8); VRDJ(7); \
    KRD(GL,3); GAPB2(o[1]=__builtin_amdgcn_mfma_f32_32x32x16_bf16(PAF(2),VFJ(5),o[1],0,0,0), C0,10); VRDJ(8); \
    GAPB2(o[0]=__builtin_amdgcn_mfma_f32_32x32x16_bf16(PAF(3),VFJ(6),o[0],0,0,0), C0,12); VRDJ(9); \
    GAPB2(o[1]=__builtin_amdgcn_mfma_f32_32x32x16_bf16(PAF(3),VFJ(7),o[1],0,0,0), C0,14); VRDJ(10); \
    GAPB2(o[2]=__builtin_amdgcn_mfma_f32_32x32x16_bf16(PAF(0),VFJ(8),o[2],0,0,0), C1,0); VRDJ(11); \
    GAPB2(o[3]=__builtin_amdgcn_mfma_f32_32x32x16_bf16(PAF(0),VFJ(9),o[3],0,0,0), C1,2); VRDJ(12); \
    GAPB2(o[2]=__builtin_amdgcn_mfma_f32_32x32x16_bf16(PAF(1),VFJ(10),o[2],0,0,0), C1,4); VRDJ(13); \
    GAPB2(o[3]=__builtin_amdgcn_mfma_f32_32x32x16_bf16(PAF(1),VFJ(11),o[3],0,0,0), C1,6); VRDJ(14); \
    GAPB2(o[2]=__builtin_amdgcn_mfma_f32_32x32x16_bf16(PAF(2),VFJ(12),o[2],0,0,0), C1,8); VRDJ(15); \
    GAPB2(o[3]=__builtin_amdgcn_mfma_f32_32x32x16_bf16(PAF(2),VFJ(13),o[3],0,0,0), C1,10); \
    GAPB2(o[2]=__builtin_amdgcn_mfma_f32_32x32x16_bf16(PAF(3),VFJ(14),o[2],0,0,0), C1,12); \
    GAPB2(o[3]=__builtin_amdgcn_mfma_f32_32x32x16_bf16(PAF(3),VFJ(15),o[3],0,0,0), C1,14); \
    }while(0)
  int t=1;
  #undef CMASK
  #define CMASK(P0,P1,t) do{}while(0)
  for(;t+5<NT;t+=2){
    STEP(pB0,pB1,pA0,pA1,t,true,true,true);     WAIT_BAR(3); RESC(); ROT();
    STEP(pA0,pA1,pB0,pB1,t+1,true,true,true);   WAIT_BAR(3); RESC(); ROT();
  }
  #undef CMASK
  #define CMASK(P0,P1,t) do{int jb_=(t)-(NT-4); if(jb_>=0)cmask(P0,P1,jb_,qrel,hi);}while(0)
  #define ENDW(tt) do{ if((tt)+3<NT){WAIT_BAR(3);} else if((tt)+2<NT){WAIT_BAR(2);} else {WAIT_BAR(0);} }while(0)
  for(;t+1<NT;t+=2){
    STEP(pB0,pB1,pA0,pA1,t,(t+3<NT),(t+1<NT),(t+1<NT));       ENDW(t);   RESC(); ROT();
    STEP(pA0,pA1,pB0,pB1,t+1,(t+4<NT),(t+2<NT),(t+2<NT));     ENDW(t+1); RESC(); ROT();
  }
  STEP(pB0,pB1,pA0,pA1,NT-1,false,false,false); RESC();
  { float sacc=pB0[0]+pB0[1]; _Pragma("unroll") for(int r=2;r<16;++r)sacc+=pB0[r]; _Pragma("unroll") for(int r=0;r<16;++r)sacc+=pB1[r]; l_reg+=sacc;
    pw0=(u32x4){PKW(pB0,0),PKW(pB0,2),PKW(pB0,4),PKW(pB0,6)};pw1=(u32x4){PKW(pB0,8),PKW(pB0,10),PKW(pB0,12),PKW(pB0,14)};pw2=(u32x4){PKW(pB1,0),PKW(pB1,2),PKW(pB1,4),PKW(pB1,6)};pw3=(u32x4){PKW(pB1,8),PKW(pB1,10),PKW(pB1,12),PKW(pB1,14)};
    SBAR(); pv128(o,(int)(unsigned)(uintptr_t)vp0+2*sl_cur,PAF(0),PAF(1),PAF(2),PAF(3)); }
  #undef PKW
  #undef PAF
  #undef PIN
  #undef MX3
  #undef GAPA
  #undef EX
  #undef VRDJ
  #undef VFJ
  #undef FIDX
  #undef VOFF
  #undef GAPB2
  #undef KRD
  #undef STEP
  #undef ENDW
  int lane_e=lane; asm volatile("":"+v"(lane_e)); const int r32e=lane_e&31,hie=lane_e>>5;
  {auto rr=__builtin_amdgcn_permlane32_swap(__float_as_uint(l_reg),__float_as_uint(l_reg),false,false);l_reg=__uint_as_float(rr[0])+__uint_as_float(rr[1]);}
  if(hie==0)wsf[32+r32e]=l_reg;asm volatile("s_waitcnt lgkmcnt(0)":::"memory");
  float rli[16];
  #pragma unroll
  for(int r=0;r<16;++r)rli[r]=__builtin_amdgcn_rcpf(wsf[32+crow(r,hie)]);
  bf16*Ow=O+(rowbase+q0+wid*QBLK)*PO;
  { bf16*stg=(bf16*)(shm+LDS2_OST)+wid*4096;
    #pragma unroll
    for(int r=0;r<16;++r){const int orow=crow(r,hie);
      #pragma unroll
      for(int d0=0;d0<4;++d0)stg[orow*128+d0*32+r32e]=__float2bfloat16(o[d0][r]*rli[r]);}
    asm volatile("s_waitcnt lgkmcnt(0)":::"memory");
    #pragma unroll
    for(int i=0;i<8;++i){const int row=i*4+(lane_e>>4),ch=lane_e&15; const u32x4 v=*(const u32x4*)(stg+row*128+ch*8); ATTN_STORE16(Ow+(long)row*PO+ch*8,v);} }
  asm volatile("s_waitcnt lgkmcnt(0)\n\ts_barrier":::"memory");
  #undef DMA_K
  #undef DMA_V
  #undef CMASK
  #undef START
  #undef RESC
  #undef ROT
}
constexpr int ATTN_LDS_BYTES=LDS2_BYTES;
#undef SBAR
#undef WAIT_BAR
}
#define GAS __attribute__((address_space(1)))
#define LAS __attribute__((address_space(3)))
typedef unsigned short bf16;
typedef unsigned v4u __attribute__((ext_vector_type(4)));
typedef float f32x4 __attribute__((ext_vector_type(4)));
typedef short bf16x8 __attribute__((ext_vector_type(8)));
typedef GAS unsigned gu32;
typedef GAS unsigned long long gu64;
#define RLX_AGENT __ATOMIC_RELAXED, __HIP_MEMORY_SCOPE_AGENT
#define LDS_WAIT() asm volatile("s_waitcnt lgkmcnt(0)" ::: "memory")
#define VM_WAIT() asm volatile("s_waitcnt vmcnt(0)" ::: "memory")
__device__ __forceinline__ unsigned long long rt() { return __builtin_amdgcn_s_memrealtime(); }
__device__ __forceinline__ unsigned f2bf(float f) { unsigned u = __builtin_bit_cast(unsigned, f); return (u + 0x7fffu + ((u >> 16) & 1u)) >> 16; }
__device__ __forceinline__ unsigned pk2(float lo, float hi) { return f2bf(lo) | (f2bf(hi) << 16); }

#define XB_TMO      128
#define XB_XCNT(j)  (256  + 64 * (j))
#define XB_XSUB(j)  (1280 + 64 * (j))
#define XB_XGEN(j)  (2304 + 64 * (j))
#define XB_TOP      3328
#define XB_TOPGEN   3392
#define XCD_BAR_WORDS 3456
#define XB_SPIN_CAP (1u << 18)

__device__ __forceinline__ unsigned xb_ld(unsigned* p)              { return __hip_atomic_load(p, __ATOMIC_RELAXED, __HIP_MEMORY_SCOPE_AGENT); }
__device__ __forceinline__ unsigned xb_add(unsigned* p, unsigned v) { return __hip_atomic_fetch_add(p, v, __ATOMIC_RELAXED, __HIP_MEMORY_SCOPE_AGENT); }
__device__ __forceinline__ unsigned xb_xcc_id() { return (unsigned)__builtin_amdgcn_s_getreg((3 << 11) | 20) & 0xFu; }
#define XB_SPIN(cond, bar) do { unsigned _sp = 0; while (cond) { __builtin_amdgcn_s_sleep(1); \
    if ((++_sp & 255u) == 0u) { if (xb_ld(&(bar)[XB_TMO])) break; if (_sp > XB_SPIN_CAP) { atomicAdd(&(bar)[XB_TMO], 1u); break; } } } } while (0)

struct XcdBarrier {
    unsigned* bar; unsigned x;
    volatile LAS unsigned* st;
};

__device__ __forceinline__ XcdBarrier xcd_barrier_post(unsigned* bar, volatile LAS unsigned* st) {
    XcdBarrier b; b.bar = bar; b.x = xb_xcc_id(); b.st = st;
    if (threadIdx.x == 0) (void)xb_add(&bar[XB_XCNT(b.x)], 1u);
    return b;
}
__device__ __forceinline__ void xcd_barrier_complete(unsigned* bar, unsigned x, unsigned& nloc, unsigned& nx) {
    const unsigned G = gridDim.x * gridDim.y * gridDim.z;
    unsigned sum, cnt, mine, sp = 0u;
    for (;;) {
        sum = 0u; cnt = 0u; mine = 0u;
#pragma unroll
        for (unsigned j = 0; j < 16; ++j) { const unsigned c = xb_ld(&bar[XB_XCNT(j)]); sum += c; cnt += (c > 0u) ? 1u : 0u; mine = (j == x) ? c : mine; }
        if (sum == G) break;
        __builtin_amdgcn_s_sleep(1);
        if ((++sp & 255u) == 0u) { if (xb_ld(&bar[XB_TMO])) break; if (sp > XB_SPIN_CAP) { atomicAdd(&bar[XB_TMO], 1u); break; } }
    }
    nloc = mine > 0u ? mine : 1u; nx = cnt > 0u ? cnt : 1u;
}

__device__ __forceinline__ void xcd_barrier(const XcdBarrier& b) {
    asm volatile("s_waitcnt vmcnt(0)" ::: "memory");
    __syncthreads();
    if (threadIdx.x == 0) {
        unsigned* bar = b.bar;
        __builtin_amdgcn_s_waitcnt(0);
        unsigned nloc = b.st[0], nx = b.st[1];
        if (nloc == 0u) { xcd_barrier_complete(bar, b.x, nloc, nx); b.st[0] = nloc; b.st[1] = nx; }
        const unsigned old = xb_add(&bar[XB_XSUB(b.x)], 1u);
        const unsigned gen = old / nloc;
        if (old + 1u == (gen + 1u) * nloc) {
            __builtin_amdgcn_fence(__ATOMIC_RELEASE, "agent");
            asm volatile("s_waitcnt vmcnt(0)" ::: "memory");
            const unsigned og = xb_add(&bar[XB_TOP], 1u);
            const unsigned tg = og / nx;
            if (og + 1u == (tg + 1u) * nx) xb_add(&bar[XB_TOPGEN], 1u);
            else XB_SPIN(xb_ld(&bar[XB_TOPGEN]) == tg, bar);
            __builtin_amdgcn_fence(__ATOMIC_ACQUIRE, "agent");
            xb_add(&bar[XB_XGEN(b.x)], 1u);
            asm volatile("s_waitcnt vmcnt(0)" ::: "memory");
        } else {
            XB_SPIN(xb_ld(&bar[XB_XGEN(b.x)]) == gen, bar);
            __builtin_amdgcn_fence(__ATOMIC_ACQUIRE, "agent");
            asm volatile("s_waitcnt vmcnt(0)" ::: "memory");
        }
    }
    __syncthreads();
}
constexpr int NWAVES = 8;
constexpr int BATCH = 4, SEQ = 8192, T = BATCH * SEQ, D = 1024;
constexpr int IN_COLS = 3328, RW_OFF = 1536, RWW = 512;
constexpr int NEXP = 32, TOPK = 4;
constexpr int P_MAX = T * TOPK + NEXP * 256, MAX_TILES = P_MAX / 256;
constexpr float NORM_EPS = 1e-5f, GN_EPS = 64e-5f, LAM_INIT = 0.2f;
constexpr size_t MiB = 1u << 20;
constexpr size_t WS_CTL = 0, CTL_ZERO_BYTES = 128 * 1024;
constexpr size_t WS_BS = 1 * MiB;
constexpr size_t WS_TOPI = 2 * MiB, WS_GATE = 2 * MiB + 512 * 1024, WS_POS = 3 * MiB;
constexpr size_t WS_RGATE = 5 * MiB;
constexpr size_t WS_RSRC = 7 * MiB;
constexpr size_t WS_RWS = 6 * MiB;
constexpr size_t WS_WO = 8 * MiB, WS_WL = 10 * MiB, WS_WIN = 11 * MiB, WS_W1 = 18 * MiB, WS_W2 = 146 * MiB;
constexpr size_t WS_PB = 210 * MiB;
constexpr size_t WS_YB = 418 * MiB;
constexpr size_t WS_LG = 482 * MiB;
constexpr size_t WS_AO = 514 * MiB;
constexpr size_t WS_FR = 706 * MiB;
constexpr size_t WS_XN = 902 * MiB;
constexpr size_t WS_X1 = 210 * MiB;
constexpr size_t WS_H2 = 338 * MiB;
constexpr size_t WS_ACT = 674 * MiB;
constexpr size_t WS_YS = 402 * MiB;
constexpr size_t WS_END = 1024 * MiB;
static_assert(WS_ACT + (size_t)P_MAX * 2048 <= WS_END && WS_YS + (size_t)T * 4 * 2048 <= WS_ACT && WS_XN + (size_t)T * 2048 <= WS_END && WS_FR + (size_t)BATCH * 8 * (SEQ / 16) * 12544 <= WS_XN && WS_AO + (size_t)T * 2048 <= WS_FR, "ws map");
constexpr int CW_TMO = 0, CW_CNT = 64, CW_WQ = 128, CW_DONE5 = 192, CW_AQ = 256, CW_BAR = 4096;
constexpr int RING_OFF = 0, RING_BYTES = 147456;
constexpr int LDSCTL_OFF = RING_BYTES, MISC_OFF = LDSCTL_OFF + 320;
constexpr int HIST_OFF = LDSCTL_OFF + 512, HBASE_OFF = LDSCTL_OFF + 640, PST_OFF = LDSCTL_OFF + 768, TILE_OFF = LDSCTL_OFF + 1024;
constexpr int LDS_BYTES = 163840;
static_assert(TILE_OFF + 4 * (MAX_TILES + 32) <= LDS_BYTES, "LDS map");
struct Args {
    const float* x; const int* positions; const float* attn_norm_w; const float* w_in; const float* shift_mu;
    const float *lq1, *lk1, *lq2, *lk2; const float* subln_w;
    const float *rw_w0, *rw_w2, *rw_a0, *rw_a2, *rw_g2, *rw_k_k, *rw_k_a, *rw_r_k, *rw_lnx_w, *rw_lnx_b;
    const float* w_out; const float* ffn_norm_w; const float* router_w; const float* router_b;
    const float *mlp1_w, *mlp1_b, *mlp2_w, *mlp2_b; const float* final_norm_w;
    float* out; unsigned char* ws; int ph_lo, ph_hi;
};
struct Frame { LAS unsigned char* lds; int tid, lane, wave, vcu, G; };
__device__ __forceinline__ Frame fresh(const Frame& F) { Frame G = F; G.tid = (int)__builtin_amdgcn_workitem_id_x(); asm volatile("" : "+v"(G.tid)); G.lane = G.tid & 63; return G; }
typedef const __attribute__((address_space(4))) Args* KArgs;
__device__ __forceinline__ KArgs get_args() { unsigned long long p = (unsigned long long)__builtin_amdgcn_kernarg_segment_ptr(); asm volatile("" : "+s"(p)); return (KArgs)p; }

__device__ __forceinline__ float wave_sum(float v) {
#pragma unroll
    for (int o = 1; o < 64; o <<= 1) v += __shfl_xor(v, o);
    return v;
}
__device__ __forceinline__ float bf2f(unsigned short h) { return __builtin_bit_cast(float, (unsigned)h << 16); }
__device__ __forceinline__ float bflo(unsigned w) { return __builtin_bit_cast(float, w << 16); }
__device__ __forceinline__ float bfhi(unsigned w) { return __builtin_bit_cast(float, w & 0xffff0000u); }
__device__ __forceinline__ float sigmoidf_(float v) { return 1.0f / (1.0f + __expf(-v)); }
typedef unsigned u32x2 __attribute__((ext_vector_type(2)));
__device__ __forceinline__ unsigned cvtpk(float lo, float hi) { return attn_body::cvtpk_s(lo, hi); }
typedef float f32x16 __attribute__((ext_vector_type(16)));

struct TrItem { f32x4 v[8]; };
__device__ __forceinline__ void tr_load(TrItem& t, const float* W, int N, int item, int lane) {
    const int nblk = N / 32, kb = item / nblk, nb = item % nblk, k0 = 64 * kb, n0 = 32 * nb; const int r = lane >> 3, c4 = (lane & 7) * 4;
#pragma unroll
    for (int p = 0; p < 8; ++p) t.v[p] = *(const f32x4*)(W + (size_t)(k0 + 8 * p + r) * N + n0 + c4);
}
__device__ __forceinline__ void tr_store(const TrItem& t, int K, int N, bf16* WT, LAS float* scr, int item, int lane) {
    LAS unsigned short* T = (LAS unsigned short*)scr; constexpr int PT = 40;
    const int nblk = N / 32, kb = item / nblk, nb = item % nblk, k0 = 64 * kb, n0 = 32 * nb; const int r = lane >> 3, c4 = (lane & 7) * 4;
#pragma unroll
    for (int p = 0; p < 8; ++p) { u32x2 w; w.x = cvtpk(t.v[p][0], t.v[p][1]); w.y = cvtpk(t.v[p][2], t.v[p][3]); *(LAS u32x2*)(T + (8 * p + r) * PT + c4) = w; }
    LDS_WAIT(); asm volatile("" ::: "memory");
    const int gq = lane >> 4, i = lane & 15, q = i >> 2, p4 = (i & 3) * 4, nbk = 16 * (gq & 1);
    const attn_body::lds_cptr tb = (attn_body::lds_cptr)(T + (8 * (gq >> 1) + q) * PT + nbk + p4);
#pragma unroll
    for (int rd = 0; rd < 4; ++rd) {
        const attn_body::s16x4 lo = attn_body::vtr(tb + (16 * rd) * PT * 2), hi = attn_body::vtr(tb + (16 * rd + 4) * PT * 2);
        v4u o; o.x = __builtin_bit_cast(u32x2, lo).x; o.y = __builtin_bit_cast(u32x2, lo).y; o.z = __builtin_bit_cast(u32x2, hi).x; o.w = __builtin_bit_cast(u32x2, hi).y;
        *(GAS v4u*)(WT + (size_t)(n0 + nbk + i) * K + k0 + 16 * rd + 8 * (gq >> 1)) = o; }
    LDS_WAIT(); asm volatile("" ::: "memory");
}
__device__ __forceinline__ void p0_transpose_item(const float* W, int K, int N, bf16* WT, LAS float* scr, int item, int lane) { TrItem t; tr_load(t, W, N, item, lane); tr_store(t, K, N, WT, scr, item, lane); }
__device__ __forceinline__ void tr_store8(const TrItem& t, int K, int N, unsigned char* WT, LAS float* scr, int item, int lane, float scale) {
    constexpr int PT = 36;
    const int nblk = N / 32, kb = item / nblk, nb = item % nblk, k0 = 64 * kb, n0 = 32 * nb; const int r = lane >> 3, c4 = (lane & 7) * 4;
#pragma unroll
    for (int p = 0; p < 8; ++p) *(LAS f32x4*)(scr + (8 * p + r) * PT + c4) = t.v[p] * scale;
    LDS_WAIT(); asm volatile("" ::: "memory");
    const int n = lane & 31, kh = lane >> 5; const LAS float* col = scr + (32 * kh) * PT + n;
    v4u o[2];
#pragma unroll
    for (int q = 0; q < 8; ++q) { const unsigned w = pg8::pk_fp8x4(col[(4 * q) * PT], col[(4 * q + 1) * PT], col[(4 * q + 2) * PT], col[(4 * q + 3) * PT]);
        if ((q & 3) == 0) o[q >> 2].x = w; else if ((q & 3) == 1) o[q >> 2].y = w; else if ((q & 3) == 2) o[q >> 2].z = w; else o[q >> 2].w = w; }
    GAS v4u* dst = (GAS v4u*)(WT + (size_t)(n0 + n) * K + k0 + 32 * kh);
    dst[0] = o[0]; dst[1] = o[1];
    LDS_WAIT(); asm volatile("" ::: "memory");
}

__device__ __forceinline__ void p0_prologue(const Frame& F, KArgs A) {
    unsigned char* ws = A->ws;
    LAS float* scr = (LAS float*)(F.lds + RING_OFF + F.wave * 16384);
    const int gw = F.vcu * NWAVES + F.wave, NGW = F.G * NWAVES;
    bf16* Win_t = (bf16*)(ws + WS_WIN); bf16* Wo_t = (bf16*)(ws + WS_WO); bf16* Wl_t = (bf16*)(ws + WS_WL);
    constexpr int I_IN = (D / 64) * (IN_COLS / 32), I_O = (D / 64) * (D / 32);
    constexpr int NITEMS = I_IN + I_O;
    for (int it = gw; it < NITEMS; it += NGW) {
        int r = it;
        if (r < I_IN) { p0_transpose_item(A->w_in, D, IN_COLS, Win_t, scr, r, F.lane); continue; } r -= I_IN;
        p0_transpose_item(A->w_out, D, D, Wo_t, scr, r, F.lane);
    }
    const int gt = F.vcu * (NWAVES * 64) + F.tid, NGT = F.G * NWAVES * 64;
    for (int idx = gt; idx < 1536 * 256; idx += NGT) { const int n = idx >> 8, k = idx & 255; float v = 0.f;
        if (n < 512) { if (k < 64) v = A->rw_w2[k * 512 + n]; }
        else if (n < 1024) { if (k >= 64 && k < 128) v = A->rw_a2[(k - 64) * 512 + (n - 512)]; }
        else { if (k >= 128) v = A->rw_g2[(k - 128) * 512 + (n - 1024)]; }
        Wl_t[idx] = (bf16)f2bf(v); }
    float* RWS = (float*)(ws + WS_RWS);
    for (int idx = gt; idx < D * NEXP; idx += NGT) RWS[idx] = A->router_w[idx] * A->ffn_norm_w[idx >> 5];
    float* RGATE0 = (float*)(ws + WS_RGATE);
    int* RSRC = (int*)(ws + WS_RSRC);
    for (int idx = gt; idx < P_MAX; idx += NGT) { RGATE0[idx] = 0.f; RSRC[idx] = 0; }
    bf16* XN = (bf16*)(ws + WS_XN);
    f32x4 nw[4];
#pragma unroll
    for (int j = 0; j < 4; ++j) nw[j] = *((const f32x4*)A->attn_norm_w + F.lane + 64 * j);
    for (int m = gw; m < T; m += NGW) {
        const GAS f32x4* xr = (const GAS f32x4*)(A->x + (size_t)m * D) + F.lane;
        f32x4 v[4]; float s2 = 0.f;
#pragma unroll
        for (int j = 0; j < 4; ++j) { v[j] = xr[64 * j]; s2 += (v[j].x * v[j].x + v[j].y * v[j].y) + (v[j].z * v[j].z + v[j].w * v[j].w); }
        const float rstd = 1.f / sqrtf(wave_sum(s2) * (1.f / D) + NORM_EPS);
        GAS unsigned long long* o8 = (GAS unsigned long long*)(XN + (size_t)m * D) + F.lane;
#pragma unroll
        for (int j = 0; j < 4; ++j) o8[64 * j] = (unsigned long long)pk2(v[j].x * rstd * nw[j].x, v[j].y * rstd * nw[j].y) | ((unsigned long long)pk2(v[j].z * rstd * nw[j].z, v[j].w * rstd * nw[j].w) << 32);
    }
}

template <bool STOP> __device__ __forceinline__ void moe_weight_queue(const Frame& F, KArgs A, gu32* ctl, unsigned stop_at) {
    unsigned char* ws = A->ws;
    LAS float* scr = (LAS float*)(F.lds + RING_OFF + F.wave * 16384);
    unsigned char* W1_t = ws + WS_W1; unsigned char* W2_t = ws + WS_W2;
    constexpr int I_1E = (D / 64) * (2048 / 32), I_2E = (D / 64) * (D / 32), NITEMS = NEXP * I_1E + NEXP * I_2E, GRAB = 4;
    for (;;) {
        if (STOP) { if ((unsigned)__builtin_amdgcn_readfirstlane((int)__hip_atomic_load(ctl + CW_DONE5, __ATOMIC_RELAXED, __HIP_MEMORY_SCOPE_AGENT)) >= stop_at) break; }
        unsigned base = 0u; if (F.lane == 0) base = __hip_atomic_fetch_add(ctl + CW_WQ, (unsigned)GRAB, __ATOMIC_RELAXED, __HIP_MEMORY_SCOPE_AGENT);
        base = (unsigned)__builtin_amdgcn_readfirstlane((int)base);
        if (base >= (unsigned)NITEMS) break;
        for (int k = 0; k < GRAB; ++k) { int r = (int)base + k; if (r >= NITEMS) break;
            TrItem ti;
            if (r < NEXP * I_1E) { const int e = r / I_1E; tr_load(ti, A->mlp1_w + (size_t)e * D * 2048, 2048, r % I_1E, F.lane); tr_store8(ti, D, 2048, W1_t + (size_t)e * 2048 * D, scr, r % I_1E, F.lane, pg8::MOE_WSCALE); }
            else { r -= NEXP * I_1E; const int e = r / I_2E; tr_load(ti, A->mlp2_w + (size_t)e * D * D, D, r % I_2E, F.lane); tr_store8(ti, D, D, W2_t + (size_t)e * D * D, scr, r % I_2E, F.lane, pg8::MOE_WSCALE); } }
    }
}

__device__ __forceinline__ void moe_weight_queue_scan(const Frame& F, KArgs A, gu32* ctl, int stop_word, unsigned stop_at) {
    unsigned char* ws = A->ws;
    LAS float* scr = (LAS float*)(F.lds + RING_OFF + F.wave * 16384);
    unsigned char* W1_t = ws + WS_W1; unsigned char* W2_t = ws + WS_W2;
    constexpr int I_1E = (D / 64) * (2048 / 32), I_2E = (D / 64) * (D / 32), NITEMS = NEXP * I_1E + NEXP * I_2E, GRAB = 4;
    static_assert(I_1E % GRAB == 0 && I_2E % GRAB == 0, "a grab stays inside one expert matrix");
    for (;;) {
        if ((unsigned)__builtin_amdgcn_readfirstlane((int)__hip_atomic_load(ctl + stop_word, __ATOMIC_RELAXED, __HIP_MEMORY_SCOPE_AGENT)) >= stop_at) break;
        unsigned base = 0u; if (F.lane == 0) base = __hip_atomic_fetch_add(ctl + CW_WQ, (unsigned)GRAB, __ATOMIC_RELAXED, __HIP_MEMORY_SCOPE_AGENT);
        base = (unsigned)__builtin_amdgcn_readfirstlane((int)base);
        if (base >= (unsigned)NITEMS) break;
        const int r0 = (int)base; const bool first = r0 < NEXP * I_1E; const int rr = first ? r0 : r0 - NEXP * I_1E, ipe = first ? I_1E : I_2E, e = rr / ipe, it0 = rr % ipe, Nn = first ? 2048 : D;
        const float* Wsrc = first ? A->mlp1_w + (size_t)e * D * 2048 : A->mlp2_w + (size_t)e * D * D; unsigned char* Wdst = first ? W1_t + (size_t)e * 2048 * D : W2_t + (size_t)e * D * D;
#pragma unroll 1
        for (int k = 0; k < GRAB; k += 2) { TrItem ta, tb; tr_load(ta, Wsrc, Nn, it0 + k, F.lane); tr_load(tb, Wsrc, Nn, it0 + k + 1, F.lane);
            tr_store8(ta, D, Nn, Wdst, scr, it0 + k, F.lane, pg8::MOE_WSCALE); tr_store8(tb, D, Nn, Wdst, scr, it0 + k + 1, F.lane, pg8::MOE_WSCALE); }
    }
}

__device__ __forceinline__ void p2_prep(const Frame& F, KArgs A) {
    unsigned char* ws = A->ws;
    bf16* PB = (bf16*)(ws + WS_PB); bf16* LA = (bf16*)(ws + WS_XN);
    const int gw = F.vcu * NWAVES + F.wave, NGW = F.G * NWAVES, lane = F.lane;
    const int g = lane & 7, i0 = 4 * g;
    float invf[4];
#pragma unroll
    for (int i = 0; i < 4; ++i) invf[i] = exp2f(-(float)(i0 + i) * (13.287712379549449f / 32.0f));
    for (int t = gw; t < T; t += NGW) {
        const int s = t & (SEQ - 1);
        const float pos = (float)A->positions[t];
        bf16* row = PB + (size_t)t * IN_COLS;
        float cs[4], sn[4];
#pragma unroll
        for (int i = 0; i < 4; ++i) { const float ang = pos * invf[i]; double rev = (double)ang * 0.15915494309189535; rev -= floor(rev); const float rf = (float)rev;
            sn[i] = __builtin_amdgcn_sinf(rf); cs[i] = __builtin_amdgcn_cosf(rf); }
#pragma unroll
        for (int j = 0; j < 2; ++j) { const int blk = (lane >> 3) + 8 * j; bf16* p1 = row + blk * 64 + i0; bf16* p2 = p1 + 32;
            const u32x2 a = *(const u32x2*)p1, b = *(const u32x2*)p2; const float sc = blk < 8 ? attn_body::C2 : 1.0f;
            const float x1[4] = {bflo(a.x), bfhi(a.x), bflo(a.y), bfhi(a.y)}, x2[4] = {bflo(b.x), bfhi(b.x), bflo(b.y), bfhi(b.y)};
            float o1[4], o2[4];
#pragma unroll
            for (int i = 0; i < 4; ++i) { o1[i] = (x1[i] * cs[i] - x2[i] * sn[i]) * sc; o2[i] = (x2[i] * cs[i] + x1[i] * sn[i]) * sc; }
            u32x2 wa, wb; wa.x = pk2(o1[0], o1[1]); wa.y = pk2(o1[2], o1[3]); wb.x = pk2(o2[0], o2[1]); wb.y = pk2(o2[2], o2[3]);
            *(u32x2*)p1 = wa; *(u32x2*)p2 = wb; }
        {
            const int c4 = lane * 4; const bf16* pc = row + RW_OFF + 1536 + c4;
            const u32x2 cu = *(const u32x2*)pc; u32x2 pu = *(const u32x2*)(pc - (s > 0 ? IN_COLS : 0)); pu.x = s > 0 ? pu.x : 0u; pu.y = s > 0 ? pu.y : 0u;
            const f32x4 mu = *(const f32x4*)(A->shift_mu + 1536 + c4);
            const float cur[4] = {bflo(cu.x), bfhi(cu.x), bflo(cu.y), bfhi(cu.y)}, prv[4] = {bflo(pu.x), bfhi(pu.x), bflo(pu.y), bfhi(pu.y)};
            f32x4 v, o;
#pragma unroll
            for (int i = 0; i < 4; ++i) v[i] = cur[i] + mu[i] * (prv[i] - cur[i]);
            if (c4 < 64) { for (int i = 0; i < 4; ++i) { const float e2 = __expf(2.0f * v[i]); o[i] = 1.0f - 2.0f * __builtin_amdgcn_rcpf(e2 + 1.0f); } }
            else if (c4 < 128) o = v;
            else { for (int i = 0; i < 4; ++i) o[i] = __builtin_amdgcn_rcpf(1.0f + __expf(-v[i])); }
            u32x2 w; w.x = pk2(o[0], o[1]); w.y = pk2(o[2], o[3]);
            *(u32x2*)(LA + (size_t)t * 256 + c4) = w;
        }
    }
}

constexpr int FR_KA = 0, FR_RT = 2048, FR_AU = 4096, FR_AY = 5120, FR_AS = 6144, FR_VT = 10240, FR_GC = 12288, FR_BYTES = 12544, NCHUNK = SEQ / 16;
#define SC_MFMA(a, b, c) __builtin_amdgcn_mfma_f32_16x16x32_bf16(__builtin_bit_cast(bf16x8, a), __builtin_bit_cast(bf16x8, b), c, 0, 0, 0)
template <int CTRL> __device__ __forceinline__ float dpp_f(float v) { return __builtin_bit_cast(float, __builtin_amdgcn_update_dpp(0, __builtin_bit_cast(int, v), CTRL, 0xF, 0xF, true)); }
__device__ __forceinline__ f32x4 mm16(const f32x4& XT, const f32x4& Y) {
    f32x4 o = {0.f, 0.f, 0.f, 0.f};
#pragma unroll
    for (int s = 0; s < 4; ++s) o = __builtin_amdgcn_mfma_f32_16x16x4f32(XT[s], Y[s], o, 0, 0, 0);
    return o;
}
__device__ __forceinline__ v4u pack8(const float* x) { v4u o; o.x = cvtpk(x[0], x[1]); o.y = cvtpk(x[2], x[3]); o.z = cvtpk(x[4], x[5]); o.w = cvtpk(x[6], x[7]); return o; }
__device__ __forceinline__ f32x4 shift4(const bf16* pc, bool has_prev, const float* mu) {
    const u32x2 cu = *(const u32x2*)pc; u32x2 pu = *(const u32x2*)(pc - (has_prev ? IN_COLS : 0));
    pu.x = has_prev ? pu.x : 0u; pu.y = has_prev ? pu.y : 0u;
    const f32x4 m = *(const f32x4*)mu;
    const float cur[4] = {bflo(cu.x), bfhi(cu.x), bflo(cu.y), bfhi(cu.y)}, prv[4] = {bflo(pu.x), bfhi(pu.x), bflo(pu.y), bfhi(pu.y)};
    f32x4 v;
#pragma unroll
    for (int i = 0; i < 4; ++i) v[i] = cur[i] + m[i] * (prv[i] - cur[i]);
    return v;
}
struct PrepRaw { v4u lab[8]; u32x2 rc[4], rp[4], kc[4], kp[4], vc[4], vp[4]; };
__device__ __forceinline__ void prep_load_la(PrepRaw& R, const bf16* LA, int ci, int i, int g) {
    const int bh = ci / NCHUNK, chk = ci % NCHUNK, b = bh >> 3;
    const bf16* pla = LA + ((size_t)b * SEQ + chk * 16 + i) * 256 + 8 * g;
#pragma unroll
    for (int sx = 0; sx < 8; ++sx) R.lab[sx] = *(const v4u*)(pla + 32 * sx);
}
__device__ __forceinline__ void prep_load_rkv(PrepRaw& R, const bf16* PB, int ci, int i, int g) {
    const int bh = ci / NCHUNK, chk = ci % NCHUNK, b = bh >> 3, h = bh & 7;
    const size_t t = (size_t)b * SEQ + chk * 16 + i; const bool hp = (chk * 16 + i) > 0;
    const bf16* prow = PB + t * IN_COLS + RW_OFF + h * 64 + 4 * g; const bf16* pprev = prow - (hp ? IN_COLS : 0);
#pragma unroll
    for (int q = 0; q < 4; ++q) {
        R.rc[q] = *(const u32x2*)(prow + 16 * q); R.rp[q] = *(const u32x2*)(pprev + 16 * q);
        R.kc[q] = *(const u32x2*)(prow + 512 + 16 * q); R.kp[q] = *(const u32x2*)(pprev + 512 + 16 * q);
        R.vc[q] = *(const u32x2*)(prow + 1024 + 16 * q); R.vp[q] = *(const u32x2*)(pprev + 1024 + 16 * q); }
}
__device__ __forceinline__ f32x4 shiftr(const u32x2 cu, u32x2 pu, bool hp, const f32x4 m) {
    pu.x = hp ? pu.x : 0u; pu.y = hp ? pu.y : 0u;
    const float cur[4] = {bflo(cu.x), bfhi(cu.x), bflo(cu.y), bfhi(cu.y)}, prv[4] = {bflo(pu.x), bfhi(pu.x), bflo(pu.y), bfhi(pu.y)};
    f32x4 v;
#pragma unroll
    for (int k = 0; k < 4; ++k) v[k] = cur[k] + m[k] * (prv[k] - cur[k]);
    return v;
}
__device__ __forceinline__ void prep_body(PrepRaw& R, int ci, int ci_next, const bf16* LA, const bf16* PB, bf16* LG, const LAS unsigned char* WLF, int lane_in, LAS unsigned short* TB, const LAS float* CST, float* BS, unsigned char* FR) {
    int lane = lane_in; asm volatile("" : "+v"(lane));
    const int i = lane & 15, g = lane >> 4;
    LAS unsigned short* TK = TB + 1024; LAS unsigned short* TV = TB + 2048;
    {
        const int bh = ci / NCHUNK, chk = ci % NCHUNK, b = bh >> 3, h = bh & 7;
        const size_t t0 = (size_t)b * SEQ + chk * 16, t = t0 + i;
        const bool hp = (chk * 16 + i) > 0;
        float nlw[16], av[16], kkv[16], km[16], rr[16], vs[16]; float ss = 0.f, bsum = 0.f;
#pragma unroll
        for (int q = 0; q < 4; ++q) {
            const LAS f32x4* cq = (const LAS f32x4*)(CST + 16 * q + 4 * g);
            const f32x4 r4 = shiftr(R.rc[q], R.rp[q], hp, cq[0]), ks4 = shiftr(R.kc[q], R.kp[q], hp, cq[16]), v4 = shiftr(R.vc[q], R.vp[q], hp, cq[32]);
            const f32x4 w04 = cq[48], a04 = cq[64], kk4 = cq[80], ka4 = cq[96], rk4 = cq[112];
            const LAS v4u* wq = (const LAS v4u*)(WLF + (q * 8) * 1024) + lane; const f32x4 zl = {0.f, 0.f, 0.f, 0.f};
            const f32x4 lw = SC_MFMA(wq[64], R.lab[1], SC_MFMA(wq[0], R.lab[0], zl)), la = SC_MFMA(wq[192], R.lab[3], SC_MFMA(wq[128], R.lab[2], zl));
            const f32x4 gg = SC_MFMA(wq[448], R.lab[7], SC_MFMA(wq[384], R.lab[6], SC_MFMA(wq[320], R.lab[5], SC_MFMA(wq[256], R.lab[4], zl))));
            { u32x2 go; go.x = cvtpk(gg[0], gg[1]); go.y = cvtpk(gg[2], gg[3]); *(u32x2*)(LG + t * RWW + h * 64 + 16 * q + 4 * g) = go; }
#pragma unroll
            for (int j = 0; j < 4; ++j) { const int x = q * 4 + j;
                const float u = fminf(-(w04[j] + lw[j]), 60.f);
                nlw[x] = -0.6065306597126334f * __builtin_amdgcn_rcpf(1.0f + __expf(u));
                av[x] = __builtin_amdgcn_rcpf(1.0f + __expf(-(a04[j] + la[j])));
                kkv[x] = ks4[j] * kk4[j]; ss += kkv[x] * kkv[x];
                km[x] = ks4[j] * (1.0f + (av[x] - 1.0f) * ka4[j]);
                rr[x] = r4[j]; vs[x] = v4[j]; bsum += r4[j] * km[x] * rk4[j]; }
        }
        ss += __shfl_xor(ss, 16); ss += __shfl_xor(ss, 32); bsum += __shfl_xor(bsum, 16); bsum += __shfl_xor(bsum, 32);
        const float rn = fminf(__builtin_amdgcn_rsqf(ss), 1e12f);
        if (g == 0) BS[t * 8 + h] = bsum;
        float Ka[16], Bt[16], Kt[16], Rt[16], gam[16];
#pragma unroll
        for (int x = 0; x < 16; ++x) {
            float c = nlw[x];
            c += dpp_f<0x111>(c); c += dpp_f<0x112>(c); c += dpp_f<0x114>(c); c += dpp_f<0x118>(c);
            const float gm = __expf(c), ig = __builtin_amdgcn_rcpf(gm), kk = kkv[x] * rn; float gm1 = dpp_f<0x111>(gm); gm1 = i == 0 ? 1.0f : gm1;
            gam[x] = gm; Ka[x] = gm1 * kk; Bt[x] = kk * av[x] * ig; Kt[x] = km[x] * ig; Rt[x] = gm * rr[x];
        }
        const v4u pKa0 = pack8(Ka), pKa1 = pack8(Ka + 8), pRt0 = pack8(Rt), pRt1 = pack8(Rt + 8), pBt0 = pack8(Bt), pBt1 = pack8(Bt + 8), pKt0 = pack8(Kt), pKt1 = pack8(Kt + 8);
#pragma unroll
        for (int x = 0; x < 16; ++x) { const int k = 16 * (x >> 2) + 4 * g + (x & 3); const unsigned bk = cvtpk(Bt[x], Kt[x]), vv = cvtpk(vs[x], 0.f);
            TB[k * 16 + i] = (unsigned short)bk; TK[k * 16 + i] = (unsigned short)(bk >> 16); TV[k * 16 + i] = (unsigned short)vv; }
        if (ci_next >= 0) prep_load_rkv(R, PB, ci_next, i, g);
        const f32x4 z4 = {0.f, 0.f, 0.f, 0.f};
        f32x4 N = SC_MFMA(pBt1, pKa1, SC_MFMA(pBt0, pKa0, z4)), NT = SC_MFMA(pKa1, pBt1, SC_MFMA(pKa0, pBt0, z4)), MkT = SC_MFMA(pKa1, pKt1, SC_MFMA(pKa0, pKt0, z4));
        f32x4 Rb = SC_MFMA(pBt1, pRt1, SC_MFMA(pBt0, pRt0, z4)), Rk = SC_MFMA(pKt1, pRt1, SC_MFMA(pKt0, pRt0, z4));
        f32x4 I1, IN2T, IN4T, IN8;
#pragma unroll
        for (int r = 0; r < 4; ++r) { const int row = 4 * g + r; I1[r] = row == i ? 1.f : 0.f;
            N[r] = row < i ? N[r] : 0.f; NT[r] = i < row ? NT[r] : 0.f; MkT[r] = i < row ? MkT[r] : 0.f; Rb[r] = row <= i ? Rb[r] : 0.f; Rk[r] = row <= i ? Rk[r] : 0.f; }
        const f32x4 N2 = mm16(NT, N), N2T = mm16(N, NT), N4 = mm16(N2T, N2), N4T = mm16(N2, N2T), N8 = mm16(N4T, N4);
        IN2T = I1 + N2T; IN4T = I1 + N4T; IN8 = I1 + N8;
        const f32x4 H1 = mm16(IN4T, IN8), H2 = mm16(IN2T, H1); const f32x4 F1T = I1 - NT; const f32x4 Tinv = mm16(F1T, H2), Wm = mm16(MkT, Tinv);
        unsigned char* fb = FR + (size_t)ci * FR_BYTES + lane * 16;
        *(v4u*)(fb + FR_KA) = pKa0; *(v4u*)(fb + FR_KA + 1024) = pKa1;
        *(v4u*)(fb + FR_RT) = pRt0; *(v4u*)(fb + FR_RT + 1024) = pRt1;
        { const float au[8] = {-Tinv[0], -Tinv[1], -Tinv[2], -Tinv[3], -Wm[0], -Wm[1], -Wm[2], -Wm[3]}; *(v4u*)(fb + FR_AU) = pack8(au);
          const float ay[8] = {Rb[0], Rb[1], Rb[2], Rb[3], Rk[0], Rk[1], Rk[2], Rk[3]}; *(v4u*)(fb + FR_AY) = pack8(ay); }
        if (ci_next >= 0) prep_load_la(R, LA, ci_next, i, g);
        LDS_WAIT(); asm volatile("" ::: "memory");
#pragma unroll
        for (int i4 = 0; i4 < 4; ++i4) { const u32x2 bq = *(const LAS u32x2*)(TB + (16 * i4 + i) * 16 + 4 * g), kq = *(const LAS u32x2*)(TK + (16 * i4 + i) * 16 + 4 * g);
            v4u o; o.x = bq.x; o.y = bq.y; o.z = kq.x; o.w = kq.y; *(v4u*)(fb + FR_AS + i4 * 1024) = o;
            const u32x2 vq = *(const LAS u32x2*)(TV + (16 * i4 + i) * 16 + 4 * g);
            *(u32x2*)(FR + (size_t)ci * FR_BYTES + FR_VT + i4 * 512 + lane * 8) = vq; }
        LDS_WAIT(); asm volatile("" ::: "memory");
        if (i == 15) { float* gc = (float*)(FR + (size_t)ci * FR_BYTES + FR_GC) + g * 16;
#pragma unroll
            for (int q = 0; q < 4; ++q) *(f32x4*)(gc + 4 * q) = (f32x4){gam[4 * q], gam[4 * q + 1], gam[4 * q + 2], gam[4 * q + 3]}; }
    }
}
__device__ __forceinline__ void p4_chunk_prep(const Frame& F, KArgs A) {
    unsigned char* ws = A->ws;
    const bf16* LA = (const bf16*)(ws + WS_XN); const bf16* PB = (const bf16*)(ws + WS_PB); bf16* LG = (bf16*)(ws + WS_LG); const bf16* Wl_t = (const bf16*)(ws + WS_WL);
    float* BS = (float*)(ws + WS_BS); unsigned char* FR = ws + WS_FR;
    const int gw = F.vcu * NWAVES + F.wave, lane = F.lane, i = lane & 15, g = lane >> 4;
    LAS unsigned short* TB = (LAS unsigned short*)(F.lds + RING_OFF + F.wave * 8192); LAS float* CST = (LAS float*)(TB + 3072);
    LAS unsigned char* WLF = F.lds + RING_OFF + 65536;
    constexpr int CPW = (BATCH * 8 * NCHUNK) / (256 * NWAVES);
    static_assert(CPW == 8 && NCHUNK % (CPW * NWAVES) == 0, "a workgroup's chunks share one head");
    const int ci0 = gw * CPW;
    { const int h = ((F.vcu * NWAVES * CPW) / NCHUNK) & 7;
#pragma unroll
      for (int k = 0; k < 4; ++k) { const int e = F.tid + 512 * k, q = e >> 9, sx = (e >> 6) & 7, l = e & 63;
          const int n = (sx < 2 ? 0 : sx < 4 ? 512 : 1024) + h * 64 + 16 * q + (l & 15);
          *(LAS v4u*)(WLF + (size_t)e * 16) = *(const v4u*)(Wl_t + (size_t)n * 256 + 32 * sx + 8 * (l >> 4)); }
      const int c = h * 64 + lane;
      CST[lane] = A->shift_mu[c]; CST[64 + lane] = A->shift_mu[512 + c]; CST[128 + lane] = A->shift_mu[1024 + c];
      CST[192 + lane] = A->rw_w0[c]; CST[256 + lane] = A->rw_a0[c]; CST[320 + lane] = A->rw_k_k[c]; CST[384 + lane] = A->rw_k_a[c]; CST[448 + lane] = A->rw_r_k[c];
      __syncthreads(); }
    if (ci0 >= BATCH * 8 * NCHUNK) return;
    PrepRaw ra;
    prep_load_la(ra, LA, ci0, i, g); prep_load_rkv(ra, PB, ci0, i, g);
#pragma unroll 1
    for (int cj = 0; cj < CPW; ++cj) prep_body(ra, ci0 + cj, cj + 1 < CPW ? ci0 + cj + 1 : -1, LA, PB, LG, WLF, lane, TB, CST, BS, FR);
}

__device__ __forceinline__ void scan_phase3(const Frame& F, KArgs A, int bh) {
    constexpr int GRP = 4, NGRP = NCHUNK / GRP, SLOT = 13312, FBUF = GRP * SLOT, YOFF = 2 * FBUF, YBUF = GRP * 16 * 64 * 4;
    static_assert(YOFF + 2 * YBUF <= RING_BYTES, "scan rings fit the LDS ring region");
    LAS unsigned char* L = F.lds + RING_OFF;
    const unsigned char* fr = A->ws + WS_FR + (size_t)bh * NCHUNK * FR_BYTES;
    const int lane = F.lane, b = bh >> 3, h = bh & 7;
    if (F.wave >= 4) {
        const int io = F.wave - 4;
        bf16* yb = (bf16*)(A->ws + WS_YB) + (size_t)b * SEQ * RWW + h * 64;
#define SC_ISSUE(n) do { const unsigned char* src_ = fr + (size_t)(n) * GRP * FR_BYTES + lane * 16; const int bo_ = ((n) & 1) * FBUF; \
        _Pragma("unroll") for (int k_ = 0; k_ < 13; ++k_) { const int p_ = io + 4 * k_, ci_ = p_ / 13, pc_ = p_ % 13; \
            __builtin_amdgcn_global_load_lds((const unsigned*)(src_ + (size_t)ci_ * FR_BYTES + pc_ * 1024), (LAS unsigned*)(L + bo_ + ci_ * SLOT + pc_ * 1024), 16, 0, 0); } } while (0)
#define SC_YOUT(n) do { const LAS float* ys_ = (const LAS float*)(L + YOFF + ((n) & 1) * YBUF); \
        _Pragma("unroll") for (int k_ = 0; k_ < 4; ++k_) { const int i4_ = io * 64 + lane + 256 * k_, ci_ = i4_ >> 8, t_ = (i4_ >> 4) & 15, v4_ = i4_ & 15; \
            const f32x4 y_ = *(const LAS f32x4*)(ys_ + i4_ * 4); u32x2 w_; w_.x = cvtpk(y_[0], y_[1]); w_.y = cvtpk(y_[2], y_[3]); *(u32x2*)(yb + ((size_t)((n) * GRP + ci_) * 16 + t_) * RWW + v4_ * 4) = w_; } } while (0)
        SC_ISSUE(0);
        __syncthreads();
        for (int n = 0; n < NGRP; ++n) {
            if (n + 1 < NGRP) SC_ISSUE(n + 1);
            if (n > 0) SC_YOUT(n - 1);
            __syncthreads();
        }
        SC_YOUT(NGRP - 1);
#undef SC_ISSUE
#undef SC_YOUT
    } else {
        const int wv = F.wave, vl = lane & 15, g = lane >> 4;
        f32x4 s0 = {0.f, 0.f, 0.f, 0.f}, s1 = s0, s2 = s0, s3 = s0; const f32x4 zero = {0.f, 0.f, 0.f, 0.f};
        __syncthreads();
        for (int n = 0; n < NGRP; ++n) {
            const LAS unsigned char* fbuf = L + (n & 1) * FBUF; LAS float* ybuf = (LAS float*)(L + YOFF + (n & 1) * YBUF) + (4 * g) * 64 + 16 * wv + vl;
#pragma unroll
            for (int ci = 0; ci < GRP; ++ci) {
                const LAS unsigned char* p = fbuf + ci * SLOT; const LAS unsigned char* q = p + lane * 16;
                const v4u ka0 = *(const LAS v4u*)(q + FR_KA), ka1 = *(const LAS v4u*)(q + FR_KA + 1024), rt0 = *(const LAS v4u*)(q + FR_RT), rt1 = *(const LAS v4u*)(q + FR_RT + 1024);
                const v4u au = *(const LAS v4u*)(q + FR_AU), ay = *(const LAS v4u*)(q + FR_AY);
                const v4u as0 = *(const LAS v4u*)(q + FR_AS), as1 = *(const LAS v4u*)(q + FR_AS + 1024), as2 = *(const LAS v4u*)(q + FR_AS + 2048), as3 = *(const LAS v4u*)(q + FR_AS + 3072);
                const LAS f32x4* gc = (const LAS f32x4*)(p + FR_GC) + g * 4; const f32x4 gc0 = gc[0], gc1 = gc[1], gc2 = gc[2], gc3 = gc[3];
                const u32x2 vt = *(const LAS u32x2*)(p + FR_VT + wv * 512 + lane * 8);
                v4u bS0, bS1; bS0.x = cvtpk(s0[0], s0[1]); bS0.y = cvtpk(s0[2], s0[3]); bS0.z = cvtpk(s1[0], s1[1]); bS0.w = cvtpk(s1[2], s1[3]);
                bS1.x = cvtpk(s2[0], s2[1]); bS1.y = cvtpk(s2[2], s2[3]); bS1.z = cvtpk(s3[0], s3[1]); bS1.w = cvtpk(s3[2], s3[3]);
                f32x4 PT = SC_MFMA(ka0, bS0, zero); PT = SC_MFMA(ka1, bS1, PT);
                f32x4 YT = SC_MFMA(rt0, bS0, zero); YT = SC_MFMA(rt1, bS1, YT);
                v4u bU; bU.x = cvtpk(PT[0], PT[1]); bU.y = cvtpk(PT[2], PT[3]); bU.z = vt.x; bU.w = vt.y;
                const f32x4 UT = SC_MFMA(au, bU, zero);
                bU.x = cvtpk(UT[0], UT[1]); bU.y = cvtpk(UT[2], UT[3]);
                YT = SC_MFMA(ay, bU, YT);
                s0 = SC_MFMA(as0, bU, s0) * gc0; s1 = SC_MFMA(as1, bU, s1) * gc1; s2 = SC_MFMA(as2, bU, s2) * gc2; s3 = SC_MFMA(as3, bU, s3) * gc3;
                LAS float* yo = ybuf + ci * 1024;
                yo[0] = YT[0]; yo[64] = YT[1]; yo[128] = YT[2]; yo[192] = YT[3];
            }
            __syncthreads();
        }
    }
    __syncthreads();
}

__device__ __forceinline__ void attn_queue(const Frame& F, KArgs A, gu32* ctl) {
    const attn_body::bf16* PB = (const attn_body::bf16*)(A->ws + WS_PB); attn_body::bf16* OA = (attn_body::bf16*)(A->ws + WS_XN);
    char* shm = (char*)(F.lds + RING_OFF);
    volatile LAS unsigned* slot = (volatile LAS unsigned*)(F.lds + MISC_OFF) + 16;
    const int x = (int)(blockIdx.x & 7);
    for (;;) {
        if (F.tid == 0) slot[0] = __hip_atomic_fetch_add(ctl + CW_AQ + 64 * x, 1u, __ATOMIC_RELAXED, __HIP_MEMORY_SCOPE_AGENT);
        __syncthreads();
        const int u = __builtin_amdgcn_readfirstlane((int)slot[0]);
        __syncthreads();
        if (u >= 128) break;
        int cb = x + 8 * (u & 3); asm volatile("" : "+s"(cb));
        const int qb = 31 - (u >> 2), b = cb >> 3, h = (cb >> 1) & 3, c = cb & 1;
        const attn_body::bf16* Q = PB + h * 128 + c * 64; const attn_body::bf16* K = PB + 512 + h * 128 + c * 64; const attn_body::bf16* V = PB + 1024 + h * 128;
        attn_body::attn_unit128<8>(b, qb, Q, K, V, OA + h * 256 + c * 128, shm);
    }
}

__device__ __forceinline__ void p6_combine(const Frame& F, KArgs A) {
    unsigned char* ws = A->ws;
    const bf16* OA = (const bf16*)(ws + WS_XN); const bf16* YB = (const bf16*)(ws + WS_YB); const bf16* LG = (const bf16*)(ws + WS_LG);
    const bf16* PB = (const bf16*)(ws + WS_PB); const float* BS = (const float*)(ws + WS_BS);
    bf16* AO = (bf16*)(ws + WS_AO);
    const int gw = F.vcu * NWAVES + F.wave, NGW = F.G * NWAVES, lane = F.lane;
    const float lam = __expf(wave_sum(A->lq1[lane] * A->lk1[lane])) - __expf(wave_sum(A->lq2[lane] * A->lk2[lane])) + LAM_INIT;
    const int hd = lane >> 4, dv = (lane & 15) * 8, c8 = lane * 8, hr = lane >> 3;
    float sw[8], lw[8], lb[8];
#pragma unroll
    for (int i = 0; i < 8; ++i) { sw[i] = A->subln_w[dv + i] * (1.0f - LAM_INIT); lw[i] = A->rw_lnx_w[c8 + i]; lb[i] = A->rw_lnx_b[c8 + i]; }
    for (int t = gw; t < T; t += NGW) {
        const v4u p0 = *(const v4u*)(OA + (size_t)t * 1024 + hd * 256 + dv), p1 = *(const v4u*)(OA + (size_t)t * 1024 + hd * 256 + 128 + dv);
        const float o0[8] = {bflo(p0.x), bfhi(p0.x), bflo(p0.y), bfhi(p0.y), bflo(p0.z), bfhi(p0.z), bflo(p0.w), bfhi(p0.w)};
        const float o1[8] = {bflo(p1.x), bfhi(p1.x), bflo(p1.y), bfhi(p1.y), bflo(p1.z), bfhi(p1.z), bflo(p1.w), bfhi(p1.w)};
        float d[8]; float ss = 0.f;
#pragma unroll
        for (int i = 0; i < 8; ++i) { d[i] = o0[i] - lam * o1[i]; ss += d[i] * d[i]; }
        ss += __shfl_xor(ss, 1); ss += __shfl_xor(ss, 2); ss += __shfl_xor(ss, 4); ss += __shfl_xor(ss, 8);
        const float rs = 1.0f / sqrtf(ss * (1.0f / 128.0f) + NORM_EPS);
        v4u w; w.x = pk2(d[0] * rs * sw[0], d[1] * rs * sw[1]); w.y = pk2(d[2] * rs * sw[2], d[3] * rs * sw[3]); w.z = pk2(d[4] * rs * sw[4], d[5] * rs * sw[5]); w.w = pk2(d[6] * rs * sw[6], d[7] * rs * sw[7]);
        *(v4u*)(AO + (size_t)t * 1024 + hd * 128 + dv) = w;
        const size_t o = (size_t)t * RWW + c8;
        const v4u yp = *(const v4u*)(YB + o); const f32x4 y0 = {bflo(yp.x), bfhi(yp.x), bflo(yp.y), bfhi(yp.y)}, y1 = {bflo(yp.z), bfhi(yp.z), bflo(yp.w), bfhi(yp.w)};
        const bf16* pv = PB + (size_t)t * IN_COLS + RW_OFF + 1024 + c8; const bool hp = (t & (SEQ - 1)) > 0;
        const f32x4 v0 = shift4(pv, hp, A->shift_mu + 1024 + c8), v1 = shift4(pv + 4, hp, A->shift_mu + 1024 + c8 + 4);
        const v4u gp = *(const v4u*)(LG + o);
        const float g[8] = {bflo(gp.x), bfhi(gp.x), bflo(gp.y), bfhi(gp.y), bflo(gp.z), bfhi(gp.z), bflo(gp.w), bfhi(gp.w)};
        const float y[8] = {y0[0], y0[1], y0[2], y0[3], y1[0], y1[1], y1[2], y1[3]}, vv[8] = {v0[0], v0[1], v0[2], v0[3], v1[0], v1[1], v1[2], v1[3]};
        float sm = 0.f;
#pragma unroll
        for (int i = 0; i < 8; ++i) sm += y[i];
        sm += __shfl_xor(sm, 1); sm += __shfl_xor(sm, 2); sm += __shfl_xor(sm, 4);
        const float mean = sm * (1.0f / 64.0f); float sq = 0.f;
#pragma unroll
        for (int i = 0; i < 8; ++i) { const float dd = y[i] - mean; sq += dd * dd; }
        sq += __shfl_xor(sq, 1); sq += __shfl_xor(sq, 2); sq += __shfl_xor(sq, 4);
        const float rg = 1.0f / sqrtf(sq * (1.0f / 64.0f) + GN_EPS), bsc = BS[(size_t)t * 8 + hr];
        float r[8];
#pragma unroll
        for (int i = 0; i < 8; ++i) r[i] = ((y[i] - mean) * rg * lw[i] + lb[i] + bsc * vv[i]) * g[i];
        w.x = pk2(r[0], r[1]); w.y = pk2(r[2], r[3]); w.z = pk2(r[4], r[5]); w.w = pk2(r[6], r[7]);
        *(v4u*)(AO + (size_t)t * 1024 + 512 + c8) = w;
    }
}

__device__ __forceinline__ void p8_router(const Frame& F, KArgs A, gu32* ctl) {
    unsigned char* ws = A->ws;
    const float* X1 = (const float*)(ws + WS_X1); const float* RWS = (const float*)(ws + WS_RWS); unsigned char* H2 = ws + WS_H2;
    int* TOPI = (int*)(ws + WS_TOPI); int* POS = (int*)(ws + WS_POS); float* GATE = (float*)(ws + WS_GATE);
    LAS int* hist = (LAS int*)(F.lds + HIST_OFF); LAS int* hbase = (LAS int*)(F.lds + HBASE_OFF);
    const int lane = F.lane, tile = F.wave * F.G + F.vcu;
    const bool has = tile < T / 32;
    const int r0 = tile * 32, hi = lane >> 5, l31 = lane & 31;
    int sel[4] = {0, 0, 0, 0}, lr[4] = {0, 0, 0, 0}; float gate[4] = {0.f, 0.f, 0.f, 0.f}; float rstd = 0.f;
    if (has) {
        f32x16 acc;
#pragma unroll
        for (int r = 0; r < 16; ++r) acc[r] = 0.f;
        float ssq = 0.f;
        const float* xa = X1 + (size_t)(r0 + l31) * D + 4 * hi; const float* wb = RWS + hi * 128 + l31;
        f32x4 aA[8], aB[8]; float bA[8][4], bB[8][4];
#define P8_LOAD(AS, BS, grp) do { _Pragma("unroll") for (int mm = 0; mm < 8; ++mm) { const int m = (grp) * 8 + mm; AS[mm] = *(const f32x4*)(xa + 8 * m); \
            BS[mm][0] = wb[(8 * m) * 32]; BS[mm][1] = wb[(8 * m + 1) * 32]; BS[mm][2] = wb[(8 * m + 2) * 32]; BS[mm][3] = wb[(8 * m + 3) * 32]; } } while (0)
#define P8_COMP(AS, BS) do { _Pragma("unroll") for (int mm = 0; mm < 8; ++mm) { const f32x4 a = AS[mm]; ssq += (a[0] * a[0] + a[1] * a[1]) + (a[2] * a[2] + a[3] * a[3]); \
            acc = __builtin_amdgcn_mfma_f32_32x32x2f32(a[0], BS[mm][0], acc, 0, 0, 0); acc = __builtin_amdgcn_mfma_f32_32x32x2f32(a[1], BS[mm][1], acc, 0, 0, 0); \
            acc = __builtin_amdgcn_mfma_f32_32x32x2f32(a[2], BS[mm][2], acc, 0, 0, 0); acc = __builtin_amdgcn_mfma_f32_32x32x2f32(a[3], BS[mm][3], acc, 0, 0, 0); } } while (0)
        P8_LOAD(aA, bA, 0);
        for (int gp = 0; gp < 16; gp += 2) {
            P8_LOAD(aB, bB, gp + 1);
            P8_COMP(aA, bA);
            if (gp + 2 < 16) P8_LOAD(aA, bA, gp + 2);
            P8_COMP(aB, bB);
        }
#undef P8_LOAD
#undef P8_COMP
        ssq += __shfl_xor(ssq, 32);
        rstd = 1.0f / sqrtf(ssq * (1.0f / D) + NORM_EPS);
        LAS float* Lw = (LAS float*)(F.lds + RING_OFF + F.wave * 16384 + 8704);
#pragma unroll
        for (int r = 0; r < 16; ++r) Lw[((r & 3) + 8 * (r >> 2) + 4 * hi) * 36 + l31] = acc[r];
        LDS_WAIT(); asm volatile("" ::: "memory");
        if (lane < 32) {
            float val[32];
#pragma unroll
            for (int j = 0; j < 8; ++j) { const f32x4 q = *(const LAS f32x4*)(Lw + lane * 36 + 4 * j); const f32x4 bb = *(const f32x4*)(A->router_b + 4 * j);
                val[4 * j] = q[0] * rstd + bb[0]; val[4 * j + 1] = q[1] * rstd + bb[1]; val[4 * j + 2] = q[2] * rstd + bb[2]; val[4 * j + 3] = q[3] * rstd + bb[3]; }
            unsigned used = 0u; float sv[4];
#pragma unroll
            for (int s = 0; s < 4; ++s) { float best = -INFINITY; int bi = 0;
#pragma unroll
                for (int e = 0; e < 32; ++e) { const bool ok = (((used >> e) & 1u) == 0u) && (val[e] > best); best = ok ? val[e] : best; bi = ok ? e : bi; }
                used |= 1u << bi; sel[s] = bi; sv[s] = best; }
            float ex[4], se = 0.f;
#pragma unroll
            for (int s = 0; s < 4; ++s) { ex[s] = __expf(sv[s] - sv[0]); se += ex[s]; }
            const float inv = 1.0f / se;
#pragma unroll
            for (int s = 0; s < 4; ++s) { gate[s] = ex[s] * inv; lr[s] = __hip_atomic_fetch_add(hist + sel[s], 1, __ATOMIC_RELAXED, __HIP_MEMORY_SCOPE_WORKGROUP); }
        }
    }
    __syncthreads();
    if (F.tid < NEXP) hbase[F.tid] = (int)__hip_atomic_fetch_add(ctl + CW_CNT + F.tid, (unsigned)hist[F.tid], __ATOMIC_RELAXED, __HIP_MEMORY_SCOPE_AGENT);
    __syncthreads();
    if (has) {
        if (lane < 32) { const size_t t4 = (size_t)(r0 + lane) * 4;
#pragma unroll
            for (int s = 0; s < 4; ++s) { TOPI[t4 + s] = sel[s]; POS[t4 + s] = hbase[sel[s]] + lr[s]; GATE[t4 + s] = gate[s]; } }
        f32x4 nw[4];
#pragma unroll
        for (int j = 0; j < 4; ++j) nw[j] = *((const f32x4*)A->ffn_norm_w + lane + 64 * j);
        for (int r4 = 0; r4 < 32; r4 += 4) {
            f32x4 v[4][4];
#pragma unroll
            for (int q = 0; q < 4; ++q) { const f32x4* xr = (const f32x4*)(X1 + (size_t)(r0 + r4 + q) * D) + lane;
#pragma unroll
                for (int j = 0; j < 4; ++j) v[q][j] = xr[64 * j]; }
#pragma unroll
            for (int q = 0; q < 4; ++q) {
                const float rs = __builtin_bit_cast(float, __builtin_amdgcn_readlane(__builtin_bit_cast(int, rstd), r4 + q));
                unsigned* o4 = (unsigned*)(H2 + (size_t)(r0 + r4 + q) * D) + lane;
#pragma unroll
                for (int j = 0; j < 4; ++j) o4[64 * j] = pg8::pk_fp8x4(v[q][j][0] * rs * nw[j][0], v[q][j][1] * rs * nw[j][1], v[q][j][2] * rs * nw[j][2], v[q][j][3] * rs * nw[j][3]);
            }
        }
    }
}

__device__ __forceinline__ void moe_tables(const Frame& F, gu32* ctl) {
    LAS int* pst = (LAS int*)(F.lds + PST_OFF); LAS int* te = (LAS int*)(F.lds + TILE_OFF);
    __syncthreads();
    if (F.tid == 0) { int acc = 0;
        for (int e = 0; e < NEXP; ++e) { pst[e] = acc; const int c = (int)__hip_atomic_load(ctl + CW_CNT + e, __ATOMIC_RELAXED, __HIP_MEMORY_SCOPE_AGENT); acc += ((c + 255) >> 8) << 8; }
        pst[32] = acc; pst[33] = acc >> 8; }
    __syncthreads();
    if (F.tid < NEXP) { for (int tl = pst[F.tid] >> 8; tl < (pst[F.tid + 1] >> 8); ++tl) te[tl] = F.tid; }
    __syncthreads();
}

__device__ __forceinline__ void p9_gather(const Frame& F, KArgs A) {
    unsigned char* ws = A->ws;
    int* RSRC = (int*)(ws + WS_RSRC);
    const int* TOPI = (const int*)(ws + WS_TOPI); const int* POS = (const int*)(ws + WS_POS); const float* GATE = (const float*)(ws + WS_GATE);
    float* RGATE = (float*)(ws + WS_RGATE);
    const LAS int* pst = (const LAS int*)(F.lds + PST_OFF);
    const int gt = F.vcu * (NWAVES * 64) + F.tid, NGT = F.G * NWAVES * 64;
    for (int idx = gt; idx < T * TOPK; idx += NGT) { const int dest = pst[TOPI[idx]] + POS[idx]; RSRC[dest] = idx >> 2; RGATE[dest] = GATE[idx]; }
}

__device__ __forceinline__ void p12_final(const Frame& F, KArgs A) {
    unsigned char* ws = A->ws;
    const float* X1 = (const float*)(ws + WS_X1); const unsigned char* YS = ws + WS_YS;
    const int* TOPI = (const int*)(ws + WS_TOPI); const int* POS = (const int*)(ws + WS_POS); const LAS int* pst = (const LAS int*)(F.lds + PST_OFF);
    const int gw = F.vcu * NWAVES + F.wave, NGW = F.G * NWAVES, lane = F.lane;
    f32x4 nw[4];
#pragma unroll
    for (int j = 0; j < 4; ++j) nw[j] = *((const f32x4*)A->final_norm_w + lane + 64 * j);
    for (int t = gw; t < T; t += NGW) {
        f32x4 v[4]; float ss = 0.f;
#pragma unroll
        for (int j = 0; j < 4; ++j) v[j] = *((const f32x4*)(X1 + (size_t)t * D) + lane + 64 * j);
#pragma unroll
        for (int s = 0; s < 4; ++s) { const unsigned* yr = (const unsigned*)(YS + (size_t)(pst[TOPI[t * 4 + s]] + POS[t * 4 + s]) * D) + lane;
#pragma unroll
            for (int j = 0; j < 4; ++j) { const unsigned p = yr[64 * j]; const attn_body::f32x2_t lo = __builtin_amdgcn_cvt_pk_f32_fp8((int)p, false), hi = __builtin_amdgcn_cvt_pk_f32_fp8((int)p, true);
                v[j][0] += lo[0] * pg8::MOE_YSCALE_INV; v[j][1] += lo[1] * pg8::MOE_YSCALE_INV; v[j][2] += hi[0] * pg8::MOE_YSCALE_INV; v[j][3] += hi[1] * pg8::MOE_YSCALE_INV; } }
#pragma unroll
        for (int j = 0; j < 4; ++j) ss += (v[j][0] * v[j][0] + v[j][1] * v[j][1]) + (v[j][2] * v[j][2] + v[j][3] * v[j][3]);
        const float rs = 1.0f / sqrtf(wave_sum(ss) * (1.0f / D) + NORM_EPS);
#pragma unroll
        for (int j = 0; j < 4; ++j) __builtin_nontemporal_store(v[j] * rs * nw[j], (f32x4*)(A->out + (size_t)t * D) + lane + 64 * j);
    }
}
#ifndef MK_N_LAUNCHES
#define MK_N_LAUNCHES 1
#endif
constexpr int N_PHASES = 13;
__global__ void __launch_bounds__(NWAVES * 64, 2) mk_fwd(Args A_by_value_unused) {
    extern __shared__ __attribute__((aligned(16))) unsigned char lds[];
    Frame F;
    F.lds = (LAS unsigned char*)lds;
    volatile LAS unsigned* MISC = (volatile LAS unsigned*)(F.lds + MISC_OFF);
    F.tid = threadIdx.x; F.lane = F.tid & 63; F.wave = __builtin_amdgcn_readfirstlane(F.tid >> 6);
    F.G = gridDim.x; { const int bx = blockIdx.x; F.vcu = (F.G % 8 == 0) ? (bx % 8) * (F.G / 8) + bx / 8 : bx; }
    unsigned char* ws = get_args()->ws;
    gu32* ctl = (gu32*)(ws + WS_CTL);
    for (int u = F.tid; u < (LDS_BYTES - LDSCTL_OFF) / 4; u += NWAVES * 64) ((LAS unsigned*)(F.lds + LDSCTL_OFF))[u] = 0u;
    __syncthreads();
    XcdBarrier bar = xcd_barrier_post((unsigned*)(ctl + CW_BAR), MISC + 8);
    const int lo = get_args()->ph_lo, hi = get_args()->ph_hi;
#if defined(PROBE_A)
#ifndef PROBE_SCALE
#define PROBE_SCALE 0.25f
#endif
    unsigned long long* tsw = (unsigned long long*)(ws + WS_CTL + 65536);
    int n_stamp = 0;
#define STAMP() do { if (blockIdx.x == 0 && F.tid == 0) tsw[n_stamp] = rt(); ++n_stamp; } while (0)
#else
#define STAMP() do { } while (0)
#endif
    STAMP();
#define IN(k) (lo <= (k) && (k) < hi)
#define SEAM(k) do { if (IN(k) && IN((k) + 1)) xcd_barrier(bar); STAMP(); } while (0)
    bf16* XN = (bf16*)(ws + WS_XN); bf16* PB = (bf16*)(ws + WS_PB);

    if (IN(0)) { p0_prologue(fresh(F), get_args()); SEAM(0); }
    if (IN(1)) {
        pg8::Gemm g{XN, (const bf16*)(ws + WS_WIN), T, IN_COLS, D}; pg8::StaticOrder S; S.init(T, IN_COLS, F.G, (int)blockIdx.x);
        pg8::EpiBf16<0> E{PB, IN_COLS, nullptr, 0, 0, 1.f};
        pg8::gemm_phase<pg8::EpiBf16<0>, pg8::StaticOrder, PG8_ALIGN, PG8_SP2>(F.lds + RING_OFF, g, S, E);
        { constexpr int NU = (T / 256) * (IN_COLS / 256), FULL = NU / 256, REM = NU % 256;
          if (REM != 0 && F.G == 256) { if ((int)blockIdx.x < REM) { if (F.tid == 0) __hip_atomic_fetch_add(ctl + CW_DONE5, 1u, __ATOMIC_RELAXED, __HIP_MEMORY_SCOPE_AGENT); }
                                        else { __syncthreads(); moe_weight_queue_scan(fresh(F), get_args(), ctl, CW_DONE5, (unsigned)(REM - 8)); } } (void)FULL; }
        SEAM(1);
    }
    if (IN(2)) { p2_prep(fresh(F), get_args()); SEAM(2); }
    if (IN(4)) { p4_chunk_prep(fresh(F), get_args()); SEAM(4); }
    if (IN(5)) {
        constexpr int NS = BATCH * 8;
        if ((F.vcu & 7) == 0 && (F.vcu >> 3) < NS) { scan_phase3(fresh(F), get_args(), F.vcu >> 3); moe_weight_queue_scan(fresh(F), get_args(), ctl, CW_AQ + 64 * (int)(blockIdx.x & 7), 128u); }
        attn_queue(fresh(F), get_args(), ctl);
        moe_weight_queue<false>(fresh(F), get_args(), ctl, 0u);
        SEAM(5);
    }
    if (IN(6)) { p6_combine(fresh(F), get_args()); SEAM(6); }
    if (IN(7)) {
        pg8::Gemm g{(const bf16*)(ws + WS_AO), (const bf16*)(ws + WS_WO), T, D, D}; pg8::StaticOrder S; S.init(T, D, F.G, (int)blockIdx.x);
        pg8::EpiResF32 E{get_args()->x, (float*)(ws + WS_X1), D};
        pg8::gemm_phase<pg8::EpiResF32, pg8::StaticOrder, PG8_ALIGN, PG8_SP2>(F.lds + RING_OFF, g, S, E);
        SEAM(7);
    }
    if (IN(8)) { p8_router(fresh(F), get_args(), ctl); moe_weight_queue<false>(fresh(F), get_args(), ctl, 0u); SEAM(8); }
    if (IN(9)) { moe_tables(fresh(F), ctl); p9_gather(fresh(F), get_args()); SEAM(9); }
    if (IN(10)) {
        moe_tables(fresh(F), ctl);
        const LAS int* pst = (const LAS int*)(F.lds + PST_OFF);
        pg8::Gemm g{(const bf16*)(ws + WS_H2), (const bf16*)(ws + WS_W1), P_MAX, NEXP * 2048, D, (const int*)(ws + WS_RSRC)};
        pg8::MoeOrder<8> S{pst[33], (int)blockIdx.x, F.G, (const LAS int*)(F.lds + TILE_OFF)};
        pg8::EpiSwiglu E{ws + WS_ACT, get_args()->mlp1_b};
        pg8::gemm_phase<pg8::EpiSwiglu, pg8::MoeOrder<8>, PG8_ALIGN, PG8_SP2, true, true>(F.lds + RING_OFF, g, S, E);
        SEAM(10);
    }
    if (IN(11)) {
        moe_tables(fresh(F), ctl);
        const LAS int* pst = (const LAS int*)(F.lds + PST_OFF);
        pg8::Gemm g{(const bf16*)(ws + WS_ACT), (const bf16*)(ws + WS_W2), P_MAX, NEXP * D, D};
        pg8::MoeOrder<4> S{pst[33], (int)blockIdx.x, F.G, (const LAS int*)(F.lds + TILE_OFF)};
        pg8::EpiMoeOut E{ws + WS_YS, get_args()->mlp2_b, (const float*)(ws + WS_RGATE)};
        pg8::gemm_phase<pg8::EpiMoeOut, pg8::MoeOrder<4>, PG8_ALIGN, PG8_SP2, false, true>(F.lds + RING_OFF, g, S, E);
        SEAM(11);
    }
    if (IN(12)) { moe_tables(fresh(F), ctl); p12_final(fresh(F), get_args()); }
#if defined(PROBE_A)
    xcd_barrier(bar); STAMP();
    if (blockIdx.x == 0 && F.tid == 0) { asm volatile("s_waitcnt vmcnt(0)" ::: "memory"); const float us = (float)(tsw[PROBE_B] - tsw[PROBE_A]) * 0.01f; get_args()->out[12345] = us * PROBE_SCALE; }
#endif
#undef IN
#undef SEAM
}

extern "C" void kernel_launch(void* const* d_in, const int* in_sizes, int n_in, void* d_out, int out_size, void* d_ws, size_t ws_size, hipStream_t stream) {
    static int grid = 0;
    if (grid == 0) {
        if (n_in != 29 || in_sizes[0] != T * D || out_size != T * D || ws_size < WS_END) { fprintf(stderr, "kernel_launch: built for 29 inputs, x/out of %d floats, >= %zu bytes of workspace; got n_in %d, in0 %d, out %d, ws %zu; nothing launched\n", T * D, (size_t)WS_END, n_in, n_in > 0 ? in_sizes[0] : -1, out_size, ws_size); grid = -1; return; }
        int dev = 0, cus = 0, per_cu = 0;
        if (hipGetDevice(&dev) != hipSuccess || hipDeviceGetAttribute(&cus, hipDeviceAttributeMultiprocessorCount, dev) != hipSuccess) { fprintf(stderr, "kernel_launch: device query failed\n"); grid = -1; return; }
        if (hipFuncSetAttribute((const void*)mk_fwd, hipFuncAttributeMaxDynamicSharedMemorySize, LDS_BYTES) != hipSuccess) { fprintf(stderr, "kernel_launch: hipFuncSetAttribute failed\n"); grid = -1; return; }
        if (hipOccupancyMaxActiveBlocksPerMultiprocessor(&per_cu, (const void*)mk_fwd, NWAVES * 64, LDS_BYTES) != hipSuccess || per_cu < 1)
            fprintf(stderr, "kernel_launch: note: occupancy query reports %d workgroups per CU\n", per_cu);
        (void)hipGetLastError();
        grid = cus;
        if (grid != 256) { fprintf(stderr, "kernel_launch: %d CUs; this kernel is built for 256; nothing launched\n", grid); grid = -1; return; }
    }
    if (grid < 0) return;
    if (hipMemsetAsync((char*)d_ws + WS_CTL, 0, CTL_ZERO_BYTES, stream) != hipSuccess) { fprintf(stderr, "kernel_launch: hipMemsetAsync failed\n"); return; }
    Args a{};
    a.x = (const float*)d_in[0]; a.positions = (const int*)d_in[1]; a.attn_norm_w = (const float*)d_in[2]; a.w_in = (const float*)d_in[3]; a.shift_mu = (const float*)d_in[4];
    a.lq1 = (const float*)d_in[5]; a.lk1 = (const float*)d_in[6]; a.lq2 = (const float*)d_in[7]; a.lk2 = (const float*)d_in[8]; a.subln_w = (const float*)d_in[9];
    a.rw_w0 = (const float*)d_in[10]; a.rw_w2 = (const float*)d_in[11]; a.rw_a0 = (const float*)d_in[12]; a.rw_a2 = (const float*)d_in[13]; a.rw_g2 = (const float*)d_in[14];
    a.rw_k_k = (const float*)d_in[15]; a.rw_k_a = (const float*)d_in[16]; a.rw_r_k = (const float*)d_in[17]; a.rw_lnx_w = (const float*)d_in[18]; a.rw_lnx_b = (const float*)d_in[19];
    a.w_out = (const float*)d_in[20]; a.ffn_norm_w = (const float*)d_in[21]; a.router_w = (const float*)d_in[22]; a.router_b = (const float*)d_in[23];
    a.mlp1_w = (const float*)d_in[24]; a.mlp1_b = (const float*)d_in[25]; a.mlp2_w = (const float*)d_in[26]; a.mlp2_b = (const float*)d_in[27]; a.final_norm_w = (const float*)d_in[28];
    a.out = (float*)d_out; a.ws = (unsigned char*)d_ws;
    if (MK_N_LAUNCHES == 1) { a.ph_lo = 0; a.ph_hi = N_PHASES; hipLaunchKernelGGL(mk_fwd, dim3(grid), dim3(NWAVES * 64), LDS_BYTES, stream, a); }
    else for (int p = 0; p < N_PHASES; ++p) { a.ph_lo = p; a.ph_hi = p + 1; hipLaunchKernelGGL(mk_fwd, dim3(grid), dim3(NWAVES * 64), LDS_BYTES, stream, a); }
    const hipError_t le = hipPeekAtLastError();
    if (le != hipSuccess) fprintf(stderr, "kernel_launch: launch failed: %s\n", hipGetErrorName(le));
}
```

```cpp
#include <hip/hip_runtime.h>
#include <cstdio>
#include <cstdint>
namespace pg8 {
#define PG8_LAS __attribute__((address_space(3)))
typedef unsigned short bf16_t;
typedef short bf16x8 __attribute__((ext_vector_type(8)));
typedef float f32x4 __attribute__((ext_vector_type(4)));
typedef unsigned u32x4 __attribute__((ext_vector_type(4)));
typedef int i32x4 __attribute__((ext_vector_type(4)));
typedef int i32x8 __attribute__((ext_vector_type(8)));
constexpr int BM = 256, BK = 64, HALF = 128, HTB = HALF * BK * 2  , STAGE_BYTES = 8 * HTB, NXCD = 8, WGM = 8;

__host__ __device__ __forceinline__ int lds_byte(int r, int c) { const int st = (r >> 4) * 2 + (c >> 5), rr = r & 15, cc = c & 31, ob = rr * 64 + cc * 2; return st * 1024 + (ob ^ (((ob >> 9) & 1) << 5)); }
__host__ __device__ __forceinline__ void stage_rc(int b, int& R, int& C) { const int st = b / 1024, sb = b % 1024, swz = sb ^ (((sb >> 9) & 1) << 5); R = (st >> 1) * 16 + swz / 64; C = (st & 1) * 32 + (swz % 64) / 2; }
__host__ __device__ __forceinline__ int perm32(int rho) { const int n = rho >> 4, i = rho & 15; return 8 * (i >> 2) + 4 * n + (i & 3); }

struct Unit { int pm, pn; };
struct Gemm { const bf16_t* A; const bf16_t* Bt; int M, N, K; const int* rows; };

struct StaticOrder {
    int nM, nN, nwg, G, c;
    __host__ __device__ void init(int M, int N, int G_, int c_) { nM = M / BM; nN = N / BM; nwg = nM * nN; G = G_; c = c_; }
    __host__ __device__ bool next(int i, Unit& u) const {
        const long L = (long)i * G + c; if (L >= nwg) return false;
        int wgid = (int)L; { const int q = nwg / NXCD, r = nwg % NXCD, xcd = wgid % NXCD, off = wgid / NXCD; wgid = (xcd < r ? xcd * (q + 1) : r * (q + 1) + (xcd - r) * q) + off; }
        const int nig = WGM * nN, gid = wgid / nig, fm = gid * WGM, gsz = (nM - fm) < WGM ? (nM - fm) : WGM;
        u.pm = fm + ((wgid % nig) % gsz); u.pn = (wgid % nig) / gsz; return true;
    }
    __device__ __forceinline__ void a_ready(const Unit&) const {}
    __device__ __forceinline__ void done(const Unit&) const {}
};

__device__ __forceinline__ unsigned pk_fp8x4(float a, float b, float c, float d) { int w = __builtin_amdgcn_cvt_pk_fp8_f32(a, b, 0, false); w = __builtin_amdgcn_cvt_pk_fp8_f32(c, d, w, true); return (unsigned)w; }
constexpr float MOE_WSCALE = 32.0f, MOE_WSCALE_INV = 1.0f / 32.0f;
constexpr float MOE_YSCALE = 16.0f, MOE_YSCALE_INV = 1.0f / 16.0f;
__device__ __forceinline__ unsigned cvt_pk_bf16(float lo, float hi) { unsigned r; asm volatile("v_cvt_pk_bf16_f32 %0, %1, %2" : "=v"(r) : "v"(lo), "v"(hi)); return r; }
typedef float f32x2 __attribute__((ext_vector_type(2)));
__device__ __forceinline__ f32x2 gelu_pk(f32x2 v) {
    const f32x2 av = __builtin_elementwise_abs(v), d = av * 0.2316418882f + 1.0f;
    f32x2 t; t.x = __builtin_amdgcn_rcpf(d.x); t.y = __builtin_amdgcn_rcpf(d.y);
    f32x2 q = t * 0.5307027145f + (-0.7265760135f); q = q * t + 0.7107068705f; q = q * t + (-0.142248368f); q = q * t + 0.127414796f; q = q * t;
    const f32x2 s = (v * v) * (-0.72134752044f);
    f32x2 e; e.x = __builtin_amdgcn_exp2f(s.x); e.y = __builtin_amdgcn_exp2f(s.y);
    const f32x2 m = v * (q * e), r = v - m;
    f32x2 o; o.x = v.x < 0.f ? m.x : r.x; o.y = v.y < 0.f ? m.y : r.y; return o;
}

template <int ACT  > struct EpiBf16 {
    static constexpr bool PERM = true, AFTER_DRAIN = false, PERM16 = false, HAS_PRE = false, GUSPLIT = false; static_assert(ACT == 0 || ACT == 1, "EpiBf16: ACT is 0 (none) or 1 (gelu_pk)");
    bf16_t* O; int ldc; const float* bias; int split_cols; size_t split_stride; float scale0;
    __device__ __forceinline__ void operator()(const f32x4 (&acc)[2][2][4][2], const Unit& u, int wr, int wc, int fr, int fq) const {
        const int row0 = u.pm * BM + wr * 64 + fr; int colt = u.pn * BM; bf16_t* base = O;
        float sc = 1.f; if (split_cols) { const int t = colt / split_cols; base += (size_t)t * split_stride; colt -= t * split_cols; if (t == 0) sc = scale0; }
        const int col0 = colt + wc * 32 + 8 * fq, bcol0 = u.pn * BM + wc * 32 + 8 * fq;
        f32x4 bv[2][2];
#pragma unroll
        for (int bj = 0; bj < 2; ++bj)
#pragma unroll
            for (int n = 0; n < 2; ++n) bv[bj][n] = bias ? *(const f32x4*)(bias + bcol0 + bj * HALF + 4 * n) : (f32x4){0.f, 0.f, 0.f, 0.f};
#pragma unroll
        for (int ai = 0; ai < 2; ++ai)
#pragma unroll
            for (int m = 0; m < 4; ++m) { bf16_t* rowp = base + (size_t)(row0 + ai * HALF + m * 16) * ldc + col0;
#pragma unroll
                for (int bj = 0; bj < 2; ++bj) { f32x4 v0 = acc[ai][bj][m][0] + bv[bj][0], v1 = acc[ai][bj][m][1] + bv[bj][1];
                    if (ACT == 1) { f32x2 a = gelu_pk((f32x2){v0[0], v0[1]}), b = gelu_pk((f32x2){v0[2], v0[3]}), c = gelu_pk((f32x2){v1[0], v1[1]}), d = gelu_pk((f32x2){v1[2], v1[3]});
                        v0 = (f32x4){a.x, a.y, b.x, b.y}; v1 = (f32x4){c.x, c.y, d.x, d.y}; }
                    v0 = v0 * sc; v1 = v1 * sc; u32x4 w; w.x = cvt_pk_bf16(v0[0], v0[1]); w.y = cvt_pk_bf16(v0[2], v0[3]); w.z = cvt_pk_bf16(v1[0], v1[1]); w.w = cvt_pk_bf16(v1[2], v1[3]);
                    *(u32x4*)(rowp + bj * HALF) = w; } }
    }
};
__device__ __forceinline__ void pg8_glds16s(const void* gbase, unsigned voff, unsigned lds_dst) { unsigned keep;
    asm volatile("s_mov_b32 %0, m0\n\ts_mov_b32 m0, %2\n\ts_nop 0\n\tglobal_load_lds_dwordx4 %1, %3\n\ts_mov_b32 m0, %0" : "=&s"(keep) : "v"(voff), "s"(lds_dst), "s"(gbase) : "memory"); }
template <class E, bool H> struct PreOf { struct type {}; };
template <class E> struct PreOf<E, true> { using type = typename E::Pre; };
template <class Epi, class Sched, bool ALIGN_EPI = false, bool SP2 = false, bool GATHER = false, bool FP8 = false>
__device__ __forceinline__ void gemm_phase(PG8_LAS unsigned char* lds, const Gemm g, const Sched& S, const Epi& E) {
    const int tid = threadIdx.x, wid = __builtin_amdgcn_readfirstlane(tid >> 6), lane = tid & 63, wr = wid >> 2, wc = wid & 3, fr = lane & 15, fq = lane >> 4;
    constexpr int EB = FP8 ? 1 : 2;
    int K = g.K; asm volatile("" : "+s"(K));
    const int nt = (K * EB) / (BK * 2);
    unsigned voffA[2], voffB[2]; int Rl[2]; unsigned Cb[2];
#pragma unroll
    for (int i = 0; i < 2; ++i) { int R, C; stage_rc(tid * 16 + i * 8192, R, C); const int Rb = Epi::PERM ? ((R & ~31) + perm32(R & 31)) : R;
        voffA[i] = (unsigned)(R * K) * EB + (unsigned)C * 2u; voffB[i] = (unsigned)(Rb * K) * EB + (unsigned)C * 2u; Rl[i] = R; Cb[i] = (unsigned)C * 2u; }
    unsigned voffB16[2][2];
#pragma unroll
    for (int h_ = 0; h_ < 2; ++h_)
#pragma unroll
        for (int i_ = 0; i_ < 2; ++i_) { const int R = Rl[i_]; voffB16[h_][i_] = (unsigned)((64 * (R >> 5) + 16 * ((R >> 2) & 3) + 8 * h_ + (Epi::GUSPLIT ? 2 * (R & 3) + ((R >> 4) & 1) : 4 * ((R >> 4) & 1) + (R & 3))) * K) * EB + Cb[i_]; }
#define PG8_STAGE_B(bufoff, kptr, h) do { if constexpr (Epi::PERM16) { PG8_STAGE(bufoff, kptr, voffB16[h]); } else { PG8_STAGE(bufoff, (kptr) + (h) * hstep, voffB); } } while (0)
    unsigned gcur[2][2], gnxt[2][2];
#define PG8_GATH(dst, u) do { _Pragma("unroll") for (int h_ = 0; h_ < 2; ++h_) _Pragma("unroll") for (int i_ = 0; i_ < 2; ++i_) \
        dst[h_][i_] = (unsigned)g.rows[(u).pm * BM + h_ * HALF + Rl[i_]] * (unsigned)(K * EB) + Cb[i_]; } while (0)
#define PG8_STAGE_A(bufoff, kptr, h, GA) do { if constexpr (GATHER) { PG8_STAGE(bufoff, kptr, GA[h]); } else { PG8_STAGE(bufoff, (kptr) + (h) * hstep, voffA); } } while (0)
#define PG8_STAGE_A2(bufoff, kptr, h) do { if constexpr (GATHER) { const unsigned gs_[2] = {lastsel ? gnxt[h][0] : gcur[h][0], lastsel ? gnxt[h][1] : gcur[h][1]}; PG8_STAGE(bufoff, kptr, gs_); } else { PG8_STAGE(bufoff, (kptr) + (h) * hstep, voffA); } } while (0)
    const size_t kstep = (size_t)(BK * 2);
    const size_t hstep = (size_t)HALF * K * EB;
    const size_t tstep = 2 * hstep;
    const unsigned lds0 = (unsigned)(uintptr_t)lds;
    const unsigned ldsw = (unsigned)wid * 1024u;
    const int aoff = lds_byte(wr * 64 + fr, fq * 8), boff = lds_byte(wc * 32 + fr, fq * 8);
#define PG8_SA(b, h) (((b) * 2 + (h)) * HTB)
#define PG8_SB(b, h) ((4 + (b) * 2 + (h)) * HTB)
#define PG8_STAGE(bufoff, gbase, voff) do { _Pragma("unroll") for (int _i = 0; _i < 2; ++_i) { \
        if constexpr (FP8) pg8_glds16s((const char*)(gbase), (voff)[_i], (unsigned)__builtin_amdgcn_readfirstlane((int)(lds0 + (unsigned)(bufoff) + ldsw + _i * 8192))); \
        else __builtin_amdgcn_global_load_lds((const unsigned*)((const char*)(gbase) + (voff)[_i]), (PG8_LAS unsigned*)(lds + (bufoff) + ldsw + _i * 8192), 16, 0, 0); } } while (0)
#define PG8_CAT(x, y) __builtin_shufflevector(__builtin_bit_cast(i32x4, x), __builtin_bit_cast(i32x4, y), 0, 1, 2, 3, 4, 5, 6, 7)
#define PG8_LDA(dst, b, h) do { if constexpr (FP8) { _Pragma("unroll") for (int m = 0; m < 4; ++m) dst##8[m] = PG8_CAT(*(const PG8_LAS bf16x8*)(lds + PG8_SA(b, h) + aoff + m * 2048), *(const PG8_LAS bf16x8*)(lds + PG8_SA(b, h) + aoff + m * 2048 + 1024)); } \
        else { _Pragma("unroll") for (int m = 0; m < 4; ++m) _Pragma("unroll") for (int k = 0; k < 2; ++k) dst[m][k] = *(const PG8_LAS bf16x8*)(lds + PG8_SA(b, h) + aoff + m * 2048 + k * 1024); } } while (0)
#define PG8_LDB(dst, b, h) do { if constexpr (FP8) { _Pragma("unroll") for (int n = 0; n < 2; ++n) dst##8[n] = PG8_CAT(*(const PG8_LAS bf16x8*)(lds + PG8_SB(b, h) + boff + n * 2048), *(const PG8_LAS bf16x8*)(lds + PG8_SB(b, h) + boff + n * 2048 + 1024)); } \
        else { _Pragma("unroll") for (int n = 0; n < 2; ++n) _Pragma("unroll") for (int k = 0; k < 2; ++k) dst[n][k] = *(const PG8_LAS bf16x8*)(lds + PG8_SB(b, h) + boff + n * 2048 + k * 1024); } } while (0)
#define PG8_MMA(ai, bj, At, Bt) do { __builtin_amdgcn_s_setprio(1); _Pragma("unroll") for (int m = 0; m < 4; ++m) _Pragma("unroll") for (int n = 0; n < 2; ++n) { \
        if constexpr (FP8) asm volatile("v_mfma_f32_16x16x128_f8f6f4 %0, %1, %2, %0" : "+v"(acc[ai][bj][m][n]) : "v"(Bt##8[n]), "v"(At##8[m])); \
        else { _Pragma("unroll") for (int k = 0; k < 2; ++k) acc[ai][bj][m][n] = __builtin_amdgcn_mfma_f32_16x16x32_bf16(Bt[n][k], At[m][k], acc[ai][bj][m][n], 0, 0, 0); } } \
        __builtin_amdgcn_s_setprio(0); } while (0)
#define PG8_WAIT_V(n) asm volatile("s_waitcnt vmcnt(" #n ")" ::: "memory")
#define PG8_WAIT_L(n) asm volatile("s_waitcnt lgkmcnt(" #n ")" ::: "memory")
#define PG8_BAR __builtin_amdgcn_s_barrier()
#define PG8_SCHED __builtin_amdgcn_sched_barrier(0)
    Unit cur, nxt; int ui = 0;
    if (!S.next(0, cur)) return;
    typename PreOf<Epi, Epi::HAS_PRE>::type pre;
    f32x4 acc[2][2][4][2];
#pragma unroll
    for (int a = 0; a < 2; ++a)
#pragma unroll
        for (int b = 0; b < 2; ++b)
#pragma unroll
            for (int m = 0; m < 4; ++m)
#pragma unroll
                for (int n = 0; n < 2; ++n) acc[a][b][m][n] = (f32x4){0.f, 0.f, 0.f, 0.f};
    bf16x8 At[4][2], B0[2][2], B1[2][2];
    i32x8 At8[4], B08[2], B18[2];
    const char* cA = (const char*)g.A + (GATHER ? (size_t)0 : (size_t)cur.pm * tstep); const char* cB = (const char*)g.Bt + (size_t)cur.pn * tstep;
    if constexpr (GATHER) PG8_GATH(gcur, cur);
    S.a_ready(cur);
    if constexpr (SP2) {
        PG8_STAGE_B(PG8_SB(0, 0), cB, 0); PG8_STAGE_B(PG8_SB(0, 1), cB, 1); PG8_STAGE_A(PG8_SA(0, 0), cA, 0, gcur); PG8_STAGE_A(PG8_SA(0, 1), cA, 1, gcur);
        if (wr == 1) PG8_BAR;
        PG8_WAIT_V(2); PG8_BAR;
        PG8_STAGE_B(PG8_SB(1, 0), cB + kstep, 0); PG8_STAGE_A(PG8_SA(1, 0), cA + kstep, 0, gcur); PG8_STAGE_B(PG8_SB(1, 1), cB + kstep, 1);
        PG8_WAIT_V(6); PG8_BAR;
    } else {
        PG8_STAGE_B(PG8_SB(0, 0), cB, 0); PG8_STAGE_A(PG8_SA(0, 0), cA, 0, gcur); PG8_STAGE_B(PG8_SB(0, 1), cB, 1); PG8_STAGE_A(PG8_SA(0, 1), cA, 1, gcur);
        if (wr == 1) PG8_BAR;
        PG8_WAIT_V(4); PG8_BAR;
        PG8_STAGE_B(PG8_SB(1, 0), cB + kstep, 0); PG8_STAGE_A(PG8_SA(1, 0), cA + kstep, 0, gcur); PG8_STAGE_B(PG8_SB(1, 1), cB + kstep, 1);
        PG8_WAIT_V(6); PG8_BAR;
    }
    for (;;) {
        const bool has_next = S.next(ui + 1, nxt);
        if constexpr (Epi::HAS_PRE) E.prefetch(pre, cur, wr, fr);
        if constexpr (GATHER) { if (has_next) { PG8_GATH(gnxt, nxt); } else { _Pragma("unroll") for (int h_ = 0; h_ < 2; ++h_) _Pragma("unroll") for (int i_ = 0; i_ < 2; ++i_) gnxt[h_][i_] = gcur[h_][i_]; } }
        const char* nA = (has_next && !GATHER) ? (const char*)g.A + (size_t)nxt.pm * tstep : cA; const char* nB = has_next ? (const char*)g.Bt + (size_t)nxt.pn * tstep : cB;
        for (int t = 0; t < nt; t += 2) {
            const bool last = (t == nt - 2);
            const bool lastsel = last;
            const char* a1 = cA + (size_t)(t + 1) * kstep;
            const char* a2 = last ? nA : cA + (size_t)(t + 2) * kstep; const char* b2 = last ? nB : cB + (size_t)(t + 2) * kstep;
            const char* a3 = a2 + kstep; const char* b3 = b2 + kstep;
            if (last && has_next) S.a_ready(nxt);
            if constexpr (SP2) {
            PG8_LDB(B0, 0, 0); PG8_LDB(B1, 0, 1); PG8_SCHED; PG8_LDA(At, 0, 0); PG8_STAGE_A(PG8_SA(1, 1), a1, 1, gcur);
            PG8_WAIT_V(8); PG8_WAIT_L(0); PG8_BAR; PG8_MMA(0, 0, At, B0); PG8_MMA(0, 1, At, B1); PG8_BAR; PG8_SCHED;
            PG8_LDA(At, 0, 1); PG8_STAGE_B(PG8_SB(0, 0), b2, 0); PG8_STAGE_B(PG8_SB(0, 1), b2, 1); PG8_STAGE_A2(PG8_SA(0, 0), a2, 0);
            PG8_WAIT_V(8); PG8_WAIT_L(0); PG8_BAR; PG8_MMA(1, 0, At, B0); PG8_MMA(1, 1, At, B1); PG8_BAR; PG8_SCHED;
            PG8_LDB(B0, 1, 0); PG8_LDB(B1, 1, 1); PG8_SCHED; PG8_LDA(At, 1, 0); PG8_STAGE_A2(PG8_SA(0, 1), a2, 1);
            PG8_WAIT_V(8); PG8_WAIT_L(0); PG8_BAR; PG8_MMA(0, 0, At, B0); PG8_MMA(0, 1, At, B1); PG8_BAR; PG8_SCHED;
            PG8_LDA(At, 1, 1); PG8_STAGE_B(PG8_SB(1, 0), b3, 0); PG8_STAGE_B(PG8_SB(1, 1), b3, 1); PG8_STAGE_A2(PG8_SA(1, 0), a3, 0);
            PG8_WAIT_V(8); PG8_WAIT_L(0); PG8_BAR; PG8_MMA(1, 0, At, B0); PG8_MMA(1, 1, At, B1); PG8_BAR; PG8_SCHED;
            } else {
            PG8_LDB(B0, 0, 0); PG8_SCHED; PG8_LDA(At, 0, 0); PG8_STAGE_A(PG8_SA(1, 1), a1, 1, gcur);
            PG8_WAIT_L(8); PG8_BAR; PG8_WAIT_L(0); PG8_MMA(0, 0, At, B0); PG8_BAR; PG8_SCHED;
            PG8_LDB(B1, 0, 1); PG8_STAGE_B(PG8_SB(0, 0), b2, 0);
            PG8_BAR; PG8_WAIT_L(0); PG8_MMA(0, 1, At, B1); PG8_BAR;
            PG8_LDA(At, 0, 1); PG8_STAGE_A2(PG8_SA(0, 0), a2, 0);
            PG8_BAR; PG8_WAIT_L(0); PG8_MMA(1, 0, At, B0); PG8_BAR; PG8_SCHED;
            PG8_STAGE_B(PG8_SB(0, 1), b2, 1);
            PG8_WAIT_V(6); PG8_BAR; PG8_MMA(1, 1, At, B1); PG8_BAR;
            PG8_LDB(B0, 1, 0); PG8_SCHED; PG8_LDA(At, 1, 0); PG8_STAGE_A2(PG8_SA(0, 1), a2, 1);
            PG8_WAIT_L(8); PG8_BAR; PG8_WAIT_L(0); PG8_MMA(0, 0, At, B0); PG8_BAR; PG8_SCHED;
            PG8_LDB(B1, 1, 1); PG8_STAGE_B(PG8_SB(1, 0), b3, 0);
            PG8_BAR; PG8_WAIT_L(0); PG8_MMA(0, 1, At, B1); PG8_BAR;
            PG8_LDA(At, 1, 1); PG8_STAGE_A2(PG8_SA(1, 0), a3, 0);
            PG8_BAR; PG8_WAIT_L(0); PG8_MMA(1, 0, At, B0); PG8_BAR; PG8_SCHED;
            PG8_STAGE_B(PG8_SB(1, 1), b3, 1);
            PG8_WAIT_V(6); PG8_BAR; PG8_MMA(1, 1, At, B1); PG8_BAR;
            }
        }
        if constexpr (FP8) {
            _Pragma("unroll") for (int a = 0; a < 2; ++a) _Pragma("unroll") for (int b = 0; b < 2; ++b) _Pragma("unroll") for (int m = 0; m < 4; ++m)
                { if (a == 0 && b == 0 && m == 0) asm volatile("s_nop 15\n\ts_nop 7" : "+v"(acc[a][b][m][0]), "+v"(acc[a][b][m][1])); else asm volatile("" : "+v"(acc[a][b][m][0]), "+v"(acc[a][b][m][1])); }
        }
        if constexpr (ALIGN_EPI) { if (wr == 0) PG8_BAR; }
        if constexpr (!Epi::AFTER_DRAIN) { if constexpr (Epi::HAS_PRE) E(acc, cur, wr, wc, fr, fq, pre); else E(acc, cur, wr, wc, fr, fq); S.done(cur); }
        if (!has_next) break;
#pragma unroll
        for (int a = 0; a < 2; ++a)
#pragma unroll
            for (int b = 0; b < 2; ++b)
#pragma unroll
                for (int m = 0; m < 4; ++m)
#pragma unroll
                    for (int n = 0; n < 2; ++n) acc[a][b][m][n] = (f32x4){0.f, 0.f, 0.f, 0.f};
        cur = nxt; cA = nA; cB = nB; ++ui;
        if constexpr (GATHER) { _Pragma("unroll") for (int h_ = 0; h_ < 2; ++h_) _Pragma("unroll") for (int i_ = 0; i_ < 2; ++i_) gcur[h_][i_] = gnxt[h_][i_]; }
        if constexpr (ALIGN_EPI) { if (wr == 1) PG8_BAR; }
    }
    PG8_WAIT_V(0);
    if constexpr (!ALIGN_EPI) { if (wr == 0) PG8_BAR; }
    PG8_BAR;
    if constexpr (Epi::AFTER_DRAIN) { E.fused(acc, cur, wr, wc, fr, fq, lds, wid, lane); S.done(cur); }
#undef PG8_SA
#undef PG8_SB
#undef PG8_STAGE
#undef PG8_STAGE_A
#undef PG8_STAGE_A2
#undef PG8_STAGE_B
#undef PG8_GATH
#undef PG8_LDA
#undef PG8_LDB
#undef PG8_MMA
#undef PG8_CAT
#undef PG8_WAIT_V
#undef PG8_WAIT_L
#undef PG8_BAR
#undef PG8_SCHED
}
}

#ifndef PG8_SP2
#define PG8_SP2 true
#endif
#ifndef PG8_ALIGN
#define PG8_ALIGN true
#endif
namespace pg8 {
struct EpiResF32 {
    static constexpr bool PERM = false, AFTER_DRAIN = false, PERM16 = false, HAS_PRE = false, GUSPLIT = false;
    const float* base; float* out; int ldc;
    __device__ __forceinline__ void operator()(const f32x4 (&acc)[2][2][4][2], const Unit& u, int wr, int wc, int fr, int fq) const {
        const int col0 = u.pn * BM + wc * 32 + 4 * fq;
        const size_t off0 = (size_t)(u.pm * BM + wr * 64 + fr) * ldc + col0;
        f32x4 bs[8][2][2];
#define PG8_RES_LD(g) do { const size_t off_ = off0 + (size_t)(((g) >> 2) * HALF + ((g) & 3) * 16) * ldc; _Pragma("unroll") for (int bj = 0; bj < 2; ++bj) _Pragma("unroll") for (int n = 0; n < 2; ++n) \
            bs[g][bj][n] = *(const f32x4*)(base + off_ + bj * HALF + n * 16); } while (0)
        PG8_RES_LD(0); PG8_RES_LD(1); PG8_RES_LD(2);
#pragma unroll
        for (int g = 0; g < 8; ++g) { const int ai = g >> 2, m = g & 3; const size_t off = off0 + (size_t)(ai * HALF + m * 16) * ldc;
            if (g + 3 < 8) PG8_RES_LD(g + 3);
#pragma unroll
            for (int bj = 0; bj < 2; ++bj)
#pragma unroll
                for (int n = 0; n < 2; ++n) *(f32x4*)(out + off + bj * HALF + n * 16) = bs[g][bj][n] + acc[ai][bj][m][n]; }
#undef PG8_RES_LD
    }
};
struct EpiSwiglu {
    static constexpr bool PERM = true, AFTER_DRAIN = false, PERM16 = true, HAS_PRE = true, GUSPLIT = true;
    unsigned char* O; const float* bias;
    struct Pre { f32x4 bv[2][2]; };
    __device__ __forceinline__ void prefetch(Pre& p, const Unit& u, int wr, int fr) const {
        const int tid = threadIdx.x, wc = __builtin_amdgcn_readfirstlane(tid >> 6) & 3, fq = (tid & 63) >> 4;
        const int e = u.pn >> 3, pnl = u.pn & 7, bcol0 = pnl * BM + wc * 64 + 16 * fq;
        const float* bp = bias + (size_t)e * 2048 + bcol0;
#pragma unroll
        for (int bj = 0; bj < 2; ++bj)
#pragma unroll
            for (int n = 0; n < 2; ++n) p.bv[bj][n] = *(const f32x4*)(bp + 8 * bj + 4 * n);
    }
    typedef float f2 __attribute__((ext_vector_type(2)));
    static __device__ __forceinline__ f2 pkmul(f2 a, f2 b) { f2 r; asm("v_pk_mul_f32 %0, %1, %2" : "=v"(r) : "v"(a), "v"(b)); return r; }
    static __device__ __forceinline__ f2 pkadd1(f2 a) { f2 r; asm("s_nop 0\n\tv_pk_add_f32 %0, %1, 1.0 op_sel_hi:[1,0]" : "=v"(r) : "v"(a)); return r; }
    static __device__ __forceinline__ f2 pkmul_t(f2 a, f2 b) { f2 r; asm("s_nop 0\n\tv_pk_mul_f32 %0, %1, %2" : "=v"(r) : "v"(a), "v"(b)); return r; }
    static __device__ __forceinline__ f2 pkfma(f2 a, f2 b, f2 c) { f2 r; asm("v_pk_fma_f32 %0, %1, %2, %3" : "=v"(r) : "v"(a), "v"(b), "v"(c)); return r; }
    __device__ __forceinline__ void operator()(const f32x4 (&acc)[2][2][4][2], const Unit& u, int wr, int wc, int fr, int fq, const Pre& p) const {
        const int pnl = u.pn & 7;
        const int row0 = u.pm * BM + wr * 64 + fr, bcol0 = pnl * BM + wc * 64 + 16 * fq;
        f32x4 bg[2], bu[2];
#pragma unroll
        for (int bj = 0; bj < 2; ++bj) { bg[bj] = (f32x4){p.bv[bj][0][0], p.bv[bj][0][2], p.bv[bj][1][0], p.bv[bj][1][2]}; bu[bj] = (f32x4){p.bv[bj][0][1], p.bv[bj][0][3], p.bv[bj][1][1], p.bv[bj][1][3]}; }
        const f2 kk = {-1.702f * 1.4426950408889634f, -1.702f * 1.4426950408889634f};
#pragma unroll
        for (int ai = 0; ai < 2; ++ai)
#pragma unroll
            for (int m = 0; m < 4; ++m) { unsigned char* rowp = O + (size_t)(row0 + ai * HALF + m * 16) * 1024 + (bcol0 >> 1);
                f2 a[4];
#pragma unroll
                for (int bj = 0; bj < 2; ++bj) { const f32x4 G = acc[ai][bj][m][0] * MOE_WSCALE_INV + bg[bj], U = acc[ai][bj][m][1] * MOE_WSCALE_INV + bu[bj];
#pragma unroll
                    for (int h = 0; h < 2; ++h) {
                        const f2 gc = {fminf(G[2 * h], 7.0f), fminf(G[2 * h + 1], 7.0f)}, uc = {fminf(fmaxf(U[2 * h], -7.0f), 7.0f), fminf(fmaxf(U[2 * h + 1], -7.0f), 7.0f)};
                        const f2 t = pkmul(gc, kk); const f2 e = {__builtin_amdgcn_exp2f(t[0]), __builtin_amdgcn_exp2f(t[1])};
                        const f2 d = pkadd1(e); const f2 r = {__builtin_amdgcn_rcpf(d[0]), __builtin_amdgcn_rcpf(d[1])};
                        a[2 * bj + h] = pkmul_t(pkfma(uc, gc, gc), r); } }
                typedef unsigned u32x2 __attribute__((ext_vector_type(2)));
                u32x2 w; w.x = pk_fp8x4(a[0][0], a[0][1], a[1][0], a[1][1]); w.y = pk_fp8x4(a[2][0], a[2][1], a[3][0], a[3][1]);
                *(u32x2*)rowp = w; }
    }
};
struct EpiMoeOut {
    static constexpr bool PERM = true, AFTER_DRAIN = false, PERM16 = true, HAS_PRE = true, GUSPLIT = false;
    unsigned char* YS; const float* bias; const float* rgate;
    struct Pre { float g[8]; f32x4 bv[2][2]; };
    __device__ __forceinline__ void prefetch(Pre& p, const Unit& u, int wr, int fr) const {
        const int row0 = u.pm * BM + wr * 64 + fr;
#pragma unroll
        for (int ai = 0; ai < 2; ++ai)
#pragma unroll
            for (int m = 0; m < 4; ++m) p.g[ai * 4 + m] = rgate[row0 + ai * HALF + m * 16];
        const int tid = threadIdx.x, wc = __builtin_amdgcn_readfirstlane(tid >> 6) & 3, fq = (tid & 63) >> 4;
        const float* bp = bias + (size_t)(u.pn >> 2) * 1024 + (u.pn & 3) * BM + wc * 64 + 16 * fq;
#pragma unroll
        for (int bj = 0; bj < 2; ++bj)
#pragma unroll
            for (int n = 0; n < 2; ++n) p.bv[bj][n] = *(const f32x4*)(bp + 8 * bj + 4 * n);
    }
    __device__ __forceinline__ void operator()(const f32x4 (&acc)[2][2][4][2], const Unit& u, int wr, int wc, int fr, int fq, const Pre& p) const {
        const int pnl = u.pn & 3;
        const int col0 = pnl * BM + wc * 64 + 16 * fq;
        const int row0 = u.pm * BM + wr * 64 + fr;
        const f32x4 (&bv)[2][2] = p.bv;
#pragma unroll
        for (int ai = 0; ai < 2; ++ai)
#pragma unroll
            for (int m = 0; m < 4; ++m) { const float gt = p.g[ai * 4 + m] * MOE_YSCALE; u32x4 w;
                { const f32x4 v0 = (acc[ai][0][m][0] * MOE_WSCALE_INV + bv[0][0]) * gt, v1 = (acc[ai][0][m][1] * MOE_WSCALE_INV + bv[0][1]) * gt; w.x = pk_fp8x4(v0[0], v0[1], v0[2], v0[3]); w.y = pk_fp8x4(v1[0], v1[1], v1[2], v1[3]); }
                { const f32x4 v0 = (acc[ai][1][m][0] * MOE_WSCALE_INV + bv[1][0]) * gt, v1 = (acc[ai][1][m][1] * MOE_WSCALE_INV + bv[1][1]) * gt; w.z = pk_fp8x4(v0[0], v0[1], v0[2], v0[3]); w.w = pk_fp8x4(v1[0], v1[1], v1[2], v1[3]); }
                *(u32x4*)(YS + (size_t)(row0 + ai * HALF + m * 16) * 1024 + col0) = w; }
    }
};
template <int NTN> struct MoeOrder {
    int ntiles, c, G; const PG8_LAS int* te;
    __device__ __forceinline__ bool next(int i, Unit& u) const {
        int pm, pnl; constexpr int RT = 32 / NTN;
        if (G == 256) { const int x = c & 7, j = c >> 3, gidx = i * 8 + x; pm = RT * gidx + (j % RT); pnl = j / RT; }
        else { const long L = (long)i * G + c; pm = (int)(L / NTN); pnl = (int)(L % NTN); }
        if (pm >= ntiles) return false;
        u.pm = pm; u.pn = te[pm] * NTN + pnl; return true;
    }
    __device__ __forceinline__ void a_ready(const Unit&) const {}
    __device__ __forceinline__ void done(const Unit&) const {}
};
}
#include <hip/hip_bf16.h>
#include <cmath>
namespace attn_body {
using bf16=__hip_bfloat16;
using bf16x8=__attribute__((ext_vector_type(8)))short;
using s16x4=__attribute__((ext_vector_type(4)))short;
using f32x16=__attribute__((ext_vector_type(16)))float;
using u32x4=__attribute__((ext_vector_type(4)))unsigned;
constexpr int SEQ=8192,D=64,PQ=3328,PO=1024;
constexpr int NW=8,QBLK=32,QB=QBLK*NW,KVBLK=64,NQB=SEQ/QB;
constexpr int ATTN_UNIT_ROWS=QB;
__device__ __forceinline__ int crow(int r,int hi){return (r&3)+8*(r>>2)+4*hi;}
#define SBAR() __builtin_amdgcn_sched_barrier(0)
__device__ __forceinline__ void cmask(f32x16&p0,f32x16&p1,int jb,int qrel,int hi){
  const float NEG=-INFINITY; int kb=64*jb+4*hi;
  #pragma unroll
  for(int r=0;r<16;++r){int kv=kb+(r&3)+8*(r>>2); if(kv>qrel)p0[r]=NEG; if(kv+32>qrel)p1[r]=NEG;}
}

constexpr int NSLOT=3, SLOTB=8192;
constexpr int LDS_K=0, LDS_V=NSLOT*SLOTB, LDS_WS=2*NSLOT*SLOTB, LDS_OST=LDS_WS+NW*64*4, LDS_BYTES=LDS_OST+NW*4096;
constexpr float C2=0.125f*1.4426950408889634f;
__device__ __forceinline__ void glds16(const void*gsrc,unsigned lds_dst){unsigned keep;
  asm volatile("s_mov_b32 %0, m0\n\ts_mov_b32 m0, %2\n\ts_nop 0\n\tglobal_load_lds_dwordx4 %1, off\n\ts_mov_b32 m0, %0":"=&s"(keep):"v"(gsrc),"s"(lds_dst):"memory");}
__device__ __forceinline__ void glds16s(const void*gbase,unsigned voff,unsigned lds_dst){unsigned keep;
  asm volatile("s_mov_b32 %0, m0\n\ts_mov_b32 m0, %2\n\ts_nop 0\n\tglobal_load_lds_dwordx4 %1, %3\n\ts_mov_b32 m0, %0":"=&s"(keep):"v"(voff),"s"(lds_dst),"s"(gbase):"memory");}
__device__ __forceinline__ float max3f(float a,float b,float c){float r;asm("v_max3_f32 %0, %1, %2, %3":"=v"(r):"v"(a),"v"(b),"v"(c));return r;}
__device__ __forceinline__ float max2f(float a,float b){float r;asm("v_max_f32_e32 %0, %1, %2":"=v"(r):"v"(a),"v"(b));return r;}
__device__ __forceinline__ float fadd_s(float a,float b){float r;asm("v_add_f32_e32 %0, %1, %2":"=v"(r):"v"(a),"v"(b));return r;}
__device__ __forceinline__ float fsub_s(float a,float b){float r;asm("v_sub_f32_e32 %0, %1, %2":"=v"(r):"v"(a),"v"(b));return r;}
typedef float f32x2_t __attribute__((ext_vector_type(2))); typedef __bf16 bf16x2_t __attribute__((ext_vector_type(2)));
__device__ __forceinline__ unsigned cvtpk_s(float lo,float hi){f32x2_t v={lo,hi};bf16x2_t b=__builtin_convertvector(v,bf16x2_t);return __builtin_bit_cast(unsigned,b);}
#define WAIT_BAR(N) asm volatile("s_waitcnt vmcnt(" #N ") lgkmcnt(0)\n\ts_barrier":::"memory")

__device__ __forceinline__ void qkt(f32x16&p0,f32x16&p1,const char*Kslot,const bf16x8*qr,const f32x16&negm,int r32,int hi){
  const char*kb=Kslot+hi*1024+r32*16;
  #pragma unroll
  for(int d0=0;d0<4;++d0){
    const bf16x8 b0=*reinterpret_cast<const bf16x8*>(kb+d0*2048);
    const bf16x8 b1=*reinterpret_cast<const bf16x8*>(kb+d0*2048+512);
    if(d0==0){p0=__builtin_amdgcn_mfma_f32_32x32x16_bf16(b0,qr[0],negm,0,0,0);p1=__builtin_amdgcn_mfma_f32_32x32x16_bf16(b1,qr[0],negm,0,0,0);}
    else{p0=__builtin_amdgcn_mfma_f32_32x32x16_bf16(b0,qr[d0],p0,0,0,0);p1=__builtin_amdgcn_mfma_f32_32x32x16_bf16(b1,qr[d0],p1,0,0,0);}}
}
typedef __attribute__((address_space(3))) const char* lds_cptr;
typedef short v4i16_t __attribute__((ext_vector_type(4)));
__device__ __forceinline__ void kload8(bf16x8*kf,lds_cptr kp){
  kf[0]=*(const __attribute__((address_space(3))) bf16x8*)(kp);      kf[1]=*(const __attribute__((address_space(3))) bf16x8*)(kp+512);
  kf[2]=*(const __attribute__((address_space(3))) bf16x8*)(kp+2048); kf[3]=*(const __attribute__((address_space(3))) bf16x8*)(kp+2560);
  kf[4]=*(const __attribute__((address_space(3))) bf16x8*)(kp+4096); kf[5]=*(const __attribute__((address_space(3))) bf16x8*)(kp+4608);
  kf[6]=*(const __attribute__((address_space(3))) bf16x8*)(kp+6144); kf[7]=*(const __attribute__((address_space(3))) bf16x8*)(kp+6656);
}
__device__ __forceinline__ void kload2(bf16x8*kf,lds_cptr kp,int j){ kf[2*j]=*(const __attribute__((address_space(3))) bf16x8*)(kp+j*2048); kf[2*j+1]=*(const __attribute__((address_space(3))) bf16x8*)(kp+j*2048+512); }
__device__ __forceinline__ s16x4 vtr(lds_cptr p){ return __builtin_bit_cast(s16x4,__builtin_amdgcn_ds_read_tr16_b64_v4i16((__attribute__((address_space(3))) v4i16_t*)p)); }
__device__ __forceinline__ float rowmax(const f32x16&p0,const f32x16&p1){
  float a=max3f(p0[0],p0[1],p1[0]),b=max3f(p0[2],p0[3],p1[1]);a=max3f(a,p1[2],p1[3]);
  #pragma unroll
  for(int r=4;r<16;r+=4){a=max3f(a,p0[r],p0[r+1]);b=max3f(b,p0[r+2],p0[r+3]);a=max3f(a,p1[r],p1[r+1]);b=max3f(b,p1[r+2],p1[r+3]);}
  const float m=max2f(a,b);
  auto rr=__builtin_amdgcn_permlane32_swap(__float_as_uint(m),__float_as_uint(m),false,false);
  return max2f(__uint_as_float(rr[0]),__uint_as_float(rr[1]));
}
#ifndef ATTN_STORE16
#define ATTN_STORE16(p,v) (*(u32x4*)(p)=(v))
#endif
constexpr int VSLOTB=16384, LDS2_V=NSLOT*SLOTB, LDS2_WS=LDS2_V+NSLOT*VSLOTB, LDS2_OST=LDS2_WS+NW*64*4, LDS2_BYTES=LDS2_OST+NW*8192;
__device__ __forceinline__ void pv128(f32x16*o,int vb,bf16x8 pa0,bf16x8 pa1,bf16x8 pa2,bf16x8 pa3){
  #pragma unroll
  for(int d0=0;d0<4;++d0){s16x4 lo[4],hi[4];
    #pragma unroll
    for(int ks=0;ks<4;++ks){
      asm volatile("ds_read_b64_tr_b16 %0,%1 offset:%c2":"=&v"(lo[ks]):"v"(vb),"i"(d0*4096+ks*1024):"memory");
      asm volatile("ds_read_b64_tr_b16 %0,%1 offset:%c2":"=&v"(hi[ks]):"v"(vb),"i"(d0*4096+ks*1024+512):"memory");}
    asm volatile("s_waitcnt lgkmcnt(0)":::"memory");SBAR();
    #define PK(k) (bf16x8){lo[k][0],lo[k][1],lo[k][2],lo[k][3],hi[k][0],hi[k][1],hi[k][2],hi[k][3]}
    o[d0]=__builtin_amdgcn_mfma_f32_32x32x16_bf16(pa0,PK(0),o[d0],0,0,0);
    o[d0]=__builtin_amdgcn_mfma_f32_32x32x16_bf16(pa1,PK(1),o[d0],0,0,0);
    o[d0]=__builtin_amdgcn_mfma_f32_32x32x16_bf16(pa2,PK(2),o[d0],0,0,0);
    o[d0]=__builtin_amdgcn_mfma_f32_32x32x16_bf16(pa3,PK(3),o[d0],0,0,0);
    #undef PK
  }
}
template<int THRL> __device__ __forceinline__ void attn_unit128(int b,int qb,const bf16*Q,const bf16*__restrict__ K,const bf16*__restrict__ V,bf16*O,char*shm){
  const int tid=threadIdx.x,lane=tid&63,r32=lane&31,hi=lane>>5; const int wid=__builtin_amdgcn_readfirstlane(tid>>6);
  const long rowbase=(long)b*SEQ; const int q0=qb*QB;
  const bf16*Qw=Q+(rowbase+q0+wid*QBLK)*PQ;
  const bf16*Kh=K+rowbase*PQ,*Vh=V+rowbase*PQ;
  const unsigned lds0=(unsigned)(uintptr_t)shm;
  float*wsf=(float*)(shm+LDS2_WS)+wid*64;
  const bf16*ksrc=Kh+wid*8; const unsigned koff=(unsigned)lane*(PQ*2);
  const bf16*vsrc=Vh+(long)(16*(wid&3))*PQ+(wid>>2)*32; const unsigned voff=(unsigned)(lane>>2)*(PQ*2)+(unsigned)(lane&3)*16;
  const unsigned kdst=lds0+LDS_K+wid*1024, vdst=lds0+LDS2_V+wid*1024;
  #define DMA_K(t,slot) glds16s(ksrc+(long)(t)*KVBLK*PQ,koff,(unsigned)__builtin_amdgcn_readfirstlane(kdst+(slot)))
  #define DMA_V(t,slot) do{ glds16s(vsrc+(long)(t)*KVBLK*PQ,voff,(unsigned)__builtin_amdgcn_readfirstlane(vdst+2*(slot))); glds16s(vsrc+(long)(t)*KVBLK*PQ+64,voff,(unsigned)__builtin_amdgcn_readfirstlane(vdst+2*(slot)+8192)); }while(0)
  const char*Kbase=shm+LDS_K; bf16x8 kf[8];
  const lds_cptr shm3=(lds_cptr)shm; const lds_cptr kp0=shm3+LDS_K+hi*1024+r32*16; const lds_cptr vp0=shm3+LDS2_V+((lane>>4)&1)*32+(lane&3)*8+(4*hi+((lane&15)>>2))*64;
  const int NT=(q0+QB)/KVBLK;
  DMA_K(0,0);DMA_V(0,0);DMA_K(1,SLOTB);
  bf16x8 qr[4];
  #pragma unroll
  for(int d0=0;d0<4;++d0)qr[d0]=*reinterpret_cast<const bf16x8*>(&Qw[(long)r32*PQ+d0*16+hi*8]);
  float mhat=0.f,l_reg=0.f;f32x16 o[4];o[0]=f32x16{};o[1]=f32x16{};o[2]=f32x16{};o[3]=f32x16{};const f32x16 zz=f32x16{};
  const int qrel=wid*QBLK+r32;
  #define CMASK(P0,P1,t) do{int jb_=(t)-(NT-4); if(jb_>=0)cmask(P0,P1,jb_,qrel,hi);}while(0)
  bool resc=false;
  #define START(P0,P1) do{ const float rm=rowmax(P0,P1); resc=false; \
    mhat=rm; \
    _Pragma("unroll") for(int r=0;r<16;++r)P0[r]=__builtin_amdgcn_exp2f(P0[r]-mhat); }while(0)
  #define RESC() do{ if(resc){ asm volatile("s_waitcnt lgkmcnt(0)":::"memory"); \
      _Pragma("unroll") for(int d_=0;d_<4;++d_) _Pragma("unroll") for(int r=0;r<16;++r)o[d_][r]*=wsf[crow(r,hi)]; } }while(0)
  f32x16 pA0,pA1,pB0,pB1;
  int sl_prev=0,sl_cur=0,sl_next=SLOTB;
  #define ROT() do{sl_prev=sl_cur;sl_cur=sl_next;sl_next=(sl_next==(NSLOT-1)*SLOTB)?0:sl_next+SLOTB;}while(0)
  DMA_K(2,2*SLOTB);
  WAIT_BAR(3);
  qkt(pA0,pA1,Kbase,qr,zz,r32,hi);asm volatile("s_nop 15\n\ts_nop 7":"+v"(pA0),"+v"(pA1));CMASK(pA0,pA1,0);
  START(pA0,pA1);
  _Pragma("unroll") for(int r=0;r<16;++r)pA1[r]=__builtin_amdgcn_exp2f(pA1[r]-mhat);
  WAIT_BAR(0);
  DMA_K(3,0);DMA_V(1,SLOTB);
  ROT();
  kload8(kf,kp0+sl_cur);
  WAIT_BAR(3);
  s16x4 vlo[4],vhi[4]; u32x4 pw0,pw1,pw2,pw3;
  #define PKW(P,B) cvtpk_s(P[B],P[B+1])
  #define PAF(k) __builtin_bit_cast(bf16x8,pw##k)
  #define FIDX(j) ((((j)&7)>>1)+4*((j)&1)+8*((j)>>3))
  #define VOFF(f) (((f)>>2)*4096+((f)&3)*1024)
  #define VRDJ(j) do{ vlo[(j)&3]=vtr(vp_+VOFF(FIDX(j))); vhi[(j)&3]=vtr(vp_+(VOFF(FIDX(j))+512)); SBAR(); }while(0)
  #define VFJ(j) (bf16x8){vlo[(j)&3][0],vlo[(j)&3][1],vlo[(j)&3][2],vlo[(j)&3][3],vhi[(j)&3][0],vhi[(j)&3][1],vhi[(j)&3][2],vhi[(j)&3][3]}
  #define PIN(x) asm volatile("":"+v"(x))
  #define MX3(a,b,c) __builtin_fmaxf(__builtin_fmaxf((a),(b)),(c))
  #define GAPA(MF,A0,A1,A2,A3,W0,W1,PW) do{ MF; sacc+=A0; sacc+=A1; sacc+=A2; sacc+=A3; PIN(sacc); W0; W1; PIN(PW); SBAR(); }while(0)
  #define EX(v) __builtin_amdgcn_exp2f(v)
  #define GAPB2(MF,X,B) do{ MF; X[B]=EX(X[B]-mhat); X[B+1]=EX(X[B+1]-mhat); PIN(X); SBAR(); }while(0)
  #define KRD(G,j) do{ if(G){ kload2(kf,kp0+sl_next,j); SBAR(); } }while(0)
  #define STEP(C0,C1,P0,P1,t,GK,GV,GL) do{ SBAR(); \
    const lds_cptr vp_=vp0+2*sl_prev; \
    float sacc=(P0[0]+P0[1]); \
    GAPA(C0=__builtin_amdgcn_mfma_f32_32x32x16_bf16(kf[0],qr[0],zz,0,0,0), P0[2],P0[3],P0[4],P0[5], pw0[0]=PKW(P0,0), pw0[1]=PKW(P0,2), pw0); \
    GAPA(C1=__builtin_amdgcn_mfma_f32_32x32x16_bf16(kf[1],qr[0],zz,0,0,0), P0[6],P0[7],P0[8],P0[9], pw0[2]=PKW(P0,4), pw0[3]=PKW(P0,6), pw0); \
    GAPA(C0=__builtin_amdgcn_mfma_f32_32x32x16_bf16(kf[2],qr[1],C0,0,0,0), P0[10],P0[11],P0[12],P0[13], pw1[0]=PKW(P0,8), pw1[1]=PKW(P0,10), pw1); \
    GAPA(C1=__builtin_amdgcn_mfma_f32_32x32x16_bf16(kf[3],qr[1],C1,0,0,0), P0[14],P0[15],P1[0],P1[1], pw1[2]=PKW(P0,12),pw1[3]=PKW(P0,14), pw1); \
    GAPA(C0=__builtin_amdgcn_mfma_f32_32x32x16_bf16(kf[4],qr[2],C0,0,0,0), P1[2],P1[3],P1[4],P1[5], pw2[0]=PKW(P1,0), pw2[1]=PKW(P1,2), pw2); \
    GAPA(C1=__builtin_amdgcn_mfma_f32_32x32x16_bf16(kf[5],qr[2],C1,0,0,0), P1[6],P1[7],P1[8],P1[9], pw2[2]=PKW(P1,4), pw2[3]=PKW(P1,6), pw2); \
    GAPA(C0=__builtin_amdgcn_mfma_f32_32x32x16_bf16(kf[6],qr[3],C0,0,0,0), P1[10],P1[11],P1[12],P1[13], pw3[0]=PKW(P1,8), pw3[1]=PKW(P1,10), pw3); \
    GAPA(C1=__builtin_amdgcn_mfma_f32_32x32x16_bf16(kf[7],qr[3],C1,0,0,0), P1[14],P1[15],0.f,0.f, pw3[2]=PKW(P1,12),pw3[3]=PKW(P1,14), pw3); \
    l_reg+=sacc; \
    if(GK){DMA_K((t)+3,sl_cur);} if(GV){DMA_V((t)+1,sl_next);} \
    VRDJ(0); VRDJ(1); VRDJ(2); \
    CMASK(C0,C1,t); \
    { float a=MX3(C0[0],C0[1],C1[0]),b=MX3(C0[2],C0[3],C1[1]); a=MX3(a,C1[2],C1[3]); \
      _Pragma("unroll") for(int r=4;r<16;r+=4){a=MX3(a,C0[r],C0[r+1]);b=MX3(b,C0[r+2],C0[r+3]);a=MX3(a,C1[r],C1[r+1]);b=MX3(b,C1[r+2],C1[r+3]);} \
      float rm=__builtin_fmaxf(a,b); { auto rr=__builtin_amdgcn_permlane32_swap(__float_as_uint(rm),__float_as_uint(rm),false,false); rm=__builtin_fmaxf(__uint_as_float(rr[0]),__uint_as_float(rr[1])); } \
      resc=false; \
      rm-=mhat; \
      if(__builtin_expect(__any(rm>(float)THRL),0)){ const float dl=__builtin_fmaxf(rm,0.f); mhat+=dl; \
        const float f=__builtin_amdgcn_exp2f(-dl); l_reg*=f; if(hi==0)wsf[r32]=f; resc=true; } } \
    SBAR(); \
    GAPB2(o[0]=__builtin_amdgcn_mfma_f32_32x32x16_bf16(PAF(0),VFJ(0),o[0],0,0,0), C0,0); VRDJ(3); \
    GAPB2(o[1]=__builtin_amdgcn_mfma_f32_32x32x16_bf16(PAF(0),VFJ(1),o[1],0,0,0), C0,2); VRDJ(4); \
    KRD(GL,0); GAPB2(o[0]=__builtin_amdgcn_mfma_f32_32x32x16_bf16(PAF(1),VFJ(2),o[0],0,0,0), C0,4); VRDJ(5); \
    KRD(GL,1); GAPB2(o[1]=__builtin_amdgcn_mfma_f32_32x32x16_bf16(PAF(1),VFJ(3),o[1],0,0,0), C0,6); VRDJ(6); \
    KRD(GL,2); GAPB2(o[0]=__builtin_amdgcn_mfma_f32_32x32x16_bf16(PAF(2),VFJ(4),o[0],0,0,0), C0,8); VRDJ(7); \
    KRD(GL,3); GAPB2(o[1]=__builtin_amdgcn_mfma_f32_32x32x16_bf16(PAF(2),VFJ(5),o[1],0,0,0), C0,10); VRDJ(8); \
    GAPB2(o[0]=__builtin_amdgcn_mfma_f32_32x32x16_bf16(PAF(3),VFJ(6),o[0],0,0,0), C0,12); VRDJ(9); \
    GAPB2(o[1]=__builtin_amdgcn_mfma_f32_32x32x16_bf16(PAF(3),VFJ(7),o[1],0,0,0), C0,14); VRDJ(10); \
    GAPB2(o[2]=__builtin_amdgcn_mfma_f32_32x32x16_bf16(PAF(0),VFJ(8),o[2],0,0,0), C1,0); VRDJ(11); \
    GAPB2(o[3]=__builtin_amdgcn_mfma_f32_32x32x16_bf16(PAF(0),VFJ(9),o[3],0,0,0), C1,2); VRDJ(12); \
    GAPB2(o[2]=__builtin_amdgcn_mfma_f32_32x32x16_bf16(PAF(1),VFJ(10),o[2],0,0,0), C1,4); VRDJ(13); \
    GAPB2(o[3]=__builtin_amdgcn_mfma_f32_32x32x16_bf16(PAF(1),VFJ(11),o[3],0,0,0), C1,6); VRDJ(14); \
    GAPB2(o[2]=__builtin_amdgcn_mfma_f32_32x32x16_bf16(PAF(2),VFJ(12),o[2],0,0,0), C1,8); VRDJ(15); \
    GAPB2(o[3]=__builtin_amdgcn_mfma_f32_32x32x16_bf16(PAF(2),VFJ(13),o[3],0,0,0), C1,10); \
    GAPB2(o[2]=__builtin_amdgcn_mfma_f32_32x32x16_bf16(PAF(3),VFJ(14),o[2],0,0,0), C1,12); \
    GAPB2(o[3]=__builtin_amdgcn_mfma_f32_32x32x16_bf16(PAF(3),VFJ(15),o[3],0,0,0), C1,14); \
    }while(0)
  int t=1;
  #undef CMASK
  #define CMASK(P0,P1,t) do{}while(0)
  for(;t+5<NT;t+=2){
    STEP(pB0,pB1,pA0,pA1,t,true,true,true);     WAIT_BAR(3); RESC(); ROT();
    STEP(pA0,pA1,pB0,pB1,t+1,true,true,true);   WAIT_BAR(3); RESC(); ROT();
  }
  #undef CMASK
  #define CMASK(P0,P1,t) do{int jb_=(t)-(NT-4); if(jb_>=0)cmask(P0,P1,jb_,qrel,hi);}while(0)
  #define ENDW(tt) do{ if((tt)+3<NT){WAIT_BAR(3);} else if((tt)+2<NT){WAIT_BAR(2);} else {WAIT_BAR(0);} }while(0)
  for(;t+1<NT;t+=2){
    STEP(pB0,pB1,pA0,pA1,t,(t+3<NT),(t+1<NT),(t+1<NT));       ENDW(t);   RESC(); ROT();
    STEP(pA0,pA1,pB0,pB1,t+1,(t+4<NT),(t+2<NT),(t+2<NT));     ENDW(t+1); RESC(); ROT();
  }
  STEP(pB0,pB1,pA0,pA1,NT-1,false,false,false); RESC();
  { float sacc=pB0[0]+pB0[1]; _Pragma("unroll") for(int r=2;r<16;++r)sacc+=pB0[r]; _Pragma("unroll") for(int r=0;r<16;++r)sacc+=pB1[r]; l_reg+=sacc;
    pw0=(u32x4){PKW(pB0,0),PKW(pB0,2),PKW(pB0,4),PKW(pB0,6)};pw1=(u32x4){PKW(pB0,8),PKW(pB0,10),PKW(pB0,12),PKW(pB0,14)};pw2=(u32x4){PKW(pB1,0),PKW(pB1,2),PKW(pB1,4),PKW(pB1,6)};pw3=(u32x4){PKW(pB1,8),PKW(pB1,10),PKW(pB1,12),PKW(pB1,14)};
    SBAR(); pv128(o,(int)(unsigned)(uintptr_t)vp0+2*sl_cur,PAF(0),PAF(1),PAF(2),PAF(3)); }
  #undef PKW
  #undef PAF
  #undef PIN
  #undef MX3
  #undef GAPA
  #undef EX
  #undef VRDJ
  #undef VFJ
  #undef FIDX
  #undef VOFF
  #undef GAPB2
  #undef KRD
  #undef STEP
  #undef ENDW
  int lane_e=lane; asm volatile("":"+v"(lane_e)); const int r32e=lane_e&31,hie=lane_e>>5;
  {auto rr=__builtin_amdgcn_permlane32_swap(__float_as_uint(l_reg),__float_as_uint(l_reg),false,false);l_reg=__uint_as_float(rr[0])+__uint_as_float(rr[1]);}
  if(hie==0)wsf[32+r32e]=l_reg;asm volatile("s_waitcnt lgkmcnt(0)":::"memory");
  float rli[16];
  #pragma unroll
  for(int r=0;r<16;++r)rli[r]=__builtin_amdgcn_rcpf(wsf[32+crow(r,hie)]);
  bf16*Ow=O+(rowbase+q0+wid*QBLK)*PO;
  { bf16*stg=(bf16*)(shm+LDS2_OST)+wid*4096;
    #pragma unroll
    for(int r=0;r<16;++r){const int orow=crow(r,hie);
      #pragma unroll
      for(int d0=0;d0<4;++d0)stg[orow*128+d0*32+r32e]=__float2bfloat16(o[d0][r]*rli[r]);}
    asm volatile("s_waitcnt lgkmcnt(0)":::"memory");
    #pragma unroll
    for(int i=0;i<8;++i){const int row=i*4+(lane_e>>4),ch=lane_e&15; const u32x4 v=*(const u32x4*)(stg+row*128+ch*8); ATTN_STORE16(Ow+(long)row*PO+ch*8,v);} }
  asm volatile("s_waitcnt lgkmcnt(0)\n\ts_barrier":::"memory");
  #undef DMA_K
  #undef DMA_V
  #undef CMASK
  #undef START
  #undef RESC
  #undef ROT
}
constexpr int ATTN_LDS_BYTES=LDS2_BYTES;
#undef SBAR
#undef WAIT_BAR
}
#define GAS __attribute__((address_space(1)))
#define LAS __attribute__((address_space(3)))
typedef unsigned short bf16;
typedef unsigned v4u __attribute__((ext_vector_type(4)));
typedef float f32x4 __attribute__((ext_vector_type(4)));
typedef short bf16x8 __attribute__((ext_vector_type(8)));
typedef GAS unsigned gu32;
typedef GAS unsigned long long gu64;
#define RLX_AGENT __ATOMIC_RELAXED, __HIP_MEMORY_SCOPE_AGENT
#define LDS_WAIT() asm volatile("s_waitcnt lgkmcnt(0)" ::: "memory")
#define VM_WAIT() asm volatile("s_waitcnt vmcnt(0)" ::: "memory")
__device__ __forceinline__ unsigned long long rt() { return __builtin_amdgcn_s_memrealtime(); }
__device__ __forceinline__ unsigned f2bf(float f) { unsigned u = __builtin_bit_cast(unsigned, f); return (u + 0x7fffu + ((u >> 16) & 1u)) >> 16; }
__device__ __forceinline__ unsigned pk2(float lo, float hi) { return f2bf(lo) | (f2bf(hi) << 16); }

#define XB_TMO      128
#define XB_XCNT(j)  (256  + 64 * (j))
#define XB_XSUB(j)  (1280 + 64 * (j))
#define XB_XGEN(j)  (2304 + 64 * (j))
#define XB_TOP      3328
#define XB_TOPGEN   3392
#define XCD_BAR_WORDS 3456
#define XB_SPIN_CAP (1u << 18)

__device__ __forceinline__ unsigned xb_ld(unsigned* p)              { return __hip_atomic_load(p, __ATOMIC_RELAXED, __HIP_MEMORY_SCOPE_AGENT); }
__device__ __forceinline__ unsigned xb_add(unsigned* p, unsigned v) { return __hip_atomic_fetch_add(p, v, __ATOMIC_RELAXED, __HIP_MEMORY_SCOPE_AGENT); }
__device__ __forceinline__ unsigned xb_xcc_id() { return (unsigned)__builtin_amdgcn_s_getreg((3 << 11) | 20) & 0xFu; }
#define XB_SPIN(cond, bar) do { unsigned _sp = 0; while (cond) { __builtin_amdgcn_s_sleep(1); \
    if ((++_sp & 255u) == 0u) { if (xb_ld(&(bar)[XB_TMO])) break; if (_sp > XB_SPIN_CAP) { atomicAdd(&(bar)[XB_TMO], 1u); break; } } } } while (0)

struct XcdBarrier {
    unsigned* bar; unsigned x;
    volatile LAS unsigned* st;
};

__device__ __forceinline__ XcdBarrier xcd_barrier_post(unsigned* bar, volatile LAS unsigned* st) {
    XcdBarrier b; b.bar = bar; b.x = xb_xcc_id(); b.st = st;
    if (threadIdx.x == 0) (void)xb_add(&bar[XB_XCNT(b.x)], 1u);
    return b;
}
__device__ __forceinline__ void xcd_barrier_complete(unsigned* bar, unsigned x, unsigned& nloc, unsigned& nx) {
    const unsigned G = gridDim.x * gridDim.y * gridDim.z;
    unsigned sum, cnt, mine, sp = 0u;
    for (;;) {
        sum = 0u; cnt = 0u; mine = 0u;
#pragma unroll
        for (unsigned j = 0; j < 16; ++j) { const unsigned c = xb_ld(&bar[XB_XCNT(j)]); sum += c; cnt += (c > 0u) ? 1u : 0u; mine = (j == x) ? c : mine; }
        if (sum == G) break;
        __builtin_amdgcn_s_sleep(1);
        if ((++sp & 255u) == 0u) { if (xb_ld(&bar[XB_TMO])) break; if (sp > XB_SPIN_CAP) { atomicAdd(&bar[XB_TMO], 1u); break; } }
    }
    nloc = mine > 0u ? mine : 1u; nx = cnt > 0u ? cnt : 1u;
}

__device__ __forceinline__ void xcd_barrier(const XcdBarrier& b) {
    asm volatile("s_waitcnt vmcnt(0)" ::: "memory");
    __syncthreads();
    if (threadIdx.x == 0) {
        unsigned* bar = b.bar;
        __builtin_amdgcn_s_waitcnt(0);
        unsigned nloc = b.st[0], nx = b.st[1];
        if (nloc == 0u) { xcd_barrier_complete(bar, b.x, nloc, nx); b.st[0] = nloc; b.st[1] = nx; }
        const unsigned old = xb_add(&bar[XB_XSUB(b.x)], 1u);
        const unsigned gen = old / nloc;
        if (old + 1u == (gen + 1u) * nloc) {
            __builtin_amdgcn_fence(__ATOMIC_RELEASE, "agent");
            asm volatile("s_waitcnt vmcnt(0)" ::: "memory");
            const unsigned og = xb_add(&bar[XB_TOP], 1u);
            const unsigned tg = og / nx;
            if (og + 1u == (tg + 1u) * nx) xb_add(&bar[XB_TOPGEN], 1u);
            else XB_SPIN(xb_ld(&bar[XB_TOPGEN]) == tg, bar);
            __builtin_amdgcn_fence(__ATOMIC_ACQUIRE, "agent");
            xb_add(&bar[XB_XGEN(b.x)], 1u);
            asm volatile("s_waitcnt vmcnt(0)" ::: "memory");
        } else {
            XB_SPIN(xb_ld(&bar[XB_XGEN(b.x)]) == gen, bar);
            __builtin_amdgcn_fence(__ATOMIC_ACQUIRE, "agent");
            asm volatile("s_waitcnt vmcnt(0)" ::: "memory");
        }
    }
    __syncthreads();
}
constexpr int NWAVES = 8;
constexpr int BATCH = 4, SEQ = 8192, T = BATCH * SEQ, D = 1024;
constexpr int IN_COLS = 3328, RW_OFF = 1536, RWW = 512;
constexpr int NEXP = 32, TOPK = 4;
constexpr int P_MAX = T * TOPK + NEXP * 256, MAX_TILES = P_MAX / 256;
constexpr float NORM_EPS = 1e-5f, GN_EPS = 64e-5f, LAM_INIT = 0.2f;
constexpr size_t MiB = 1u << 20;
constexpr size_t WS_CTL = 0, CTL_ZERO_BYTES = 128 * 1024;
constexpr size_t WS_BS = 1 * MiB;
constexpr size_t WS_TOPI = 2 * MiB, WS_GATE = 2 * MiB + 512 * 1024, WS_POS = 3 * MiB;
constexpr size_t WS_RGATE = 5 * MiB;
constexpr size_t WS_RSRC = 7 * MiB;
constexpr size_t WS_RWS = 6 * MiB;
constexpr size_t WS_WO = 8 * MiB, WS_WL = 10 * MiB, WS_WIN = 11 * MiB, WS_W1 = 18 * MiB, WS_W2 = 146 * MiB;
constexpr size_t WS_PB = 210 * MiB;
constexpr size_t WS_YB = 418 * MiB;
constexpr size_t WS_LG = 482 * MiB;
constexpr size_t WS_AO = 514 * MiB;
constexpr size_t WS_FR = 706 * MiB;
constexpr size_t WS_XN = 902 * MiB;
constexpr size_t WS_X1 = 210 * MiB;
constexpr size_t WS_H2 = 338 * MiB;
constexpr size_t WS_ACT = 674 * MiB;
constexpr size_t WS_YS = 402 * MiB;
constexpr size_t WS_END = 1024 * MiB;
static_assert(WS_ACT + (size_t)P_MAX * 2048 <= WS_END && WS_YS + (size_t)T * 4 * 2048 <= WS_ACT && WS_XN + (size_t)T * 2048 <= WS_END && WS_FR + (size_t)BATCH * 8 * (SEQ / 16) * 12544 <= WS_XN && WS_AO + (size_t)T * 2048 <= WS_FR, "ws map");
constexpr int CW_TMO = 0, CW_CNT = 64, CW_WQ = 128, CW_DONE5 = 192, CW_AQ = 256, CW_BAR = 4096;
constexpr int RING_OFF = 0, RING_BYTES = 147456;
constexpr int LDSCTL_OFF = RING_BYTES, MISC_OFF = LDSCTL_OFF + 320;
constexpr int HIST_OFF = LDSCTL_OFF + 512, HBASE_OFF = LDSCTL_OFF + 640, PST_OFF = LDSCTL_OFF + 768, TILE_OFF = LDSCTL_OFF + 1024;
constexpr int LDS_BYTES = 163840;
static_assert(TILE_OFF + 4 * (MAX_TILES + 32) <= LDS_BYTES, "LDS map");
struct Args {
    const float* x; const int* positions; const float* attn_norm_w; const float* w_in; const float* shift_mu;
    const float *lq1, *lk1, *lq2, *lk2; const float* subln_w;
    const float *rw_w0, *rw_w2, *rw_a0, *rw_a2, *rw_g2, *rw_k_k, *rw_k_a, *rw_r_k, *rw_lnx_w, *rw_lnx_b;
    const float* w_out; const float* ffn_norm_w; const float* router_w; const float* router_b;
    const float *mlp1_w, *mlp1_b, *mlp2_w, *mlp2_b; const float* final_norm_w;
    float* out; unsigned char* ws; int ph_lo, ph_hi;
};
struct Frame { LAS unsigned char* lds; int tid, lane, wave, vcu, G; };
__device__ __forceinline__ Frame fresh(const Frame& F) { Frame G = F; G.tid = (int)__builtin_amdgcn_workitem_id_x(); asm volatile("" : "+v"(G.tid)); G.lane = G.tid & 63; return G; }
typedef const __attribute__((address_space(4))) Args* KArgs;
__device__ __forceinline__ KArgs get_args() { unsigned long long p = (unsigned long long)__builtin_amdgcn_kernarg_segment_ptr(); asm volatile("" : "+s"(p)); return (KArgs)p; }

__device__ __forceinline__ float wave_sum(float v) {
#pragma unroll
    for (int o = 1; o < 64; o <<= 1) v += __shfl_xor(v, o);
    return v;
}
__device__ __forceinline__ float bf2f(unsigned short h) { return __builtin_bit_cast(float, (unsigned)h << 16); }
__device__ __forceinline__ float bflo(unsigned w) { return __builtin_bit_cast(float, w << 16); }
__device__ __forceinline__ float bfhi(unsigned w) { return __builtin_bit_cast(float, w & 0xffff0000u); }
__device__ __forceinline__ float sigmoidf_(float v) { return 1.0f / (1.0f + __expf(-v)); }
typedef unsigned u32x2 __attribute__((ext_vector_type(2)));
__device__ __forceinline__ unsigned cvtpk(float lo, float hi) { return attn_body::cvtpk_s(lo, hi); }
typedef float f32x16 __attribute__((ext_vector_type(16)));

struct TrItem { f32x4 v[8]; };
__device__ __forceinline__ void tr_load(TrItem& t, const float* W, int N, int item, int lane) {
    const int nblk = N / 32, kb = item / nblk, nb = item % nblk, k0 = 64 * kb, n0 = 32 * nb; const int r = lane >> 3, c4 = (lane & 7) * 4;
#pragma unroll
    for (int p = 0; p < 8; ++p) t.v[p] = *(const f32x4*)(W + (size_t)(k0 + 8 * p + r) * N + n0 + c4);
}
__device__ __forceinline__ void tr_store(const TrItem& t, int K, int N, bf16* WT, LAS float* scr, int item, int lane) {
    LAS unsigned short* T = (LAS unsigned short*)scr; constexpr int PT = 40;
    const int nblk = N / 32, kb = item / nblk, nb = item % nblk, k0 = 64 * kb, n0 = 32 * nb; const int r = lane >> 3, c4 = (lane & 7) * 4;
#pragma unroll
    for (int p = 0; p < 8; ++p) { u32x2 w; w.x = cvtpk(t.v[p][0], t.v[p][1]); w.y = cvtpk(t.v[p][2], t.v[p][3]); *(LAS u32x2*)(T + (8 * p + r) * PT + c4) = w; }
    LDS_WAIT(); asm volatile("" ::: "memory");
    const int gq = lane >> 4, i = lane & 15, q = i >> 2, p4 = (i & 3) * 4, nbk = 16 * (gq & 1);
    const attn_body::lds_cptr tb = (attn_body::lds_cptr)(T + (8 * (gq >> 1) + q) * PT + nbk + p4);
#pragma unroll
    for (int rd = 0; rd < 4; ++rd) {
        const attn_body::s16x4 lo = attn_body::vtr(tb + (16 * rd) * PT * 2), hi = attn_body::vtr(tb + (16 * rd + 4) * PT * 2);
        v4u o; o.x = __builtin_bit_cast(u32x2, lo).x; o.y = __builtin_bit_cast(u32x2, lo).y; o.z = __builtin_bit_cast(u32x2, hi).x; o.w = __builtin_bit_cast(u32x2, hi).y;
        *(GAS v4u*)(WT + (size_t)(n0 + nbk + i) * K + k0 + 16 * rd + 8 * (gq >> 1)) = o; }
    LDS_WAIT(); asm volatile("" ::: "memory");
}
__device__ __forceinline__ void p0_transpose_item(const float* W, int K, int N, bf16* WT, LAS float* scr, int item, int lane) { TrItem t; tr_load(t, W, N, item, lane); tr_store(t, K, N, WT, scr, item, lane); }
__device__ __forceinline__ void tr_store8(const TrItem& t, int K, int N, unsigned char* WT, LAS float* scr, int item, int lane, float scale) {
    constexpr int PT = 36;
    const int nblk = N / 32, kb = item / nblk, nb = item % nblk, k0 = 64 * kb, n0 = 32 * nb; const int r = lane >> 3, c4 = (lane & 7) * 4;
#pragma unroll
    for (int p = 0; p < 8; ++p) *(LAS f32x4*)(scr + (8 * p + r) * PT + c4) = t.v[p] * scale;
    LDS_WAIT(); asm volatile("" ::: "memory");
    const int n = lane & 31, kh = lane >> 5; const LAS float* col = scr + (32 * kh) * PT + n;
    v4u o[2];
#pragma unroll
    for (int q = 0; q < 8; ++q) { const unsigned w = pg8::pk_fp8x4(col[(4 * q) * PT], col[(4 * q + 1) * PT], col[(4 * q + 2) * PT], col[(4 * q + 3) * PT]);
        if ((q & 3) == 0) o[q >> 2].x = w; else if ((q & 3) == 1) o[q >> 2].y = w; else if ((q & 3) == 2) o[q >> 2].z = w; else o[q >> 2].w = w; }
    GAS v4u* dst = (GAS v4u*)(WT + (size_t)(n0 + n) * K + k0 + 32 * kh);
    dst[0] = o[0]; dst[1] = o[1];
    LDS_WAIT(); asm volatile("" ::: "memory");
}

__device__ __forceinline__ void p0_prologue(const Frame& F, KArgs A) {
    unsigned char* ws = A->ws;
    LAS float* scr = (LAS float*)(F.lds + RING_OFF + F.wave * 16384);
    const int gw = F.vcu * NWAVES + F.wave, NGW = F.G * NWAVES;
    bf16* Win_t = (bf16*)(ws + WS_WIN); bf16* Wo_t = (bf16*)(ws + WS_WO); bf16* Wl_t = (bf16*)(ws + WS_WL);
    constexpr int I_IN = (D / 64) * (IN_COLS / 32), I_O = (D / 64) * (D / 32);
    constexpr int NITEMS = I_IN + I_O;
    for (int it = gw; it < NITEMS; it += NGW) {
        int r = it;
        if (r < I_IN) { p0_transpose_item(A->w_in, D, IN_COLS, Win_t, scr, r, F.lane); continue; } r -= I_IN;
        p0_transpose_item(A->w_out, D, D, Wo_t, scr, r, F.lane);
    }
    const int gt = F.vcu * (NWAVES * 64) + F.tid, NGT = F.G * NWAVES * 64;
    for (int idx = gt; idx < 1536 * 256; idx += NGT) { const int n = idx >> 8, k = idx & 255; float v = 0.f;
        if (n < 512) { if (k < 64) v = A->rw_w2[k * 512 + n]; }
        else if (n < 1024) { if (k >= 64 && k < 128) v = A->rw_a2[(k - 64) * 512 + (n - 512)]; }
        else { if (k >= 128) v = A->rw_g2[(k - 128) * 512 + (n - 1024)]; }
        Wl_t[idx] = (bf16)f2bf(v); }
    float* RWS = (float*)(ws + WS_RWS);
    for (int idx = gt; idx < D * NEXP; idx += NGT) RWS[idx] = A->router_w[idx] * A->ffn_norm_w[idx >> 5];
    float* RGATE0 = (float*)(ws + WS_RGATE);
    int* RSRC = (int*)(ws + WS_RSRC);
    for (int idx = gt; idx < P_MAX; idx += NGT) { RGATE0[idx] = 0.f; RSRC[idx] = 0; }
    bf16* XN = (bf16*)(ws + WS_XN);
    f32x4 nw[4];
#pragma unroll
    for (int j = 0; j < 4; ++j) nw[j] = *((const f32x4*)A->attn_norm_w + F.lane + 64 * j);
    for (int m = gw; m < T; m += NGW) {
        const GAS f32x4* xr = (const GAS f32x4*)(A->x + (size_t)m * D) + F.lane;
        f32x4 v[4]; float s2 = 0.f;
#pragma unroll
        for (int j = 0; j < 4; ++j) { v[j] = xr[64 * j]; s2 += (v[j].x * v[j].x + v[j].y * v[j].y) + (v[j].z * v[j].z + v[j].w * v[j].w); }
        const float rstd = 1.f / sqrtf(wave_sum(s2) * (1.f / D) + NORM_EPS);
        GAS unsigned long long* o8 = (GAS unsigned long long*)(XN + (size_t)m * D) + F.lane;
#pragma unroll
        for (int j = 0; j < 4; ++j) o8[64 * j] = (unsigned long long)pk2(v[j].x * rstd * nw[j].x, v[j].y * rstd * nw[j].y) | ((unsigned long long)pk2(v[j].z * rstd * nw[j].z, v[j].w * rstd * nw[j].w) << 32);
    }
}

template <bool STOP> __device__ __forceinline__ void moe_weight_queue(const Frame& F, KArgs A, gu32* ctl, unsigned stop_at) {
    unsigned char* ws = A->ws;
    LAS float* scr = (LAS float*)(F.lds + RING_OFF + F.wave * 16384);
    unsigned char* W1_t = ws + WS_W1; unsigned char* W2_t = ws + WS_W2;
    constexpr int I_1E = (D / 64) * (2048 / 32), I_2E = (D / 64) * (D / 32), NITEMS = NEXP * I_1E + NEXP * I_2E, GRAB = 4;
    for (;;) {
        if (STOP) { if ((unsigned)__builtin_amdgcn_readfirstlane((int)__hip_atomic_load(ctl + CW_DONE5, __ATOMIC_RELAXED, __HIP_MEMORY_SCOPE_AGENT)) >= stop_at) break; }
        unsigned base = 0u; if (F.lane == 0) base = __hip_atomic_fetch_add(ctl + CW_WQ, (unsigned)GRAB, __ATOMIC_RELAXED, __HIP_MEMORY_SCOPE_AGENT);
        base = (unsigned)__builtin_amdgcn_readfirstlane((int)base);
        if (base >= (unsigned)NITEMS) break;
        for (int k = 0; k < GRAB; ++k) { int r = (int)base + k; if (r >= NITEMS) break;
            TrItem ti;
            if (r < NEXP * I_1E) { const int e = r / I_1E; tr_load(ti, A->mlp1_w + (size_t)e * D * 2048, 2048, r % I_1E, F.lane); tr_store8(ti, D, 2048, W1_t + (size_t)e * 2048 * D, scr, r % I_1E, F.lane, pg8::MOE_WSCALE); }
            else { r -= NEXP * I_1E; const int e = r / I_2E; tr_load(ti, A->mlp2_w + (size_t)e * D * D, D, r % I_2E, F.lane); tr_store8(ti, D, D, W2_t + (size_t)e * D * D, scr, r % I_2E, F.lane, pg8::MOE_WSCALE); } }
    }
}

__device__ __forceinline__ void moe_weight_queue_scan(const Frame& F, KArgs A, gu32* ctl, int stop_word, unsigned stop_at) {
    unsigned char* ws = A->ws;
    LAS float* scr = (LAS float*)(F.lds + RING_OFF + F.wave * 16384);
    unsigned char* W1_t = ws + WS_W1; unsigned char* W2_t = ws + WS_W2;
    constexpr int I_1E = (D / 64) * (2048 / 32), I_2E = (D / 64) * (D / 32), NITEMS = NEXP * I_1E + NEXP * I_2E, GRAB = 4;
    static_assert(I_1E % GRAB == 0 && I_2E % GRAB == 0, "a grab stays inside one expert matrix");
    for (;;) {
        if ((unsigned)__builtin_amdgcn_readfirstlane((int)__hip_atomic_load(ctl + stop_word, __ATOMIC_RELAXED, __HIP_MEMORY_SCOPE_AGENT)) >= stop_at) break;
        unsigned base = 0u; if (F.lane == 0) base = __hip_atomic_fetch_add(ctl + CW_WQ, (unsigned)GRAB, __ATOMIC_RELAXED, __HIP_MEMORY_SCOPE_AGENT);
        base = (unsigned)__builtin_amdgcn_readfirstlane((int)base);
        if (base >= (unsigned)NITEMS) break;
        const int r0 = (int)base; const bool first = r0 < NEXP * I_1E; const int rr = first ? r0 : r0 - NEXP * I_1E, ipe = first ? I_1E : I_2E, e = rr / ipe, it0 = rr % ipe, Nn = first ? 2048 : D;
        const float* Wsrc = first ? A->mlp1_w + (size_t)e * D * 2048 : A->mlp2_w + (size_t)e * D * D; unsigned char* Wdst = first ? W1_t + (size_t)e * 2048 * D : W2_t + (size_t)e * D * D;
#pragma unroll 1
        for (int k = 0; k < GRAB; k += 2) { TrItem ta, tb; tr_load(ta, Wsrc, Nn, it0 + k, F.lane); tr_load(tb, Wsrc, Nn, it0 + k + 1, F.lane);
            tr_store8(ta, D, Nn, Wdst, scr, it0 + k, F.lane, pg8::MOE_WSCALE); tr_store8(tb, D, Nn, Wdst, scr, it0 + k + 1, F.lane, pg8::MOE_WSCALE); }
    }
}

__device__ __forceinline__ void p2_prep(const Frame& F, KArgs A) {
    unsigned char* ws = A->ws;
    bf16* PB = (bf16*)(ws + WS_PB); bf16* LA = (bf16*)(ws + WS_XN);
    const int gw = F.vcu * NWAVES + F.wave, NGW = F.G * NWAVES, lane = F.lane;
    const int g = lane & 7, i0 = 4 * g;
    float invf[4];
#pragma unroll
    for (int i = 0; i < 4; ++i) invf[i] = exp2f(-(float)(i0 + i) * (13.287712379549449f / 32.0f));
    for (int t = gw; t < T; t += NGW) {
        const int s = t & (SEQ - 1);
        const float pos = (float)A->positions[t];
        bf16* row = PB + (size_t)t * IN_COLS;
        float cs[4], sn[4];
#pragma unroll
        for (int i = 0; i < 4; ++i) { const float ang = pos * invf[i]; double rev = (double)ang * 0.15915494309189535; rev -= floor(rev); const float rf = (float)rev;
            sn[i] = __builtin_amdgcn_sinf(rf); cs[i] = __builtin_amdgcn_cosf(rf); }
#pragma unroll
        for (int j = 0; j < 2; ++j) { const int blk = (lane >> 3) + 8 * j; bf16* p1 = row + blk * 64 + i0; bf16* p2 = p1 + 32;
            const u32x2 a = *(const u32x2*)p1, b = *(const u32x2*)p2; const float sc = blk < 8 ? attn_body::C2 : 1.0f;
            const float x1[4] = {bflo(a.x), bfhi(a.x), bflo(a.y), bfhi(a.y)}, x2[4] = {bflo(b.x), bfhi(b.x), bflo(b.y), bfhi(b.y)};
            float o1[4], o2[4];
#pragma unroll
            for (int i = 0; i < 4; ++i) { o1[i] = (x1[i] * cs[i] - x2[i] * sn[i]) * sc; o2[i] = (x2[i] * cs[i] + x1[i] * sn[i]) * sc; }
            u32x2 wa, wb; wa.x = pk2(o1[0], o1[1]); wa.y = pk2(o1[2], o1[3]); wb.x = pk2(o2[0], o2[1]); wb.y = pk2(o2[2], o2[3]);
            *(u32x2*)p1 = wa; *(u32x2*)p2 = wb; }
        {
            const int c4 = lane * 4; const bf16* pc = row + RW_OFF + 1536 + c4;
            const u32x2 cu = *(const u32x2*)pc; u32x2 pu = *(const u32x2*)(pc - (s > 0 ? IN_COLS : 0)); pu.x = s > 0 ? pu.x : 0u; pu.y = s > 0 ? pu.y : 0u;
            const f32x4 mu = *(const f32x4*)(A->shift_mu + 1536 + c4);
            const float cur[4] = {bflo(cu.x), bfhi(cu.x), bflo(cu.y), bfhi(cu.y)}, prv[4] = {bflo(pu.x), bfhi(pu.x), bflo(pu.y), bfhi(pu.y)};
            f32x4 v, o;
#pragma unroll
            for (int i = 0; i < 4; ++i) v[i] = cur[i] + mu[i] * (prv[i] - cur[i]);
            if (c4 < 64) { for (int i = 0; i < 4; ++i) { const float e2 = __expf(2.0f * v[i]); o[i] = 1.0f - 2.0f * __builtin_amdgcn_rcpf(e2 + 1.0f); } }
            else if (c4 < 128) o = v;
            else { for (int i = 0; i < 4; ++i) o[i] = __builtin_amdgcn_rcpf(1.0f + __expf(-v[i])); }
            u32x2 w; w.x = pk2(o[0], o[1]); w.y = pk2(o[2], o[3]);
            *(u32x2*)(LA + (size_t)t * 256 + c4) = w;
        }
    }
}

constexpr int FR_KA = 0, FR_RT = 2048, FR_AU = 4096, FR_AY = 5120, FR_AS = 6144, FR_VT = 10240, FR_GC = 12288, FR_BYTES = 12544, NCHUNK = SEQ / 16;
#define SC_MFMA(a, b, c) __builtin_amdgcn_mfma_f32_16x16x32_bf16(__builtin_bit_cast(bf16x8, a), __builtin_bit_cast(bf16x8, b), c, 0, 0, 0)
template <int CTRL> __device__ __forceinline__ float dpp_f(float v) { return __builtin_bit_cast(float, __builtin_amdgcn_update_dpp(0, __builtin_bit_cast(int, v), CTRL, 0xF, 0xF, true)); }
__device__ __forceinline__ f32x4 mm16(const f32x4& XT, const f32x4& Y) {
    f32x4 o = {0.f, 0.f, 0.f, 0.f};
#pragma unroll
    for (int s = 0; s < 4; ++s) o = __builtin_amdgcn_mfma_f32_16x16x4f32(XT[s], Y[s], o, 0, 0, 0);
    return o;
}
__device__ __forceinline__ v4u pack8(const float* x) { v4u o; o.x = cvtpk(x[0], x[1]); o.y = cvtpk(x[2], x[3]); o.z = cvtpk(x[4], x[5]); o.w = cvtpk(x[6], x[7]); return o; }
__device__ __forceinline__ f32x4 shift4(const bf16* pc, bool has_prev, const float* mu) {
    const u32x2 cu = *(const u32x2*)pc; u32x2 pu = *(const u32x2*)(pc - (has_prev ? IN_COLS : 0));
    pu.x = has_prev ? pu.x : 0u; pu.y = has_prev ? pu.y : 0u;
    const f32x4 m = *(const f32x4*)mu;
    const float cur[4] = {bflo(cu.x), bfhi(cu.x), bflo(cu.y), bfhi(cu.y)}, prv[4] = {bflo(pu.x), bfhi(pu.x), bflo(pu.y), bfhi(pu.y)};
    f32x4 v;
#pragma unroll
    for (int i = 0; i < 4; ++i) v[i] = cur[i] + m[i] * (prv[i] - cur[i]);
    return v;
}
struct PrepRaw { v4u lab[8]; u32x2 rc[4], rp[4], kc[4], kp[4], vc[4], vp[4]; };
__device__ __forceinline__ void prep_load_la(PrepRaw& R, const bf16* LA, int ci, int i, int g) {
    const int bh = ci / NCHUNK, chk = ci % NCHUNK, b = bh >> 3;
    const bf16* pla = LA + ((size_t)b * SEQ + chk * 16 + i) * 256 + 8 * g;
#pragma unroll
    for (int sx = 0; sx < 8; ++sx) R.lab[sx] = *(const v4u*)(pla + 32 * sx);
}
__device__ __forceinline__ void prep_load_rkv(PrepRaw& R, const bf16* PB, int ci, int i, int g) {
    const int bh = ci / NCHUNK, chk = ci % NCHUNK, b = bh >> 3, h = bh & 7;
    const size_t t = (size_t)b * SEQ + chk * 16 + i; const bool hp = (chk * 16 + i) > 0;
    const bf16* prow = PB + t * IN_COLS + RW_OFF + h * 64 + 4 * g; const bf16* pprev = prow - (hp ? IN_COLS : 0);
#pragma unroll
    for (int q = 0; q < 4; ++q) {
        R.rc[q] = *(const u32x2*)(prow + 16 * q); R.rp[q] = *(const u32x2*)(pprev + 16 * q);
        R.kc[q] = *(const u32x2*)(prow + 512 + 16 * q); R.kp[q] = *(const u32x2*)(pprev + 512 + 16 * q);
        R.vc[q] = *(const u32x2*)(prow + 1024 + 16 * q); R.vp[q] = *(const u32x2*)(pprev + 1024 + 16 * q); }
}
__device__ __forceinline__ f32x4 shiftr(const u32x2 cu, u32x2 pu, bool hp, const f32x4 m) {
    pu.x = hp ? pu.x : 0u; pu.y = hp ? pu.y : 0u;
    const float cur[4] = {bflo(cu.x), bfhi(cu.x), bflo(cu.y), bfhi(cu.y)}, prv[4] = {bflo(pu.x), bfhi(pu.x), bflo(pu.y), bfhi(pu.y)};
    f32x4 v;
#pragma unroll
    for (int k = 0; k < 4; ++k) v[k] = cur[k] + m[k] * (prv[k] - cur[k]);
    return v;
}
__device__ __forceinline__ void prep_body(PrepRaw& R, int ci, int ci_next, const bf16* LA, const bf16* PB, bf16* LG, const LAS unsigned char* WLF, int lane_in, LAS unsigned short* TB, const LAS float* CST, float* BS, unsigned char* FR) {
    int lane = lane_in; asm volatile("" : "+v"(lane));
    const int i = lane & 15, g = lane >> 4;
    LAS unsigned short* TK = TB + 1024; LAS unsigned short* TV = TB + 2048;
    {
        const int bh = ci / NCHUNK, chk = ci % NCHUNK, b = bh >> 3, h = bh & 7;
        const size_t t0 = (size_t)b * SEQ + chk * 16, t = t0 + i;
        const bool hp = (chk * 16 + i) > 0;
        float nlw[16], av[16], kkv[16], km[16], rr[16], vs[16]; float ss = 0.f, bsum = 0.f;
#pragma unroll
        for (int q = 0; q < 4; ++q) {
            const LAS f32x4* cq = (const LAS f32x4*)(CST + 16 * q + 4 * g);
            const f32x4 r4 = shiftr(R.rc[q], R.rp[q], hp, cq[0]), ks4 = shiftr(R.kc[q], R.kp[q], hp, cq[16]), v4 = shiftr(R.vc[q], R.vp[q], hp, cq[32]);
            const f32x4 w04 = cq[48], a04 = cq[64], kk4 = cq[80], ka4 = cq[96], rk4 = cq[112];
            const LAS v4u* wq = (const LAS v4u*)(WLF + (q * 8) * 1024) + lane; const f32x4 zl = {0.f, 0.f, 0.f, 0.f};
            const f32x4 lw = SC_MFMA(wq[64], R.lab[1], SC_MFMA(wq[0], R.lab[0], zl)), la = SC_MFMA(wq[192], R.lab[3], SC_MFMA(wq[128], R.lab[2], zl));
            const f32x4 gg = SC_MFMA(wq[448], R.lab[7], SC_MFMA(wq[384], R.lab[6], SC_MFMA(wq[320], R.lab[5], SC_MFMA(wq[256], R.lab[4], zl))));
            { u32x2 go; go.x = cvtpk(gg[0], gg[1]); go.y = cvtpk(gg[2], gg[3]); *(u32x2*)(LG + t * RWW + h * 64 + 16 * q + 4 * g) = go; }
#pragma unroll
            for (int j = 0; j < 4; ++j) { const int x = q * 4 + j;
                const float u = fminf(-(w04[j] + lw[j]), 60.f);
                nlw[x] = -0.6065306597126334f * __builtin_amdgcn_rcpf(1.0f + __expf(u));
                av[x] = __builtin_amdgcn_rcpf(1.0f + __expf(-(a04[j] + la[j])));
                kkv[x] = ks4[j] * kk4[j]; ss += kkv[x] * kkv[x];
                km[x] = ks4[j] * (1.0f + (av[x] - 1.0f) * ka4[j]);
                rr[x] = r4[j]; vs[x] = v4[j]; bsum += r4[j] * km[x] * rk4[j]; }
        }
        ss += __shfl_xor(ss, 16); ss += __shfl_xor(ss, 32); bsum += __shfl_xor(bsum, 16); bsum += __shfl_xor(bsum, 32);
        const float rn = fminf(__builtin_amdgcn_rsqf(ss), 1e12f);
        if (g == 0) BS[t * 8 + h] = bsum;
        float Ka[16], Bt[16], Kt[16], Rt[16], gam[16];
#pragma unroll
        for (int x = 0; x < 16; ++x) {
            float c = nlw[x];
            c += dpp_f<0x111>(c); c += dpp_f<0x112>(c); c += dpp_f<0x114>(c); c += dpp_f<0x118>(c);
            const float gm = __expf(c), ig = __builtin_amdgcn_rcpf(gm), kk = kkv[x] * rn; float gm1 = dpp_f<0x111>(gm); gm1 = i == 0 ? 1.0f : gm1;
            gam[x] = gm; Ka[x] = gm1 * kk; Bt[x] = kk * av[x] * ig; Kt[x] = km[x] * ig; Rt[x] = gm * rr[x];
        }
        const v4u pKa0 = pack8(Ka), pKa1 = pack8(Ka + 8), pRt0 = pack8(Rt), pRt1 = pack8(Rt + 8), pBt0 = pack8(Bt), pBt1 = pack8(Bt + 8), pKt0 = pack8(Kt), pKt1 = pack8(Kt + 8);
#pragma unroll
        for (int x = 0; x < 16; ++x) { const int k = 16 * (x >> 2) + 4 * g + (x & 3); const unsigned bk = cvtpk(Bt[x], Kt[x]), vv = cvtpk(vs[x], 0.f);
            TB[k * 16 + i] = (unsigned short)bk; TK[k * 16 + i] = (unsigned short)(bk >> 16); TV[k * 16 + i] = (unsigned short)vv; }
        if (ci_next >= 0) prep_load_rkv(R, PB, ci_next, i, g);
        const f32x4 z4 = {0.f, 0.f, 0.f, 0.f};
        f32x4 N = SC_MFMA(pBt1, pKa1, SC_MFMA(pBt0, pKa0, z4)), NT = SC_MFMA(pKa1, pBt1, SC_MFMA(pKa0, pBt0, z4)), MkT = SC_MFMA(pKa1, pKt1, SC_MFMA(pKa0, pKt0, z4));
        f32x4 Rb = SC_MFMA(pBt1, pRt1, SC_MFMA(pBt0, pRt0, z4)), Rk = SC_MFMA(pKt1, pRt1, SC_MFMA(pKt0, pRt0, z4));
        f32x4 I1, IN2T, IN4T, IN8;
#pragma unroll
        for (int r = 0; r < 4; ++r) { const int row = 4 * g + r; I1[r] = row == i ? 1.f : 0.f;
            N[r] = row < i ? N[r] : 0.f; NT[r] = i < row ? NT[r] : 0.f; MkT[r] = i < row ? MkT[r] : 0.f; Rb[r] = row <= i ? Rb[r] : 0.f; Rk[r] = row <= i ? Rk[r] : 0.f; }
        const f32x4 N2 = mm16(NT, N), N2T = mm16(N, NT), N4 = mm16(N2T, N2), N4T = mm16(N2, N2T), N8 = mm16(N4T, N4);
        IN2T = I1 + N2T; IN4T = I1 + N4T; IN8 = I1 + N8;
        const f32x4 H1 = mm16(IN4T, IN8), H2 = mm16(IN2T, H1); const f32x4 F1T = I1 - NT; const f32x4 Tinv = mm16(F1T, H2), Wm = mm16(MkT, Tinv);
        unsigned char* fb = FR + (size_t)ci * FR_BYTES + lane * 16;
        *(v4u*)(fb + FR_KA) = pKa0; *(v4u*)(fb + FR_KA + 1024) = pKa1;
        *(v4u*)(fb + FR_RT) = pRt0; *(v4u*)(fb + FR_RT + 1024) = pRt1;
        { const float au[8] = {-Tinv[0], -Tinv[1], -Tinv[2], -Tinv[3], -Wm[0], -Wm[1], -Wm[2], -Wm[3]}; *(v4u*)(fb + FR_AU) = pack8(au);
          const float ay[8] = {Rb[0], Rb[1], Rb[2], Rb[3], Rk[0], Rk[1], Rk[2], Rk[3]}; *(v4u*)(fb + FR_AY) = pack8(ay); }
        if (ci_next >= 0) prep_load_la(R, LA, ci_next, i, g);
        LDS_WAIT(); asm volatile("" ::: "memory");
#pragma unroll
        for (int i4 = 0; i4 < 4; ++i4) { const u32x2 bq = *(const LAS u32x2*)(TB + (16 * i4 + i) * 16 + 4 * g), kq = *(const LAS u32x2*)(TK + (16 * i4 + i) * 16 + 4 * g);
            v4u o; o.x = bq.x; o.y = bq.y; o.z = kq.x; o.w = kq.y; *(v4u*)(fb + FR_AS + i4 * 1024) = o;
            const u32x2 vq = *(const LAS u32x2*)(TV + (16 * i4 + i) * 16 + 4 * g);
            *(u32x2*)(FR + (size_t)ci * FR_BYTES + FR_VT + i4 * 512 + lane * 8) = vq; }
        LDS_WAIT(); asm volatile("" ::: "memory");
        if (i == 15) { float* gc = (float*)(FR + (size_t)ci * FR_BYTES + FR_GC) + g * 16;
#pragma unroll
            for (int q = 0; q < 4; ++q) *(f32x4*)(gc + 4 * q) = (f32x4){gam[4 * q], gam[4 * q + 1], gam[4 * q + 2], gam[4 * q + 3]}; }
    }
}
__device__ __forceinline__ void p4_chunk_prep(const Frame& F, KArgs A) {
    unsigned char* ws = A->ws;
    const bf16* LA = (const bf16*)(ws + WS_XN); const bf16* PB = (const bf16*)(ws + WS_PB); bf16* LG = (bf16*)(ws + WS_LG); const bf16* Wl_t = (const bf16*)(ws + WS_WL);
    float* BS = (float*)(ws + WS_BS); unsigned char* FR = ws + WS_FR;
    const int gw = F.vcu * NWAVES + F.wave, lane = F.lane, i = lane & 15, g = lane >> 4;
    LAS unsigned short* TB = (LAS unsigned short*)(F.lds + RING_OFF + F.wave * 8192); LAS float* CST = (LAS float*)(TB + 3072);
    LAS unsigned char* WLF = F.lds + RING_OFF + 65536;
    constexpr int CPW = (BATCH * 8 * NCHUNK) / (256 * NWAVES);
    static_assert(CPW == 8 && NCHUNK % (CPW * NWAVES) == 0, "a workgroup's chunks share one head");
    const int ci0 = gw * CPW;
    { const int h = ((F.vcu * NWAVES * CPW) / NCHUNK) & 7;
#pragma unroll
      for (int k = 0; k < 4; ++k) { const int e = F.tid + 512 * k, q = e >> 9, sx = (e >> 6) & 7, l = e & 63;
          const int n = (sx < 2 ? 0 : sx < 4 ? 512 : 1024) + h * 64 + 16 * q + (l & 15);
          *(LAS v4u*)(WLF + (size_t)e * 16) = *(const v4u*)(Wl_t + (size_t)n * 256 + 32 * sx + 8 * (l >> 4)); }
      const int c = h * 64 + lane;
      CST[lane] = A->shift_mu[c]; CST[64 + lane] = A->shift_mu[512 + c]; CST[128 + lane] = A->shift_mu[1024 + c];
      CST[192 + lane] = A->rw_w0[c]; CST[256 + lane] = A->rw_a0[c]; CST[320 + lane] = A->rw_k_k[c]; CST[384 + lane] = A->rw_k_a[c]; CST[448 + lane] = A->rw_r_k[c];
      __syncthreads(); }
    if (ci0 >= BATCH * 8 * NCHUNK) return;
    PrepRaw ra;
    prep_load_la(ra, LA, ci0, i, g); prep_load_rkv(ra, PB, ci0, i, g);
#pragma unroll 1
    for (int cj = 0; cj < CPW; ++cj) prep_body(ra, ci0 + cj, cj + 1 < CPW ? ci0 + cj + 1 : -1, LA, PB, LG, WLF, lane, TB, CST, BS, FR);
}

__device__ __forceinline__ void scan_phase3(const Frame& F, KArgs A, int bh) {
    constexpr int GRP = 4, NGRP = NCHUNK / GRP, SLOT = 13312, FBUF = GRP * SLOT, YOFF = 2 * FBUF, YBUF = GRP * 16 * 64 * 4;
    static_assert(YOFF + 2 * YBUF <= RING_BYTES, "scan rings fit the LDS ring region");
    LAS unsigned char* L = F.lds + RING_OFF;
    const unsigned char* fr = A->ws + WS_FR + (size_t)bh * NCHUNK * FR_BYTES;
    const int lane = F.lane, b = bh >> 3, h = bh & 7;
    if (F.wave >= 4) {
        const int io = F.wave - 4;
        bf16* yb = (bf16*)(A->ws + WS_YB) + (size_t)b * SEQ * RWW + h * 64;
#define SC_ISSUE(n) do { const unsigned char* src_ = fr + (size_t)(n) * GRP * FR_BYTES + lane * 16; const int bo_ = ((n) & 1) * FBUF; \
        _Pragma("unroll") for (int k_ = 0; k_ < 13; ++k_) { const int p_ = io + 4 * k_, ci_ = p_ / 13, pc_ = p_ % 13; \
            __builtin_amdgcn_global_load_lds((const unsigned*)(src_ + (size_t)ci_ * FR_BYTES + pc_ * 1024), (LAS unsigned*)(L + bo_ + ci_ * SLOT + pc_ * 1024), 16, 0, 0); } } while (0)
#define SC_YOUT(n) do { const LAS float* ys_ = (const LAS float*)(L + YOFF + ((n) & 1) * YBUF); \
        _Pragma("unroll") for (int k_ = 0; k_ < 4; ++k_) { const int i4_ = io * 64 + lane + 256 * k_, ci_ = i4_ >> 8, t_ = (i4_ >> 4) & 15, v4_ = i4_ & 15; \
            const f32x4 y_ = *(const LAS f32x4*)(ys_ + i4_ * 4); u32x2 w_; w_.x = cvtpk(y_[0], y_[1]); w_.y = cvtpk(y_[2], y_[3]); *(u32x2*)(yb + ((size_t)((n) * GRP + ci_) * 16 + t_) * RWW + v4_ * 4) = w_; } } while (0)
        SC_ISSUE(0);
        __syncthreads();
        for (int n = 0; n < NGRP; ++n) {
            if (n + 1 < NGRP) SC_ISSUE(n + 1);
            if (n > 0) SC_YOUT(n - 1);
            __syncthreads();
        }
        SC_YOUT(NGRP - 1);
#undef SC_ISSUE
#undef SC_YOUT
    } else {
        const int wv = F.wave, vl = lane & 15, g = lane >> 4;
        f32x4 s0 = {0.f, 0.f, 0.f, 0.f}, s1 = s0, s2 = s0, s3 = s0; const f32x4 zero = {0.f, 0.f, 0.f, 0.f};
        __syncthreads();
        for (int n = 0; n < NGRP; ++n) {
            const LAS unsigned char* fbuf = L + (n & 1) * FBUF; LAS float* ybuf = (LAS float*)(L + YOFF + (n & 1) * YBUF) + (4 * g) * 64 + 16 * wv + vl;
#pragma unroll
            for (int ci = 0; ci < GRP; ++ci) {
                const LAS unsigned char* p = fbuf + ci * SLOT; const LAS unsigned char* q = p + lane * 16;
                const v4u ka0 = *(const LAS v4u*)(q + FR_KA), ka1 = *(const LAS v4u*)(q + FR_KA + 1024), rt0 = *(const LAS v4u*)(q + FR_RT), rt1 = *(const LAS v4u*)(q + FR_RT + 1024);
                const v4u au = *(const LAS v4u*)(q + FR_AU), ay = *(const LAS v4u*)(q + FR_AY);
                const v4u as0 = *(const LAS v4u*)(q + FR_AS), as1 = *(const LAS v4u*)(q + FR_AS + 1024), as2 = *(const LAS v4u*)(q + FR_AS + 2048), as3 = *(const LAS v4u*)(q + FR_AS + 3072);
                const LAS f32x4* gc = (const LAS f32x4*)(p + FR_GC) + g * 4; const f32x4 gc0 = gc[0], gc1 = gc[1], gc2 = gc[2], gc3 = gc[3];
                const u32x2 vt = *(const LAS u32x2*)(p + FR_VT + wv * 512 + lane * 8);
                v4u bS0, bS1; bS0.x = cvtpk(s0[0], s0[1]); bS0.y = cvtpk(s0[2], s0[3]); bS0.z = cvtpk(s1[0], s1[1]); bS0.w = cvtpk(s1[2], s1[3]);
                bS1.x = cvtpk(s2[0], s2[1]); bS1.y = cvtpk(s2[2], s2[3]); bS1.z = cvtpk(s3[0], s3[1]); bS1.w = cvtpk(s3[2], s3[3]);
                f32x4 PT = SC_MFMA(ka0, bS0, zero); PT = SC_MFMA(ka1, bS1, PT);
                f32x4 YT = SC_MFMA(rt0, bS0, zero); YT = SC_MFMA(rt1, bS1, YT);
                v4u bU; bU.x = cvtpk(PT[0], PT[1]); bU.y = cvtpk(PT[2], PT[3]); bU.z = vt.x; bU.w = vt.y;
                const f32x4 UT = SC_MFMA(au, bU, zero);
                bU.x = cvtpk(UT[0], UT[1]); bU.y = cvtpk(UT[2], UT[3]);
                YT = SC_MFMA(ay, bU, YT);
                s0 = SC_MFMA(as0, bU, s0) * gc0; s1 = SC_MFMA(as1, bU, s1) * gc1; s2 = SC_MFMA(as2, bU, s2) * gc2; s3 = SC_MFMA(as3, bU, s3) * gc3;
                LAS float* yo = ybuf + ci * 1024;
                yo[0] = YT[0]; yo[64] = YT[1]; yo[128] = YT[2]; yo[192] = YT[3];
            }
            __syncthreads();
        }
    }
    __syncthreads();
}

__device__ __forceinline__ void attn_queue(const Frame& F, KArgs A, gu32* ctl) {
    const attn_body::bf16* PB = (const attn_body::bf16*)(A->ws + WS_PB); attn_body::bf16* OA = (attn_body::bf16*)(A->ws + WS_XN);
    char* shm = (char*)(F.lds + RING_OFF);
    volatile LAS unsigned* slot = (volatile LAS unsigned*)(F.lds + MISC_OFF) + 16;
    const int x = (int)(blockIdx.x & 7);
    for (;;) {
        if (F.tid == 0) slot[0] = __hip_atomic_fetch_add(ctl + CW_AQ + 64 * x, 1u, __ATOMIC_RELAXED, __HIP_MEMORY_SCOPE_AGENT);
        __syncthreads();
        const int u = __builtin_amdgcn_readfirstlane((int)slot[0]);
        __syncthreads();
        if (u >= 128) break;
        int cb = x + 8 * (u & 3); asm volatile("" : "+s"(cb));
        const int qb = 31 - (u >> 2), b = cb >> 3, h = (cb >> 1) & 3, c = cb & 1;
        const attn_body::bf16* Q = PB + h * 128 + c * 64; const attn_body::bf16* K = PB + 512 + h * 128 + c * 64; const attn_body::bf16* V = PB + 1024 + h * 128;
        attn_body::attn_unit128<8>(b, qb, Q, K, V, OA + h * 256 + c * 128, shm);
    }
}

__device__ __forceinline__ void p6_combine(const Frame& F, KArgs A) {
    unsigned char* ws = A->ws;
    const bf16* OA = (const bf16*)(ws + WS_XN); const bf16* YB = (const bf16*)(ws + WS_YB); const bf16* LG = (const bf16*)(ws + WS_LG);
    const bf16* PB = (const bf16*)(ws + WS_PB); const float* BS = (const float*)(ws + WS_BS);
    bf16* AO = (bf16*)(ws + WS_AO);
    const int gw = F.vcu * NWAVES + F.wave, NGW = F.G * NWAVES, lane = F.lane;
    const float lam = __expf(wave_sum(A->lq1[lane] * A->lk1[lane])) - __expf(wave_sum(A->lq2[lane] * A->lk2[lane])) + LAM_INIT;
    const int hd = lane >> 4, dv = (lane & 15) * 8, c8 = lane * 8, hr = lane >> 3;
    float sw[8], lw[8], lb[8];
#pragma unroll
    for (int i = 0; i < 8; ++i) { sw[i] = A->subln_w[dv + i] * (1.0f - LAM_INIT); lw[i] = A->rw_lnx_w[c8 + i]; lb[i] = A->rw_lnx_b[c8 + i]; }
    for (int t = gw; t < T; t += NGW) {
        const v4u p0 = *(const v4u*)(OA + (size_t)t * 1024 + hd * 256 + dv), p1 = *(const v4u*)(OA + (size_t)t * 1024 + hd * 256 + 128 + dv);
        const float o0[8] = {bflo(p0.x), bfhi(p0.x), bflo(p0.y), bfhi(p0.y), bflo(p0.z), bfhi(p0.z), bflo(p0.w), bfhi(p0.w)};
        const float o1[8] = {bflo(p1.x), bfhi(p1.x), bflo(p1.y), bfhi(p1.y), bflo(p1.z), bfhi(p1.z), bflo(p1.w), bfhi(p1.w)};
        float d[8]; float ss = 0.f;
#pragma unroll
        for (int i = 0; i < 8; ++i) { d[i] = o0[i] - lam * o1[i]; ss += d[i] * d[i]; }
        ss += __shfl_xor(ss, 1); ss += __shfl_xor(ss, 2); ss += __shfl_xor(ss, 4); ss += __shfl_xor(ss, 8);
        const float rs = 1.0f / sqrtf(ss * (1.0f / 128.0f) + NORM_EPS);
        v4u w; w.x = pk2(d[0] * rs * sw[0], d[1] * rs * sw[1]); w.y = pk2(d[2] * rs * sw[2], d[3] * rs * sw[3]); w.z = pk2(d[4] * rs * sw[4], d[5] * rs * sw[5]); w.w = pk2(d[6] * rs * sw[6], d[7] * rs * sw[7]);
        *(v4u*)(AO + (size_t)t * 1024 + hd * 128 + dv) = w;
        const size_t o = (size_t)t * RWW + c8;
        const v4u yp = *(const v4u*)(YB + o); const f32x4 y0 = {bflo(yp.x), bfhi(yp.x), bflo(yp.y), bfhi(yp.y)}, y1 = {bflo(yp.z), bfhi(yp.z), bflo(yp.w), bfhi(yp.w)};
        const bf16* pv = PB + (size_t)t * IN_COLS + RW_OFF + 1024 + c8; const bool hp = (t & (SEQ - 1)) > 0;
        const f32x4 v0 = shift4(pv, hp, A->shift_mu + 1024 + c8), v1 = shift4(pv + 4, hp, A->shift_mu + 1024 + c8 + 4);
        const v4u gp = *(const v4u*)(LG + o);
        const float g[8] = {bflo(gp.x), bfhi(gp.x), bflo(gp.y), bfhi(gp.y), bflo(gp.z), bfhi(gp.z), bflo(gp.w), bfhi(gp.w)};
        const float y[8] = {y0[0], y0[1], y0[2], y0[3], y1[0], y1[1], y1[2], y1[3]}, vv[8] = {v0[0], v0[1], v0[2], v0[3], v1[0], v1[1], v1[2], v1[3]};
        float sm = 0.f;
#pragma unroll
        for (int i = 0; i < 8; ++i) sm += y[i];
        sm += __shfl_xor(sm, 1); sm += __shfl_xor(sm, 2); sm += __shfl_xor(sm, 4);
        const float mean = sm * (1.0f / 64.0f); float sq = 0.f;
#pragma unroll
        for (int i = 0; i < 8; ++i) { const float dd = y[i] - mean; sq += dd * dd; }
        sq += __shfl_xor(sq, 1); sq += __shfl_xor(sq, 2); sq += __shfl_xor(sq, 4);
        const float rg = 1.0f / sqrtf(sq * (1.0f / 64.0f) + GN_EPS), bsc = BS[(size_t)t * 8 + hr];
        float r[8];
#pragma unroll
        for (int i = 0; i < 8; ++i) r[i] = ((y[i] - mean) * rg * lw[i] + lb[i] + bsc * vv[i]) * g[i];
        w.x = pk2(r[0], r[1]); w.y = pk2(r[2], r[3]); w.z = pk2(r[4], r[5]); w.w = pk2(r[6], r[7]);
        *(v4u*)(AO + (size_t)t * 1024 + 512 + c8) = w;
    }
}

__device__ __forceinline__ void p8_router(const Frame& F, KArgs A, gu32* ctl) {
    unsigned char* ws = A->ws;
    const float* X1 = (const float*)(ws + WS_X1); const float* RWS = (const float*)(ws + WS_RWS); unsigned char* H2 = ws + WS_H2;
    int* TOPI = (int*)(ws + WS_TOPI); int* POS = (int*)(ws + WS_POS); float* GATE = (float*)(ws + WS_GATE);
    LAS int* hist = (LAS int*)(F.lds + HIST_OFF); LAS int* hbase = (LAS int*)(F.lds + HBASE_OFF);
    const int lane = F.lane, tile = F.wave * F.G + F.vcu;
    const bool has = tile < T / 32;
    const int r0 = tile * 32, hi = lane >> 5, l31 = lane & 31;
    int sel[4] = {0, 0, 0, 0}, lr[4] = {0, 0, 0, 0}; float gate[4] = {0.f, 0.f, 0.f, 0.f}; float rstd = 0.f;
    if (has) {
        f32x16 acc;
#pragma unroll
        for (int r = 0; r < 16; ++r) acc[r] = 0.f;
        float ssq = 0.f;
        const float* xa = X1 + (size_t)(r0 + l31) * D + 4 * hi; const float* wb = RWS + hi * 128 + l31;
        f32x4 aA[8], aB[8]; float bA[8][4], bB[8][4];
#define P8_LOAD(AS, BS, grp) do { _Pragma("unroll") for (int mm = 0; mm < 8; ++mm) { const int m = (grp) * 8 + mm; AS[mm] = *(const f32x4*)(xa + 8 * m); \
            BS[mm][0] = wb[(8 * m) * 32]; BS[mm][1] = wb[(8 * m + 1) * 32]; BS[mm][2] = wb[(8 * m + 2) * 32]; BS[mm][3] = wb[(8 * m + 3) * 32]; } } while (0)
#define P8_COMP(AS, BS) do { _Pragma("unroll") for (int mm = 0; mm < 8; ++mm) { const f32x4 a = AS[mm]; ssq += (a[0] * a[0] + a[1] * a[1]) + (a[2] * a[2] + a[3] * a[3]); \
            acc = __builtin_amdgcn_mfma_f32_32x32x2f32(a[0], BS[mm][0], acc, 0, 0, 0); acc = __builtin_amdgcn_mfma_f32_32x32x2f32(a[1], BS[mm][1], acc, 0, 0, 0); \
            acc = __builtin_amdgcn_mfma_f32_32x32x2f32(a[2], BS[mm][2], acc, 0, 0, 0); acc = __builtin_amdgcn_mfma_f32_32x32x2f32(a[3], BS[mm][3], acc, 0, 0, 0); } } while (0)
        P8_LOAD(aA, bA, 0);
        for (int gp = 0; gp < 16; gp += 2) {
            P8_LOAD(aB, bB, gp + 1);
            P8_COMP(aA, bA);
            if (gp + 2 < 16) P8_LOAD(aA, bA, gp + 2);
            P8_COMP(aB, bB);
        }
#undef P8_LOAD
#undef P8_COMP
        ssq += __shfl_xor(ssq, 32);
        rstd = 1.0f / sqrtf(ssq * (1.0f / D) + NORM_EPS);
        LAS float* Lw = (LAS float*)(F.lds + RING_OFF + F.wave * 16384 + 8704);
#pragma unroll
        for (int r = 0; r < 16; ++r) Lw[((r & 3) + 8 * (r >> 2) + 4 * hi) * 36 + l31] = acc[r];
        LDS_WAIT(); asm volatile("" ::: "memory");
        if (lane < 32) {
            float val[32];
#pragma unroll
            for (int j = 0; j < 8; ++j) { const f32x4 q = *(const LAS f32x4*)(Lw + lane * 36 + 4 * j); const f32x4 bb = *(const f32x4*)(A->router_b + 4 * j);
                val[4 * j] = q[0] * rstd + bb[0]; val[4 * j + 1] = q[1] * rstd + bb[1]; val[4 * j + 2] = q[2] * rstd + bb[2]; val[4 * j + 3] = q[3] * rstd + bb[3]; }
            unsigned used = 0u; float sv[4];
#pragma unroll
            for (int s = 0; s < 4; ++s) { float best = -INFINITY; int bi = 0;
#pragma unroll
                for (int e = 0; e < 32; ++e) { const bool ok = (((used >> e) & 1u) == 0u) && (val[e] > best); best = ok ? val[e] : best; bi = ok ? e : bi; }
                used |= 1u << bi; sel[s] = bi; sv[s] = best; }
            float ex[4], se = 0.f;
#pragma unroll
            for (int s = 0; s < 4; ++s) { ex[s] = __expf(sv[s] - sv[0]); se += ex[s]; }
            const float inv = 1.0f / se;
#pragma unroll
            for (int s = 0; s < 4; ++s) { gate[s] = ex[s] * inv; lr[s] = __hip_atomic_fetch_add(hist + sel[s], 1, __ATOMIC_RELAXED, __HIP_MEMORY_SCOPE_WORKGROUP); }
        }
    }
    __syncthreads();
    if (F.tid < NEXP) hbase[F.tid] = (int)__hip_atomic_fetch_add(ctl + CW_CNT + F.tid, (unsigned)hist[F.tid], __ATOMIC_RELAXED, __HIP_MEMORY_SCOPE_AGENT);
    __syncthreads();
    if (has) {
        if (lane < 32) { const size_t t4 = (size_t)(r0 + lane) * 4;
#pragma unroll
            for (int s = 0; s < 4; ++s) { TOPI[t4 + s] = sel[s]; POS[t4 + s] = hbase[sel[s]] + lr[s]; GATE[t4 + s] = gate[s]; } }
        f32x4 nw[4];
#pragma unroll
        for (int j = 0; j < 4; ++j) nw[j] = *((const f32x4*)A->ffn_norm_w + lane + 64 * j);
        for (int r4 = 0; r4 < 32; r4 += 4) {
            f32x4 v[4][4];
#pragma unroll
            for (int q = 0; q < 4; ++q) { const f32x4* xr = (const f32x4*)(X1 + (size_t)(r0 + r4 + q) * D) + lane;
#pragma unroll
                for (int j = 0; j < 4; ++j) v[q][j] = xr[64 * j]; }
#pragma unroll
            for (int q = 0; q < 4; ++q) {
                const float rs = __builtin_bit_cast(float, __builtin_amdgcn_readlane(__builtin_bit_cast(int, rstd), r4 + q));
                unsigned* o4 = (unsigned*)(H2 + (size_t)(r0 + r4 + q) * D) + lane;
#pragma unroll
                for (int j = 0; j < 4; ++j) o4[64 * j] = pg8::pk_fp8x4(v[q][j][0] * rs * nw[j][0], v[q][j][1] * rs * nw[j][1], v[q][j][2] * rs * nw[j][2], v[q][j][3] * rs * nw[j][3]);
            }
        }
    }
}

__device__ __forceinline__ void moe_tables(const Frame& F, gu32* ctl) {
    LAS int* pst = (LAS int*)(F.lds + PST_OFF); LAS int* te = (LAS int*)(F.lds + TILE_OFF);
    __syncthreads();
    if (F.tid == 0) { int acc = 0;
        for (int e = 0; e < NEXP; ++e) { pst[e] = acc; const int c = (int)__hip_atomic_load(ctl + CW_CNT + e, __ATOMIC_RELAXED, __HIP_MEMORY_SCOPE_AGENT); acc += ((c + 255) >> 8) << 8; }
        pst[32] = acc; pst[33] = acc >> 8; }
    __syncthreads();
    if (F.tid < NEXP) { for (int tl = pst[F.tid] >> 8; tl < (pst[F.tid + 1] >> 8); ++tl) te[tl] = F.tid; }
    __syncthreads();
}

__device__ __forceinline__ void p9_gather(const Frame& F, KArgs A) {
    unsigned char* ws = A->ws;
    int* RSRC = (int*)(ws + WS_RSRC);
    const int* TOPI = (const int*)(ws + WS_TOPI); const int* POS = (const int*)(ws + WS_POS); const float* GATE = (const float*)(ws + WS_GATE);
    float* RGATE = (float*)(ws + WS_RGATE);
    const LAS int* pst = (const LAS int*)(F.lds + PST_OFF);
    const int gt = F.vcu * (NWAVES * 64) + F.tid, NGT = F.G * NWAVES * 64;
    for (int idx = gt; idx < T * TOPK; idx += NGT) { const int dest = pst[TOPI[idx]] + POS[idx]; RSRC[dest] = idx >> 2; RGATE[dest] = GATE[idx]; }
}

__device__ __forceinline__ void p12_final(const Frame& F, KArgs A) {
    unsigned char* ws = A->ws;
    const float* X1 = (const float*)(ws + WS_X1); const unsigned char* YS = ws + WS_YS;
    const int* TOPI = (const int*)(ws + WS_TOPI); const int* POS = (const int*)(ws + WS_POS); const LAS int* pst = (const LAS int*)(F.lds + PST_OFF);
    const int gw = F.vcu * NWAVES + F.wave, NGW = F.G * NWAVES, lane = F.lane;
    f32x4 nw[4];
#pragma unroll
    for (int j = 0; j < 4; ++j) nw[j] = *((const f32x4*)A->final_norm_w + lane + 64 * j);
    for (int t = gw; t < T; t += NGW) {
        f32x4 v[4]; float ss = 0.f;
#pragma unroll
        for (int j = 0; j < 4; ++j) v[j] = *((const f32x4*)(X1 + (size_t)t * D) + lane + 64 * j);
#pragma unroll
        for (int s = 0; s < 4; ++s) { const unsigned* yr = (const unsigned*)(YS + (size_t)(pst[TOPI[t * 4 + s]] + POS[t * 4 + s]) * D) + lane;
#pragma unroll
            for (int j = 0; j < 4; ++j) { const unsigned p = yr[64 * j]; const attn_body::f32x2_t lo = __builtin_amdgcn_cvt_pk_f32_fp8((int)p, false), hi = __builtin_amdgcn_cvt_pk_f32_fp8((int)p, true);
                v[j][0] += lo[0] * pg8::MOE_YSCALE_INV; v[j][1] += lo[1] * pg8::MOE_YSCALE_INV; v[j][2] += hi[0] * pg8::MOE_YSCALE_INV; v[j][3] += hi[1] * pg8::MOE_YSCALE_INV; } }
#pragma unroll
        for (int j = 0; j < 4; ++j) ss += (v[j][0] * v[j][0] + v[j][1] * v[j][1]) + (v[j][2] * v[j][2] + v[j][3] * v[j][3]);
        const float rs = 1.0f / sqrtf(wave_sum(ss) * (1.0f / D) + NORM_EPS);
#pragma unroll
        for (int j = 0; j < 4; ++j) *((f32x4*)(A->out + (size_t)t * D) + lane + 64 * j) = v[j] * rs * nw[j];
    }
}
#ifndef MK_N_LAUNCHES
#define MK_N_LAUNCHES 1
#endif
constexpr int N_PHASES = 13;
__global__ void __launch_bounds__(NWAVES * 64, 2) mk_fwd(Args A_by_value_unused) {
    extern __shared__ __attribute__((aligned(16))) unsigned char lds[];
    Frame F;
    F.lds = (LAS unsigned char*)lds;
    volatile LAS unsigned* MISC = (volatile LAS unsigned*)(F.lds + MISC_OFF);
    F.tid = threadIdx.x; F.lane = F.tid & 63; F.wave = __builtin_amdgcn_readfirstlane(F.tid >> 6);
    F.G = gridDim.x; { const int bx = blockIdx.x; F.vcu = (F.G % 8 == 0) ? (bx % 8) * (F.G / 8) + bx / 8 : bx; }
    unsigned char* ws = get_args()->ws;
    gu32* ctl = (gu32*)(ws + WS_CTL);
    for (int u = F.tid; u < (LDS_BYTES - LDSCTL_OFF) / 4; u += NWAVES * 64) ((LAS unsigned*)(F.lds + LDSCTL_OFF))[u] = 0u;
    __syncthreads();
    XcdBarrier bar = xcd_barrier_post((unsigned*)(ctl + CW_BAR), MISC + 8);
    const int lo = get_args()->ph_lo, hi = get_args()->ph_hi;
#if defined(PROBE_A)
#ifndef PROBE_SCALE
#define PROBE_SCALE 0.25f
#endif
    unsigned long long* tsw = (unsigned long long*)(ws + WS_CTL + 65536);
    int n_stamp = 0;
#define STAMP() do { if (blockIdx.x == 0 && F.tid == 0) tsw[n_stamp] = rt(); ++n_stamp; } while (0)
#else
#define STAMP() do { } while (0)
#endif
    STAMP();
#define IN(k) (lo <= (k) && (k) < hi)
#define SEAM(k) do { if (IN(k) && IN((k) + 1)) xcd_barrier(bar); STAMP(); } while (0)
    bf16* XN = (bf16*)(ws + WS_XN); bf16* PB = (bf16*)(ws + WS_PB);

    if (IN(0)) { p0_prologue(fresh(F), get_args()); SEAM(0); }
    if (IN(1)) {
        pg8::Gemm g{XN, (const bf16*)(ws + WS_WIN), T, IN_COLS, D}; pg8::StaticOrder S; S.init(T, IN_COLS, F.G, (int)blockIdx.x);
        pg8::EpiBf16<0> E{PB, IN_COLS, nullptr, 0, 0, 1.f};
        pg8::gemm_phase<pg8::EpiBf16<0>, pg8::StaticOrder, PG8_ALIGN, PG8_SP2>(F.lds + RING_OFF, g, S, E);
        { constexpr int NU = (T / 256) * (IN_COLS / 256), FULL = NU / 256, REM = NU % 256;
          if (REM != 0 && F.G == 256) { if ((int)blockIdx.x < REM) { if (F.tid == 0) __hip_atomic_fetch_add(ctl + CW_DONE5, 1u, __ATOMIC_RELAXED, __HIP_MEMORY_SCOPE_AGENT); }
                                        else { __syncthreads(); moe_weight_queue_scan(fresh(F), get_args(), ctl, CW_DONE5, (unsigned)(REM - 8)); } } (void)FULL; }
        SEAM(1);
    }
    if (IN(2)) { p2_prep(fresh(F), get_args()); SEAM(2); }
    if (IN(4)) { p4_chunk_prep(fresh(F), get_args()); SEAM(4); }
    if (IN(5)) {
        constexpr int NS = BATCH * 8;
        if ((F.vcu & 7) == 0 && (F.vcu >> 3) < NS) { scan_phase3(fresh(F), get_args(), F.vcu >> 3); moe_weight_queue_scan(fresh(F), get_args(), ctl, CW_AQ + 64 * (int)(blockIdx.x & 7), 128u); }
        attn_queue(fresh(F), get_args(), ctl);
        moe_weight_queue<false>(fresh(F), get_args(), ctl, 0u);
        SEAM(5);
    }
    if (IN(6)) { p6_combine(fresh(F), get_args()); SEAM(6); }
    if (IN(7)) {
        pg8::Gemm g{(const bf16*)(ws + WS_AO), (const bf16*)(ws + WS_WO), T, D, D}; pg8::StaticOrder S; S.init(T, D, F.G, (int)blockIdx.x);
        pg8::EpiResF32 E{get_args()->x, (float*)(ws + WS_X1), D};
        pg8::gemm_phase<pg8::EpiResF32, pg8::StaticOrder, PG8_ALIGN, PG8_SP2>(F.lds + RING_OFF, g, S, E);
        SEAM(7);
    }
    if (IN(8)) { p8_router(fresh(F), get_args(), ctl); moe_weight_queue<false>(fresh(F), get_args(), ctl, 0u); SEAM(8); }
    if (IN(9)) { moe_tables(fresh(F), ctl); p9_gather(fresh(F), get_args()); SEAM(9); }
    if (IN(10)) {
        moe_tables(fresh(F), ctl);
        const LAS int* pst = (const LAS int*)(F.lds + PST_OFF);
        pg8::Gemm g{(const bf16*)(ws + WS_H2), (const bf16*)(ws + WS_W1), P_MAX, NEXP * 2048, D, (const int*)(ws + WS_RSRC)};
        pg8::MoeOrder<8> S{pst[33], (int)blockIdx.x, F.G, (const LAS int*)(F.lds + TILE_OFF)};
        pg8::EpiSwiglu E{ws + WS_ACT, get_args()->mlp1_b};
        pg8::gemm_phase<pg8::EpiSwiglu, pg8::MoeOrder<8>, PG8_ALIGN, PG8_SP2, true, true>(F.lds + RING_OFF, g, S, E);
        SEAM(10);
    }
    if (IN(11)) {
        moe_tables(fresh(F), ctl);
        const LAS int* pst = (const LAS int*)(F.lds + PST_OFF);
        pg8::Gemm g{(const bf16*)(ws + WS_ACT), (const bf16*)(ws + WS_W2), P_MAX, NEXP * D, D};
        pg8::MoeOrder<4> S{pst[33], (int)blockIdx.x, F.G, (const LAS int*)(F.lds + TILE_OFF)};
        pg8::EpiMoeOut E{ws + WS_YS, get_args()->mlp2_b, (const float*)(ws + WS_RGATE)};
        pg8::gemm_phase<pg8::EpiMoeOut, pg8::MoeOrder<4>, PG8_ALIGN, PG8_SP2, false, true>(F.lds + RING_OFF, g, S, E);
        SEAM(11);
    }
    if (IN(12)) { moe_tables(fresh(F), ctl); p12_final(fresh(F), get_args()); }
#if defined(PROBE_A)
    xcd_barrier(bar); STAMP();
    if (blockIdx.x == 0 && F.tid == 0) { asm volatile("s_waitcnt vmcnt(0)" ::: "memory"); const float us = (float)(tsw[PROBE_B] - tsw[PROBE_A]) * 0.01f; get_args()->out[12345] = us * PROBE_SCALE; }
#endif
#undef IN
#undef SEAM
}

extern "C" void kernel_launch(void* const* d_in, const int* in_sizes, int n_in, void* d_out, int out_size, void* d_ws, size_t ws_size, hipStream_t stream) {
    static int grid = 0;
    if (grid == 0) {
        if (n_in != 29 || in_sizes[0] != T * D || out_size != T * D || ws_size < WS_END) { fprintf(stderr, "kernel_launch: built for 29 inputs, x/out of %d floats, >= %zu bytes of workspace; got n_in %d, in0 %d, out %d, ws %zu; nothing launched\n", T * D, (size_t)WS_END, n_in, n_in > 0 ? in_sizes[0] : -1, out_size, ws_size); grid = -1; return; }
        int dev = 0, cus = 0, per_cu = 0;
        if (hipGetDevice(&dev) != hipSuccess || hipDeviceGetAttribute(&cus, hipDeviceAttributeMultiprocessorCount, dev) != hipSuccess) { fprintf(stderr, "kernel_launch: device query failed\n"); grid = -1; return; }
        if (hipFuncSetAttribute((const void*)mk_fwd, hipFuncAttributeMaxDynamicSharedMemorySize, LDS_BYTES) != hipSuccess) { fprintf(stderr, "kernel_launch: hipFuncSetAttribute failed\n"); grid = -1; return; }
        if (hipOccupancyMaxActiveBlocksPerMultiprocessor(&per_cu, (const void*)mk_fwd, NWAVES * 64, LDS_BYTES) != hipSuccess || per_cu < 1)
            fprintf(stderr, "kernel_launch: note: occupancy query reports %d workgroups per CU\n", per_cu);
        (void)hipGetLastError();
        grid = cus;
        if (grid != 256) { fprintf(stderr, "kernel_launch: %d CUs; this kernel is built for 256; nothing launched\n", grid); grid = -1; return; }
    }
    if (grid < 0) return;
    if (hipMemsetAsync((char*)d_ws + WS_CTL, 0, CTL_ZERO_BYTES, stream) != hipSuccess) { fprintf(stderr, "kernel_launch: hipMemsetAsync failed\n"); return; }
    Args a{};
    a.x = (const float*)d_in[0]; a.positions = (const int*)d_in[1]; a.attn_norm_w = (const float*)d_in[2]; a.w_in = (const float*)d_in[3]; a.shift_mu = (const float*)d_in[4];
    a.lq1 = (const float*)d_in[5]; a.lk1 = (const float*)d_in[6]; a.lq2 = (const float*)d_in[7]; a.lk2 = (const float*)d_in[8]; a.subln_w = (const float*)d_in[9];
    a.rw_w0 = (const float*)d_in[10]; a.rw_w2 = (const float*)d_in[11]; a.rw_a0 = (const float*)d_in[12]; a.rw_a2 = (const float*)d_in[13]; a.rw_g2 = (const float*)d_in[14];
    a.rw_k_k = (const float*)d_in[15]; a.rw_k_a = (const float*)d_in[16]; a.rw_r_k = (const float*)d_in[17]; a.rw_lnx_w = (const float*)d_in[18]; a.rw_lnx_b = (const float*)d_in[19];
    a.w_out = (const float*)d_in[20]; a.ffn_norm_w = (const float*)d_in[21]; a.router_w = (const float*)d_in[22]; a.router_b = (const float*)d_in[23];
    a.mlp1_w = (const float*)d_in[24]; a.mlp1_b = (const float*)d_in[25]; a.mlp2_w = (const float*)d_in[26]; a.mlp2_b = (const float*)d_in[27]; a.final_norm_w = (const float*)d_in[28];
    a.out = (float*)d_out; a.ws = (unsigned char*)d_ws;
    if (MK_N_LAUNCHES == 1) { a.ph_lo = 0; a.ph_hi = N_PHASES; hipLaunchKernelGGL(mk_fwd, dim3(grid), dim3(NWAVES * 64), LDS_BYTES, stream, a); }
    else for (int p = 0; p < N_PHASES; ++p) { a.ph_lo = p; a.ph_hi = p + 1; hipLaunchKernelGGL(mk_fwd, dim3(grid), dim3(NWAVES * 64), LDS_BYTES, stream, a); }
    const hipError_t le = hipPeekAtLastError();
    if (le != hipSuccess) fprintf(stderr, "kernel_launch: launch failed: %s\n", hipGetErrorName(le));
}
```

```cpp
#include <hip/hip_runtime.h>
#include <cstdio>
#include <cstdint>
namespace pg8 {
#define PG8_LAS __attribute__((address_space(3)))
typedef unsigned short bf16_t;
typedef short bf16x8 __attribute__((ext_vector_type(8)));
typedef float f32x4 __attribute__((ext_vector_type(4)));
typedef unsigned u32x4 __attribute__((ext_vector_type(4)));
typedef int i32x4 __attribute__((ext_vector_type(4)));
typedef int i32x8 __attribute__((ext_vector_type(8)));
constexpr int BM = 256, BK = 64, HALF = 128, HTB = HALF * BK * 2  , STAGE_BYTES = 8 * HTB, NXCD = 8, WGM = 8;

__host__ __device__ __forceinline__ int lds_byte(int r, int c) { const int st = (r >> 4) * 2 + (c >> 5), rr = r & 15, cc = c & 31, ob = rr * 64 + cc * 2; return st * 1024 + (ob ^ (((ob >> 9) & 1) << 5)); }
__host__ __device__ __forceinline__ void stage_rc(int b, int& R, int& C) { const int st = b / 1024, sb = b % 1024, swz = sb ^ (((sb >> 9) & 1) << 5); R = (st >> 1) * 16 + swz / 64; C = (st & 1) * 32 + (swz % 64) / 2; }
__host__ __device__ __forceinline__ int perm32(int rho) { const int n = rho >> 4, i = rho & 15; return 8 * (i >> 2) + 4 * n + (i & 3); }

struct Unit { int pm, pn; };
struct Gemm { const bf16_t* A; const bf16_t* Bt; int M, N, K; const int* rows; };

struct StaticOrder {
    int nM, nN, nwg, G, c;
    __host__ __device__ void init(int M, int N, int G_, int c_) { nM = M / BM; nN = N / BM; nwg = nM * nN; G = G_; c = c_; }
    __host__ __device__ bool next(int i, Unit& u) const {
        const long L = (long)i * G + c; if (L >= nwg) return false;
        int wgid = (int)L; { const int q = nwg / NXCD, r = nwg % NXCD, xcd = wgid % NXCD, off = wgid / NXCD; wgid = (xcd < r ? xcd * (q + 1) : r * (q + 1) + (xcd - r) * q) + off; }
        const int nig = WGM * nN, gid = wgid / nig, fm = gid * WGM, gsz = (nM - fm) < WGM ? (nM - fm) : WGM;
        u.pm = fm + ((wgid % nig) % gsz); u.pn = (wgid % nig) / gsz; return true;
    }
    __device__ __forceinline__ void a_ready(const Unit&) const {}
    __device__ __forceinline__ void done(const Unit&) const {}
};

__device__ __forceinline__ unsigned pk_fp8x4(float a, float b, float c, float d) { int w = __builtin_amdgcn_cvt_pk_fp8_f32(a, b, 0, false); w = __builtin_amdgcn_cvt_pk_fp8_f32(c, d, w, true); return (unsigned)w; }
constexpr float MOE_WSCALE = 32.0f, MOE_WSCALE_INV = 1.0f / 32.0f;
constexpr float MOE_YSCALE = 16.0f, MOE_YSCALE_INV = 1.0f / 16.0f;
__device__ __forceinline__ unsigned cvt_pk_bf16(float lo, float hi) { unsigned r; asm volatile("v_cvt_pk_bf16_f32 %0, %1, %2" : "=v"(r) : "v"(lo), "v"(hi)); return r; }
typedef float f32x2 __attribute__((ext_vector_type(2)));
__device__ __forceinline__ f32x2 gelu_pk(f32x2 v) {
    const f32x2 av = __builtin_elementwise_abs(v), d = av * 0.2316418882f + 1.0f;
    f32x2 t; t.x = __builtin_amdgcn_rcpf(d.x); t.y = __builtin_amdgcn_rcpf(d.y);
    f32x2 q = t * 0.5307027145f + (-0.7265760135f); q = q * t + 0.7107068705f; q = q * t + (-0.142248368f); q = q * t + 0.127414796f; q = q * t;
    const f32x2 s = (v * v) * (-0.72134752044f);
    f32x2 e; e.x = __builtin_amdgcn_exp2f(s.x); e.y = __builtin_amdgcn_exp2f(s.y);
    const f32x2 m = v * (q * e), r = v - m;
    f32x2 o; o.x = v.x < 0.f ? m.x : r.x; o.y = v.y < 0.f ? m.y : r.y; return o;
}

template <int ACT  > struct EpiBf16 {
    static constexpr bool PERM = true, AFTER_DRAIN = false, PERM16 = false, HAS_PRE = false, GUSPLIT = false, ROPE16 = false; static_assert(ACT == 0 || ACT == 1, "EpiBf16: ACT is 0 (none) or 1 (gelu_pk)");
    bf16_t* O; int ldc; const float* bias; int split_cols; size_t split_stride; float scale0;
    __device__ __forceinline__ void operator()(const f32x4 (&acc)[2][2][4][2], const Unit& u, int wr, int wc, int fr, int fq) const {
        const int row0 = u.pm * BM + wr * 64 + fr; int colt = u.pn * BM; bf16_t* base = O;
        float sc = 1.f; if (split_cols) { const int t = colt / split_cols; base += (size_t)t * split_stride; colt -= t * split_cols; if (t == 0) sc = scale0; }
        const int col0 = colt + wc * 32 + 8 * fq, bcol0 = u.pn * BM + wc * 32 + 8 * fq;
        f32x4 bv[2][2];
#pragma unroll
        for (int bj = 0; bj < 2; ++bj)
#pragma unroll
            for (int n = 0; n < 2; ++n) bv[bj][n] = bias ? *(const f32x4*)(bias + bcol0 + bj * HALF + 4 * n) : (f32x4){0.f, 0.f, 0.f, 0.f};
#pragma unroll
        for (int ai = 0; ai < 2; ++ai)
#pragma unroll
            for (int m = 0; m < 4; ++m) { bf16_t* rowp = base + (size_t)(row0 + ai * HALF + m * 16) * ldc + col0;
#pragma unroll
                for (int bj = 0; bj < 2; ++bj) { f32x4 v0 = acc[ai][bj][m][0] + bv[bj][0], v1 = acc[ai][bj][m][1] + bv[bj][1];
                    if (ACT == 1) { f32x2 a = gelu_pk((f32x2){v0[0], v0[1]}), b = gelu_pk((f32x2){v0[2], v0[3]}), c = gelu_pk((f32x2){v1[0], v1[1]}), d = gelu_pk((f32x2){v1[2], v1[3]});
                        v0 = (f32x4){a.x, a.y, b.x, b.y}; v1 = (f32x4){c.x, c.y, d.x, d.y}; }
                    v0 = v0 * sc; v1 = v1 * sc; u32x4 w; w.x = cvt_pk_bf16(v0[0], v0[1]); w.y = cvt_pk_bf16(v0[2], v0[3]); w.z = cvt_pk_bf16(v1[0], v1[1]); w.w = cvt_pk_bf16(v1[2], v1[3]);
                    *(u32x4*)(rowp + bj * HALF) = w; } }
    }
};
__device__ __forceinline__ void pg8_glds16s(const void* gbase, unsigned voff, unsigned lds_dst) { unsigned keep;
    asm volatile("s_mov_b32 %0, m0\n\ts_mov_b32 m0, %2\n\ts_nop 0\n\tglobal_load_lds_dwordx4 %1, %3\n\ts_mov_b32 m0, %0" : "=&s"(keep) : "v"(voff), "s"(lds_dst), "s"(gbase) : "memory"); }
template <class E, bool H> struct PreOf { struct type {}; };
template <class E> struct PreOf<E, true> { using type = typename E::Pre; };
template <class Epi, class Sched, bool ALIGN_EPI = false, bool SP2 = false, bool GATHER = false, bool FP8 = false>
__device__ __forceinline__ void gemm_phase(PG8_LAS unsigned char* lds, const Gemm g, const Sched& S, const Epi& E) {
    const int tid = threadIdx.x, wid = __builtin_amdgcn_readfirstlane(tid >> 6), lane = tid & 63, wr = wid >> 2, wc = wid & 3, fr = lane & 15, fq = lane >> 4;
    constexpr int EB = FP8 ? 1 : 2;
    int K = g.K; asm volatile("" : "+s"(K));
    const int nt = (K * EB) / (BK * 2);
    unsigned voffA[2], voffB[2]; int Rl[2]; unsigned Cb[2];
#pragma unroll
    for (int i = 0; i < 2; ++i) { int R, C; stage_rc(tid * 16 + i * 8192, R, C); const int Rb = Epi::PERM ? ((R & ~31) + perm32(R & 31)) : R;
        voffA[i] = (unsigned)(R * K) * EB + (unsigned)C * 2u; voffB[i] = (unsigned)(Rb * K) * EB + (unsigned)C * 2u; Rl[i] = R; Cb[i] = (unsigned)C * 2u; }
    unsigned voffB16[2][2];
#pragma unroll
    for (int h_ = 0; h_ < 2; ++h_)
#pragma unroll
        for (int i_ = 0; i_ < 2; ++i_) { const int R = Rl[i_]; voffB16[h_][i_] = (unsigned)((64 * (R >> 5) + 16 * ((R >> 2) & 3) + 8 * h_ + (Epi::GUSPLIT ? 2 * (R & 3) + ((R >> 4) & 1) : 4 * ((R >> 4) & 1) + (R & 3))) * K) * EB + Cb[i_];
            if constexpr (Epi::ROPE16) voffB16[h_][i_] = (unsigned)((64 * (R >> 5) + 32 * ((R >> 4) & 1) + 8 * ((R >> 2) & 3) + 4 * h_ + (R & 3)) * K) * EB + Cb[i_]; }
#define PG8_STAGE_B(bufoff, kptr, h) do { if constexpr (Epi::PERM16) { PG8_STAGE(bufoff, kptr, voffB16[h]); } else { PG8_STAGE(bufoff, (kptr) + (h) * hstep, voffB); } } while (0)
    unsigned gcur[2][2], gnxt[2][2];
#define PG8_GATH(dst, u) do { _Pragma("unroll") for (int h_ = 0; h_ < 2; ++h_) _Pragma("unroll") for (int i_ = 0; i_ < 2; ++i_) \
        dst[h_][i_] = (unsigned)g.rows[(u).pm * BM + h_ * HALF + Rl[i_]] * (unsigned)(K * EB) + Cb[i_]; } while (0)
#define PG8_STAGE_A(bufoff, kptr, h, GA) do { if constexpr (GATHER) { PG8_STAGE(bufoff, kptr, GA[h]); } else { PG8_STAGE(bufoff, (kptr) + (h) * hstep, voffA); } } while (0)
#define PG8_STAGE_A2(bufoff, kptr, h) do { if constexpr (GATHER) { const unsigned gs_[2] = {lastsel ? gnxt[h][0] : gcur[h][0], lastsel ? gnxt[h][1] : gcur[h][1]}; PG8_STAGE(bufoff, kptr, gs_); } else { PG8_STAGE(bufoff, (kptr) + (h) * hstep, voffA); } } while (0)
    const size_t kstep = (size_t)(BK * 2);
    const size_t hstep = (size_t)HALF * K * EB;
    const size_t tstep = 2 * hstep;
    const unsigned lds0 = (unsigned)(uintptr_t)lds;
    const unsigned ldsw = (unsigned)wid * 1024u;
    const int aoff = lds_byte(wr * 64 + fr, fq * 8), boff = lds_byte(wc * 32 + fr, fq * 8);
#define PG8_SA(b, h) (((b) * 2 + (h)) * HTB)
#define PG8_SB(b, h) ((4 + (b) * 2 + (h)) * HTB)
#define PG8_STAGE(bufoff, gbase, voff) do { _Pragma("unroll") for (int _i = 0; _i < 2; ++_i) { \
        if constexpr (FP8) pg8_glds16s((const char*)(gbase), (voff)[_i], (unsigned)__builtin_amdgcn_readfirstlane((int)(lds0 + (unsigned)(bufoff) + ldsw + _i * 8192))); \
        else __builtin_amdgcn_global_load_lds((const unsigned*)((const char*)(gbase) + (voff)[_i]), (PG8_LAS unsigned*)(lds + (bufoff) + ldsw + _i * 8192), 16, 0, 0); } } while (0)
#define PG8_CAT(x, y) __builtin_shufflevector(__builtin_bit_cast(i32x4, x), __builtin_bit_cast(i32x4, y), 0, 1, 2, 3, 4, 5, 6, 7)
#define PG8_LDA(dst, b, h) do { if constexpr (FP8) { _Pragma("unroll") for (int m = 0; m < 4; ++m) dst##8[m] = PG8_CAT(*(const PG8_LAS bf16x8*)(lds + PG8_SA(b, h) + aoff + m * 2048), *(const PG8_LAS bf16x8*)(lds + PG8_SA(b, h) + aoff + m * 2048 + 1024)); } \
        else { _Pragma("unroll") for (int m = 0; m < 4; ++m) _Pragma("unroll") for (int k = 0; k < 2; ++k) dst[m][k] = *(const PG8_LAS bf16x8*)(lds + PG8_SA(b, h) + aoff + m * 2048 + k * 1024); } } while (0)
#define PG8_LDB(dst, b, h) do { if constexpr (FP8) { _Pragma("unroll") for (int n = 0; n < 2; ++n) dst##8[n] = PG8_CAT(*(const PG8_LAS bf16x8*)(lds + PG8_SB(b, h) + boff + n * 2048), *(const PG8_LAS bf16x8*)(lds + PG8_SB(b, h) + boff + n * 2048 + 1024)); } \
        else { _Pragma("unroll") for (int n = 0; n < 2; ++n) _Pragma("unroll") for (int k = 0; k < 2; ++k) dst[n][k] = *(const PG8_LAS bf16x8*)(lds + PG8_SB(b, h) + boff + n * 2048 + k * 1024); } } while (0)
#define PG8_MMA(ai, bj, At, Bt) do { __builtin_amdgcn_s_setprio(1); _Pragma("unroll") for (int m = 0; m < 4; ++m) _Pragma("unroll") for (int n = 0; n < 2; ++n) { \
        if constexpr (FP8) asm volatile("v_mfma_f32_16x16x128_f8f6f4 %0, %1, %2, %0" : "+v"(acc[ai][bj][m][n]) : "v"(Bt##8[n]), "v"(At##8[m])); \
        else { _Pragma("unroll") for (int k = 0; k < 2; ++k) acc[ai][bj][m][n] = __builtin_amdgcn_mfma_f32_16x16x32_bf16(Bt[n][k], At[m][k], acc[ai][bj][m][n], 0, 0, 0); } } \
        __builtin_amdgcn_s_setprio(0); } while (0)
#define PG8_WAIT_V(n) asm volatile("s_waitcnt vmcnt(" #n ")" ::: "memory")
#define PG8_WAIT_L(n) asm volatile("s_waitcnt lgkmcnt(" #n ")" ::: "memory")
#define PG8_BAR __builtin_amdgcn_s_barrier()
#define PG8_SCHED __builtin_amdgcn_sched_barrier(0)
    Unit cur, nxt; int ui = 0;
    if (!S.next(0, cur)) return;
    typename PreOf<Epi, Epi::HAS_PRE>::type pre;
    f32x4 acc[2][2][4][2];
#pragma unroll
    for (int a = 0; a < 2; ++a)
#pragma unroll
        for (int b = 0; b < 2; ++b)
#pragma unroll
            for (int m = 0; m < 4; ++m)
#pragma unroll
                for (int n = 0; n < 2; ++n) acc[a][b][m][n] = (f32x4){0.f, 0.f, 0.f, 0.f};
    bf16x8 At[4][2], B0[2][2], B1[2][2];
    i32x8 At8[4], B08[2], B18[2];
    const char* cA = (const char*)g.A + (GATHER ? (size_t)0 : (size_t)cur.pm * tstep); const char* cB = (const char*)g.Bt + (size_t)cur.pn * tstep;
    if constexpr (GATHER) PG8_GATH(gcur, cur);
    S.a_ready(cur);
    if constexpr (SP2) {
        PG8_STAGE_B(PG8_SB(0, 0), cB, 0); PG8_STAGE_B(PG8_SB(0, 1), cB, 1); PG8_STAGE_A(PG8_SA(0, 0), cA, 0, gcur); PG8_STAGE_A(PG8_SA(0, 1), cA, 1, gcur);
        if (wr == 1) PG8_BAR;
        PG8_WAIT_V(2); PG8_BAR;
        PG8_STAGE_B(PG8_SB(1, 0), cB + kstep, 0); PG8_STAGE_A(PG8_SA(1, 0), cA + kstep, 0, gcur); PG8_STAGE_B(PG8_SB(1, 1), cB + kstep, 1);
        PG8_WAIT_V(6); PG8_BAR;
    } else {
        PG8_STAGE_B(PG8_SB(0, 0), cB, 0); PG8_STAGE_A(PG8_SA(0, 0), cA, 0, gcur); PG8_STAGE_B(PG8_SB(0, 1), cB, 1); PG8_STAGE_A(PG8_SA(0, 1), cA, 1, gcur);
        if (wr == 1) PG8_BAR;
        PG8_WAIT_V(4); PG8_BAR;
        PG8_STAGE_B(PG8_SB(1, 0), cB + kstep, 0); PG8_STAGE_A(PG8_SA(1, 0), cA + kstep, 0, gcur); PG8_STAGE_B(PG8_SB(1, 1), cB + kstep, 1);
        PG8_WAIT_V(6); PG8_BAR;
    }
    for (;;) {
        const bool has_next = S.next(ui + 1, nxt);
        if constexpr (Epi::HAS_PRE) E.prefetch(pre, cur, wr, fr);
        if constexpr (GATHER) { if (has_next) { PG8_GATH(gnxt, nxt); } else { _Pragma("unroll") for (int h_ = 0; h_ < 2; ++h_) _Pragma("unroll") for (int i_ = 0; i_ < 2; ++i_) gnxt[h_][i_] = gcur[h_][i_]; } }
        const char* nA = (has_next && !GATHER) ? (const char*)g.A + (size_t)nxt.pm * tstep : cA; const char* nB = has_next ? (const char*)g.Bt + (size_t)nxt.pn * tstep : cB;
        for (int t = 0; t < nt; t += 2) {
            const bool last = (t == nt - 2);
            const bool lastsel = last;
            const char* a1 = cA + (size_t)(t + 1) * kstep;
            const char* a2 = last ? nA : cA + (size_t)(t + 2) * kstep; const char* b2 = last ? nB : cB + (size_t)(t + 2) * kstep;
            const char* a3 = a2 + kstep; const char* b3 = b2 + kstep;
            if (last && has_next) S.a_ready(nxt);
            if constexpr (SP2) {
            PG8_LDB(B0, 0, 0); PG8_LDB(B1, 0, 1); PG8_SCHED; PG8_LDA(At, 0, 0); PG8_STAGE_A(PG8_SA(1, 1), a1, 1, gcur);
            PG8_WAIT_V(8); PG8_WAIT_L(0); PG8_BAR; PG8_MMA(0, 0, At, B0); PG8_MMA(0, 1, At, B1); PG8_BAR; PG8_SCHED;
            PG8_LDA(At, 0, 1); PG8_STAGE_B(PG8_SB(0, 0), b2, 0); PG8_STAGE_B(PG8_SB(0, 1), b2, 1); PG8_STAGE_A2(PG8_SA(0, 0), a2, 0);
            PG8_WAIT_V(8); PG8_WAIT_L(0); PG8_BAR; PG8_MMA(1, 0, At, B0); PG8_MMA(1, 1, At, B1); PG8_BAR; PG8_SCHED;
            PG8_LDB(B0, 1, 0); PG8_LDB(B1, 1, 1); PG8_SCHED; PG8_LDA(At, 1, 0); PG8_STAGE_A2(PG8_SA(0, 1), a2, 1);
            PG8_WAIT_V(8); PG8_WAIT_L(0); PG8_BAR; PG8_MMA(0, 0, At, B0); PG8_MMA(0, 1, At, B1); PG8_BAR; PG8_SCHED;
            PG8_LDA(At, 1, 1); PG8_STAGE_B(PG8_SB(1, 0), b3, 0); PG8_STAGE_B(PG8_SB(1, 1), b3, 1); PG8_STAGE_A2(PG8_SA(1, 0), a3, 0);
            PG8_WAIT_V(8); PG8_WAIT_L(0); PG8_BAR; PG8_MMA(1, 0, At, B0); PG8_MMA(1, 1, At, B1); PG8_BAR; PG8_SCHED;
            } else {
            PG8_LDB(B0, 0, 0); PG8_SCHED; PG8_LDA(At, 0, 0); PG8_STAGE_A(PG8_SA(1, 1), a1, 1, gcur);
            PG8_WAIT_L(8); PG8_BAR; PG8_WAIT_L(0); PG8_MMA(0, 0, At, B0); PG8_BAR; PG8_SCHED;
            PG8_LDB(B1, 0, 1); PG8_STAGE_B(PG8_SB(0, 0), b2, 0);
            PG8_BAR; PG8_WAIT_L(0); PG8_MMA(0, 1, At, B1); PG8_BAR;
            PG8_LDA(At, 0, 1); PG8_STAGE_A2(PG8_SA(0, 0), a2, 0);
            PG8_BAR; PG8_WAIT_L(0); PG8_MMA(1, 0, At, B0); PG8_BAR; PG8_SCHED;
            PG8_STAGE_B(PG8_SB(0, 1), b2, 1);
            PG8_WAIT_V(6); PG8_BAR; PG8_MMA(1, 1, At, B1); PG8_BAR;
            PG8_LDB(B0, 1, 0); PG8_SCHED; PG8_LDA(At, 1, 0); PG8_STAGE_A2(PG8_SA(0, 1), a2, 1);
            PG8_WAIT_L(8); PG8_BAR; PG8_WAIT_L(0); PG8_MMA(0, 0, At, B0); PG8_BAR; PG8_SCHED;
            PG8_LDB(B1, 1, 1); PG8_STAGE_B(PG8_SB(1, 0), b3, 0);
            PG8_BAR; PG8_WAIT_L(0); PG8_MMA(0, 1, At, B1); PG8_BAR;
            PG8_LDA(At, 1, 1); PG8_STAGE_A2(PG8_SA(1, 0), a3, 0);
            PG8_BAR; PG8_WAIT_L(0); PG8_MMA(1, 0, At, B0); PG8_BAR; PG8_SCHED;
            PG8_STAGE_B(PG8_SB(1, 1), b3, 1);
            PG8_WAIT_V(6); PG8_BAR; PG8_MMA(1, 1, At, B1); PG8_BAR;
            }
        }
        if constexpr (FP8) {
            _Pragma("unroll") for (int a = 0; a < 2; ++a) _Pragma("unroll") for (int b = 0; b < 2; ++b) _Pragma("unroll") for (int m = 0; m < 4; ++m)
                { if (a == 0 && b == 0 && m == 0) asm volatile("s_nop 15\n\ts_nop 7" : "+v"(acc[a][b][m][0]), "+v"(acc[a][b][m][1])); else asm volatile("" : "+v"(acc[a][b][m][0]), "+v"(acc[a][b][m][1])); }
        }
        if constexpr (ALIGN_EPI) { if (wr == 0) PG8_BAR; }
        if constexpr (!Epi::AFTER_DRAIN) { if constexpr (Epi::HAS_PRE) E(acc, cur, wr, wc, fr, fq, pre); else E(acc, cur, wr, wc, fr, fq); S.done(cur); }
        if (!has_next) break;
#pragma unroll
        for (int a = 0; a < 2; ++a)
#pragma unroll
            for (int b = 0; b < 2; ++b)
#pragma unroll
                for (int m = 0; m < 4; ++m)
#pragma unroll
                    for (int n = 0; n < 2; ++n) acc[a][b][m][n] = (f32x4){0.f, 0.f, 0.f, 0.f};
        cur = nxt; cA = nA; cB = nB; ++ui;
        if constexpr (GATHER) { _Pragma("unroll") for (int h_ = 0; h_ < 2; ++h_) _Pragma("unroll") for (int i_ = 0; i_ < 2; ++i_) gcur[h_][i_] = gnxt[h_][i_]; }
        if constexpr (ALIGN_EPI) { if (wr == 1) PG8_BAR; }
    }
    PG8_WAIT_V(0);
    if constexpr (!ALIGN_EPI) { if (wr == 0) PG8_BAR; }
    PG8_BAR;
    if constexpr (Epi::AFTER_DRAIN) { E.fused(acc, cur, wr, wc, fr, fq, lds, wid, lane); S.done(cur); }
#undef PG8_SA
#undef PG8_SB
#undef PG8_STAGE
#undef PG8_STAGE_A
#undef PG8_STAGE_A2
#undef PG8_STAGE_B
#undef PG8_GATH
#undef PG8_LDA
#undef PG8_LDB
#undef PG8_MMA
#undef PG8_CAT
#undef PG8_WAIT_V
#undef PG8_WAIT_L
#undef PG8_BAR
#undef PG8_SCHED
}
}

#ifndef PG8_SP2
#define PG8_SP2 true
#endif
#ifndef PG8_ALIGN
#define PG8_ALIGN true
#endif
namespace pg8 {
struct EpiInProj {
    static constexpr bool PERM = true, AFTER_DRAIN = false, PERM16 = true, HAS_PRE = false, GUSPLIT = false, ROPE16 = true;
    bf16_t* O; int ldc; const float* CS; float qscale;
    __device__ __forceinline__ void operator()(const f32x4 (&acc)[2][2][4][2], const Unit& u, int wr, int wc, int fr, int fq) const {
        const int row0 = u.pm * BM + wr * 64 + fr, col0 = u.pn * BM + wc * 64 + 8 * fq;
        const bool rope = u.pn < 4; const float sc = u.pn < 2 ? qscale : 1.0f;
#pragma unroll
        for (int ai = 0; ai < 2; ++ai)
#pragma unroll
            for (int m = 0; m < 4; ++m) { const int row = row0 + ai * HALF + m * 16; bf16_t* rowp = O + (size_t)row * ldc + col0;
                f32x4 o1[2], o2[2];
                if (rope) { const float* cs = CS + (size_t)row * 64 + 8 * fq;
#pragma unroll
                    for (int bj = 0; bj < 2; ++bj) { const f32x4 c = *(const f32x4*)(cs + 4 * bj) * sc, sn = *(const f32x4*)(cs + 32 + 4 * bj) * sc; const f32x4 x1 = acc[ai][bj][m][0], x2 = acc[ai][bj][m][1];
                        o1[bj] = x1 * c - x2 * sn; o2[bj] = x2 * c + x1 * sn; } }
                else {
#pragma unroll
                    for (int bj = 0; bj < 2; ++bj) { o1[bj] = acc[ai][bj][m][0]; o2[bj] = acc[ai][bj][m][1]; } }
                u32x4 w1, w2;
                w1.x = cvt_pk_bf16(o1[0][0], o1[0][1]); w1.y = cvt_pk_bf16(o1[0][2], o1[0][3]); w1.z = cvt_pk_bf16(o1[1][0], o1[1][1]); w1.w = cvt_pk_bf16(o1[1][2], o1[1][3]);
                w2.x = cvt_pk_bf16(o2[0][0], o2[0][1]); w2.y = cvt_pk_bf16(o2[0][2], o2[0][3]); w2.z = cvt_pk_bf16(o2[1][0], o2[1][1]); w2.w = cvt_pk_bf16(o2[1][2], o2[1][3]);
                *(u32x4*)rowp = w1; *(u32x4*)(rowp + 32) = w2; }
    }
};
struct EpiResF32 {
    static constexpr bool PERM = false, AFTER_DRAIN = false, PERM16 = false, HAS_PRE = false, GUSPLIT = false, ROPE16 = false;
    const float* base; float* out; int ldc;
    __device__ __forceinline__ void operator()(const f32x4 (&acc)[2][2][4][2], const Unit& u, int wr, int wc, int fr, int fq) const {
        const int col0 = u.pn * BM + wc * 32 + 4 * fq;
        const size_t off0 = (size_t)(u.pm * BM + wr * 64 + fr) * ldc + col0;
        f32x4 bs[8][2][2];
#define PG8_RES_LD(g) do { const size_t off_ = off0 + (size_t)(((g) >> 2) * HALF + ((g) & 3) * 16) * ldc; _Pragma("unroll") for (int bj = 0; bj < 2; ++bj) _Pragma("unroll") for (int n = 0; n < 2; ++n) \
            bs[g][bj][n] = *(const f32x4*)(base + off_ + bj * HALF + n * 16); } while (0)
        PG8_RES_LD(0); PG8_RES_LD(1); PG8_RES_LD(2);
#pragma unroll
        for (int g = 0; g < 8; ++g) { const int ai = g >> 2, m = g & 3; const size_t off = off0 + (size_t)(ai * HALF + m * 16) * ldc;
            if (g + 3 < 8) PG8_RES_LD(g + 3);
#pragma unroll
            for (int bj = 0; bj < 2; ++bj)
#pragma unroll
                for (int n = 0; n < 2; ++n) *(f32x4*)(out + off + bj * HALF + n * 16) = bs[g][bj][n] + acc[ai][bj][m][n]; }
#undef PG8_RES_LD
    }
};
struct EpiSwiglu {
    static constexpr bool PERM = true, AFTER_DRAIN = false, PERM16 = true, HAS_PRE = true, GUSPLIT = true, ROPE16 = false;
    unsigned char* O; const float* bias;
    struct Pre { f32x4 bv[2][2]; };
    __device__ __forceinline__ void prefetch(Pre& p, const Unit& u, int wr, int fr) const {
        const int tid = threadIdx.x, wc = __builtin_amdgcn_readfirstlane(tid >> 6) & 3, fq = (tid & 63) >> 4;
        const int e = u.pn >> 3, pnl = u.pn & 7, bcol0 = pnl * BM + wc * 64 + 16 * fq;
        const float* bp = bias + (size_t)e * 2048 + bcol0;
#pragma unroll
        for (int bj = 0; bj < 2; ++bj)
#pragma unroll
            for (int n = 0; n < 2; ++n) p.bv[bj][n] = *(const f32x4*)(bp + 8 * bj + 4 * n);
    }
    typedef float f2 __attribute__((ext_vector_type(2)));
    static __device__ __forceinline__ f2 pkmul(f2 a, f2 b) { f2 r; asm("v_pk_mul_f32 %0, %1, %2" : "=v"(r) : "v"(a), "v"(b)); return r; }
    static __device__ __forceinline__ f2 pkadd1(f2 a) { f2 r; asm("s_nop 0\n\tv_pk_add_f32 %0, %1, 1.0 op_sel_hi:[1,0]" : "=v"(r) : "v"(a)); return r; }
    static __device__ __forceinline__ f2 pkmul_t(f2 a, f2 b) { f2 r; asm("s_nop 0\n\tv_pk_mul_f32 %0, %1, %2" : "=v"(r) : "v"(a), "v"(b)); return r; }
    static __device__ __forceinline__ f2 pkfma(f2 a, f2 b, f2 c) { f2 r; asm("v_pk_fma_f32 %0, %1, %2, %3" : "=v"(r) : "v"(a), "v"(b), "v"(c)); return r; }
    __device__ __forceinline__ void operator()(const f32x4 (&acc)[2][2][4][2], const Unit& u, int wr, int wc, int fr, int fq, const Pre& p) const {
        const int pnl = u.pn & 7;
        const int row0 = u.pm * BM + wr * 64 + fr, bcol0 = pnl * BM + wc * 64 + 16 * fq;
        f32x4 bg[2], bu[2];
#pragma unroll
        for (int bj = 0; bj < 2; ++bj) { bg[bj] = (f32x4){p.bv[bj][0][0], p.bv[bj][0][2], p.bv[bj][1][0], p.bv[bj][1][2]}; bu[bj] = (f32x4){p.bv[bj][0][1], p.bv[bj][0][3], p.bv[bj][1][1], p.bv[bj][1][3]}; }
        const f2 kk = {-1.702f * 1.4426950408889634f, -1.702f * 1.4426950408889634f};
#pragma unroll
        for (int ai = 0; ai < 2; ++ai)
#pragma unroll
            for (int m = 0; m < 4; ++m) { unsigned char* rowp = O + (size_t)(row0 + ai * HALF + m * 16) * 1024 + (bcol0 >> 1);
                f2 a[4];
#pragma unroll
                for (int bj = 0; bj < 2; ++bj) { const f32x4 G = acc[ai][bj][m][0] * MOE_WSCALE_INV + bg[bj], U = acc[ai][bj][m][1] * MOE_WSCALE_INV + bu[bj];
#pragma unroll
                    for (int h = 0; h < 2; ++h) {
                        const f2 gc = {fminf(G[2 * h], 7.0f), fminf(G[2 * h + 1], 7.0f)}, uc = {fminf(fmaxf(U[2 * h], -7.0f), 7.0f), fminf(fmaxf(U[2 * h + 1], -7.0f), 7.0f)};
                        const f2 t = pkmul(gc, kk); const f2 e = {__builtin_amdgcn_exp2f(t[0]), __builtin_amdgcn_exp2f(t[1])};
                        const f2 d = pkadd1(e); const f2 r = {__builtin_amdgcn_rcpf(d[0]), __builtin_amdgcn_rcpf(d[1])};
                        a[2 * bj + h] = pkmul_t(pkfma(uc, gc, gc), r); } }
                typedef unsigned u32x2 __attribute__((ext_vector_type(2)));
                u32x2 w; w.x = pk_fp8x4(a[0][0], a[0][1], a[1][0], a[1][1]); w.y = pk_fp8x4(a[2][0], a[2][1], a[3][0], a[3][1]);
                *(u32x2*)rowp = w; }
    }
};
struct EpiMoeOut {
    static constexpr bool PERM = true, AFTER_DRAIN = false, PERM16 = true, HAS_PRE = true, GUSPLIT = false, ROPE16 = false;
    unsigned char* YS; const float* bias; const float* rgate;
    struct Pre { float g[8]; f32x4 bv[2][2]; };
    __device__ __forceinline__ void prefetch(Pre& p, const Unit& u, int wr, int fr) const {
        const int row0 = u.pm * BM + wr * 64 + fr;
#pragma unroll
        for (int ai = 0; ai < 2; ++ai)
#pragma unroll
            for (int m = 0; m < 4; ++m) p.g[ai * 4 + m] = rgate[row0 + ai * HALF + m * 16];
        const int tid = threadIdx.x, wc = __builtin_amdgcn_readfirstlane(tid >> 6) & 3, fq = (tid & 63) >> 4;
        const float* bp = bias + (size_t)(u.pn >> 2) * 1024 + (u.pn & 3) * BM + wc * 64 + 16 * fq;
#pragma unroll
        for (int bj = 0; bj < 2; ++bj)
#pragma unroll
            for (int n = 0; n < 2; ++n) p.bv[bj][n] = *(const f32x4*)(bp + 8 * bj + 4 * n);
    }
    __device__ __forceinline__ void operator()(const f32x4 (&acc)[2][2][4][2], const Unit& u, int wr, int wc, int fr, int fq, const Pre& p) const {
        const int pnl = u.pn & 3;
        const int col0 = pnl * BM + wc * 64 + 16 * fq;
        const int row0 = u.pm * BM + wr * 64 + fr;
        const f32x4 (&bv)[2][2] = p.bv;
#pragma unroll
        for (int ai = 0; ai < 2; ++ai)
#pragma unroll
            for (int m = 0; m < 4; ++m) { const float gt = p.g[ai * 4 + m] * MOE_YSCALE; u32x4 w;
                { const f32x4 v0 = (acc[ai][0][m][0] * MOE_WSCALE_INV + bv[0][0]) * gt, v1 = (acc[ai][0][m][1] * MOE_WSCALE_INV + bv[0][1]) * gt; w.x = pk_fp8x4(v0[0], v0[1], v0[2], v0[3]); w.y = pk_fp8x4(v1[0], v1[1], v1[2], v1[3]); }
                { const f32x4 v0 = (acc[ai][1][m][0] * MOE_WSCALE_INV + bv[1][0]) * gt, v1 = (acc[ai][1][m][1] * MOE_WSCALE_INV + bv[1][1]) * gt; w.z = pk_fp8x4(v0[0], v0[1], v0[2], v0[3]); w.w = pk_fp8x4(v1[0], v1[1], v1[2], v1[3]); }
                *(u32x4*)(YS + (size_t)(row0 + ai * HALF + m * 16) * 1024 + col0) = w; }
    }
};
template <int NTN> struct MoeOrder {
    int ntiles, c, G; const PG8_LAS int* te;
    __device__ __forceinline__ bool next(int i, Unit& u) const {
        int pm, pnl; constexpr int RT = 32 / NTN;
        if (G == 256) { const int x = c & 7, j = c >> 3, gidx = i * 8 + x; pm = RT * gidx + (j % RT); pnl = j / RT; }
        else { const long L = (long)i * G + c; pm = (int)(L / NTN); pnl = (int)(L % NTN); }
        if (pm >= ntiles) return false;
        u.pm = pm; u.pn = te[pm] * NTN + pnl; return true;
    }
    __device__ __forceinline__ void a_ready(const Unit&) const {}
    __device__ __forceinline__ void done(const Unit&) const {}
};
}
#include <hip/hip_bf16.h>
#include <cmath>
namespace attn_body {
using bf16=__hip_bfloat16;
using bf16x8=__attribute__((ext_vector_type(8)))short;
using s16x4=__attribute__((ext_vector_type(4)))short;
using f32x16=__attribute__((ext_vector_type(16)))float;
using u32x4=__attribute__((ext_vector_type(4)))unsigned;
constexpr int SEQ=8192,D=64,PQ=3328,PO=1024;
constexpr int NW=8,QBLK=32,QB=QBLK*NW,KVBLK=64,NQB=SEQ/QB;
constexpr int ATTN_UNIT_ROWS=QB;
__device__ __forceinline__ int crow(int r,int hi){return (r&3)+8*(r>>2)+4*hi;}
#define SBAR() __builtin_amdgcn_sched_barrier(0)
__device__ __forceinline__ void cmask(f32x16&p0,f32x16&p1,int jb,int qrel,int hi){
  const float NEG=-INFINITY; int kb=64*jb+4*hi;
  #pragma unroll
  for(int r=0;r<16;++r){int kv=kb+(r&3)+8*(r>>2); if(kv>qrel)p0[r]=NEG; if(kv+32>qrel)p1[r]=NEG;}
}

constexpr int NSLOT=3, SLOTB=8192;
constexpr int LDS_K=0, LDS_V=NSLOT*SLOTB, LDS_WS=2*NSLOT*SLOTB, LDS_OST=LDS_WS+NW*64*4, LDS_BYTES=LDS_OST+NW*4096;
constexpr float C2=0.125f*1.4426950408889634f;
__device__ __forceinline__ void glds16(const void*gsrc,unsigned lds_dst){unsigned keep;
  asm volatile("s_mov_b32 %0, m0\n\ts_mov_b32 m0, %2\n\ts_nop 0\n\tglobal_load_lds_dwordx4 %1, off\n\ts_mov_b32 m0, %0":"=&s"(keep):"v"(gsrc),"s"(lds_dst):"memory");}
__device__ __forceinline__ void glds16s(const void*gbase,unsigned voff,unsigned lds_dst){unsigned keep;
  asm volatile("s_mov_b32 %0, m0\n\ts_mov_b32 m0, %2\n\ts_nop 0\n\tglobal_load_lds_dwordx4 %1, %3\n\ts_mov_b32 m0, %0":"=&s"(keep):"v"(voff),"s"(lds_dst),"s"(gbase):"memory");}
__device__ __forceinline__ float max3f(float a,float b,float c){float r;asm("v_max3_f32 %0, %1, %2, %3":"=v"(r):"v"(a),"v"(b),"v"(c));return r;}
__device__ __forceinline__ float max2f(float a,float b){float r;asm("v_max_f32_e32 %0, %1, %2":"=v"(r):"v"(a),"v"(b));return r;}
__device__ __forceinline__ float fadd_s(float a,float b){float r;asm("v_add_f32_e32 %0, %1, %2":"=v"(r):"v"(a),"v"(b));return r;}
__device__ __forceinline__ float fsub_s(float a,float b){float r;asm("v_sub_f32_e32 %0, %1, %2":"=v"(r):"v"(a),"v"(b));return r;}
typedef float f32x2_t __attribute__((ext_vector_type(2))); typedef __bf16 bf16x2_t __attribute__((ext_vector_type(2)));
__device__ __forceinline__ unsigned cvtpk_s(float lo,float hi){f32x2_t v={lo,hi};bf16x2_t b=__builtin_convertvector(v,bf16x2_t);return __builtin_bit_cast(unsigned,b);}
#define WAIT_BAR(N) asm volatile("s_waitcnt vmcnt(" #N ") lgkmcnt(0)\n\ts_barrier":::"memory")

__device__ __forceinline__ void qkt(f32x16&p0,f32x16&p1,const char*Kslot,const bf16x8*qr,const f32x16&negm,int r32,int hi){
  const char*kb=Kslot+hi*1024+r32*16;
  #pragma unroll
  for(int d0=0;d0<4;++d0){
    const bf16x8 b0=*reinterpret_cast<const bf16x8*>(kb+d0*2048);
    const bf16x8 b1=*reinterpret_cast<const bf16x8*>(kb+d0*2048+512);
    if(d0==0){p0=__builtin_amdgcn_mfma_f32_32x32x16_bf16(b0,qr[0],negm,0,0,0);p1=__builtin_amdgcn_mfma_f32_32x32x16_bf16(b1,qr[0],negm,0,0,0);}
    else{p0=__builtin_amdgcn_mfma_f32_32x32x16_bf16(b0,qr[d0],p0,0,0,0);p1=__builtin_amdgcn_mfma_f32_32x32x16_bf16(b1,qr[d0],p1,0,0,0);}}
}
typedef __attribute__((address_space(3))) const char* lds_cptr;
typedef short v4i16_t __attribute__((ext_vector_type(4)));
__device__ __forceinline__ void kload8(bf16x8*kf,lds_cptr kp){
  kf[0]=*(const __attribute__((address_space(3))) bf16x8*)(kp);      kf[1]=*(const __attribute__((address_space(3))) bf16x8*)(kp+512);
  kf[2]=*(const __attribute__((address_space(3))) bf16x8*)(kp+2048); kf[3]=*(const __attribute__((address_space(3))) bf16x8*)(kp+2560);
  kf[4]=*(const __attribute__((address_space(3))) bf16x8*)(kp+4096); kf[5]=*(const __attribute__((address_space(3))) bf16x8*)(kp+4608);
  kf[6]=*(const __attribute__((address_space(3))) bf16x8*)(kp+6144); kf[7]=*(const __attribute__((address_space(3))) bf16x8*)(kp+6656);
}
__device__ __forceinline__ void kload2(bf16x8*kf,lds_cptr kp,int j){ kf[2*j]=*(const __attribute__((address_space(3))) bf16x8*)(kp+j*2048); kf[2*j+1]=*(const __attribute__((address_space(3))) bf16x8*)(kp+j*2048+512); }
__device__ __forceinline__ s16x4 vtr(lds_cptr p){ return __builtin_bit_cast(s16x4,__builtin_amdgcn_ds_read_tr16_b64_v4i16((__attribute__((address_space(3))) v4i16_t*)p)); }
__device__ __forceinline__ float rowmax(const f32x16&p0,const f32x16&p1){
  float a=max3f(p0[0],p0[1],p1[0]),b=max3f(p0[2],p0[3],p1[1]);a=max3f(a,p1[2],p1[3]);
  #pragma unroll
  for(int r=4;r<16;r+=4){a=max3f(a,p0[r],p0[r+1]);b=max3f(b,p0[r+2],p0[r+3]);a=max3f(a,p1[r],p1[r+1]);b=max3f(b,p1[r+2],p1[r+3]);}
  const float m=max2f(a,b);
  auto rr=__builtin_amdgcn_permlane32_swap(__float_as_uint(m),__float_as_uint(m),false,false);
  return max2f(__uint_as_float(rr[0]),__uint_as_float(rr[1]));
}
#ifndef ATTN_STORE16
#define ATTN_STORE16(p,v) (*(u32x4*)(p)=(v))
#endif
constexpr int VSLOTB=16384, LDS2_V=NSLOT*SLOTB, LDS2_WS=LDS2_V+NSLOT*VSLOTB, LDS2_OST=LDS2_WS+NW*64*4, LDS2_BYTES=LDS2_OST+NW*8192;
__device__ __forceinline__ void pv128(f32x16*o,int vb,bf16x8 pa0,bf16x8 pa1,bf16x8 pa2,bf16x8 pa3){
  #pragma unroll
  for(int d0=0;d0<4;++d0){s16x4 lo[4],hi[4];
    #pragma unroll
    for(int ks=0;ks<4;++ks){
      asm volatile("ds_read_b64_tr_b16 %0,%1 offset:%c2":"=&v"(lo[ks]):"v"(vb),"i"(d0*4096+ks*1024):"memory");
      asm volatile("ds_read_b64_tr_b16 %0,%1 offset:%c2":"=&v"(hi[ks]):"v"(vb),"i"(d0*4096+ks*1024+512):"memory");}
    asm volatile("s_waitcnt lgkmcnt(0)":::"memory");SBAR();
    #define PK(k) (bf16x8){lo[k][0],lo[k][1],lo[k][2],lo[k][3],hi[k][0],hi[k][1],hi[k][2],hi[k][3]}
    o[d0]=__builtin_amdgcn_mfma_f32_32x32x16_bf16(pa0,PK(0),o[d0],0,0,0);
    o[d0]=__builtin_amdgcn_mfma_f32_32x32x16_bf16(pa1,PK(1),o[d0],0,0,0);
    o[d0]=__builtin_amdgcn_mfma_f32_32x32x16_bf16(pa2,PK(2),o[d0],0,0,0);
    o[d0]=__builtin_amdgcn_mfma_f32_32x32x16_bf16(pa3,PK(3),o[d0],0,0,0);
    #undef PK
  }
}
template<int THRL> __device__ __forceinline__ void attn_unit128(int b,int qb,const bf16*Q,const bf16*__restrict__ K,const bf16*__restrict__ V,bf16*O,char*shm){
  const int tid=threadIdx.x,lane=tid&63,r32=lane&31,hi=lane>>5; const int wid=__builtin_amdgcn_readfirstlane(tid>>6);
  const long rowbase=(long)b*SEQ; const int q0=qb*QB;
  const bf16*Qw=Q+(rowbase+q0+wid*QBLK)*PQ;
  const bf16*Kh=K+rowbase*PQ,*Vh=V+rowbase*PQ;
  const unsigned lds0=(unsigned)(uintptr_t)shm;
  float*wsf=(float*)(shm+LDS2_WS)+wid*64;
  const bf16*ksrc=Kh+wid*8; const unsigned koff=(unsigned)lane*(PQ*2);
  const bf16*vsrc=Vh+(long)(16*(wid&3))*PQ+(wid>>2)*32; const unsigned voff=(unsigned)(lane>>2)*(PQ*2)+(unsigned)(lane&3)*16;
  const unsigned kdst=lds0+LDS_K+wid*1024, vdst=lds0+LDS2_V+wid*1024;
  #define DMA_K(t,slot) glds16s(ksrc+(long)(t)*KVBLK*PQ,koff,(unsigned)__builtin_amdgcn_readfirstlane(kdst+(slot)))
  #define DMA_V(t,slot) do{ glds16s(vsrc+(long)(t)*KVBLK*PQ,voff,(unsigned)__builtin_amdgcn_readfirstlane(vdst+2*(slot))); glds16s(vsrc+(long)(t)*KVBLK*PQ+64,voff,(unsigned)__builtin_amdgcn_readfirstlane(vdst+2*(slot)+8192)); }while(0)
  const char*Kbase=shm+LDS_K; bf16x8 kf[8];
  const lds_cptr shm3=(lds_cptr)shm; const lds_cptr kp0=shm3+LDS_K+hi*1024+r32*16; const lds_cptr vp0=shm3+LDS2_V+((lane>>4)&1)*32+(lane&3)*8+(4*hi+((lane&15)>>2))*64;
  const int NT=(q0+QB)/KVBLK;
  DMA_K(0,0);DMA_V(0,0);DMA_K(1,SLOTB);
  bf16x8 qr[4];
  #pragma unroll
  for(int d0=0;d0<4;++d0)qr[d0]=*reinterpret_cast<const bf16x8*>(&Qw[(long)r32*PQ+d0*16+hi*8]);
  float mhat=0.f,l_reg=0.f;f32x16 o[4];o[0]=f32x16{};o[1]=f32x16{};o[2]=f32x16{};o[3]=f32x16{};const f32x16 zz=f32x16{};
  const int qrel=wid*QBLK+r32;
  #define CMASK(P0,P1,t) do{int jb_=(t)-(NT-4); if(jb_>=0)cmask(P0,P1,jb_,qrel,hi);}while(0)
  bool resc=false;
  #define START(P0,P1) do{ const float rm=rowmax(P0,P1); resc=false; \
    mhat=rm; \
    _Pragma("unroll") for(int r=0;r<16;++r)P0[r]=__builtin_amdgcn_exp2f(P0[r]-mhat); }while(0)
  #define RESC() do{ if(resc){ asm volatile("s_waitcnt lgkmcnt(0)":::"memory"); \
      _Pragma("unroll") for(int d_=0;d_<4;++d_) _Pragma("unroll") for(int r=0;r<16;++r)o[d_][r]*=wsf[crow(r,hi)]; } }while(0)
  f32x16 pA0,pA1,pB0,pB1;
  int sl_prev=0,sl_cur=0,sl_next=SLOTB;
  #define ROT() do{sl_prev=sl_cur;sl_cur=sl_next;sl_next=(sl_next==(NSLOT-1)*SLOTB)?0:sl_next+SLOTB;}while(0)
  DMA_K(2,2*SLOTB);
  WAIT_BAR(3);
  qkt(pA0,pA1,Kbase,qr,zz,r32,hi);asm volatile("s_nop 15\n\ts_nop 7":"+v"(pA0),"+v"(pA1));CMASK(pA0,pA1,0);
  START(pA0,pA1);
  _Pragma("unroll") for(int r=0;r<16;++r)pA1[r]=__builtin_amdgcn_exp2f(pA1[r]-mhat);
  WAIT_BAR(0);
  DMA_K(3,0);DMA_V(1,SLOTB);
  ROT();
  kload8(kf,kp0+sl_cur);
  WAIT_BAR(3);
  s16x4 vlo[4],vhi[4]; u32x4 pw0,pw1,pw2,pw3;
  #define PKW(P,B) cvtpk_s(P[B],P[B+1])
  #define PAF(k) __builtin_bit_cast(bf16x8,pw##k)
  #define FIDX(j) ((((j)&7)>>1)+4*((j)&1)+8*((j)>>3))
  #define VOFF(f) (((f)>>2)*4096+((f)&3)*1024)
  #define VRDJ(j) do{ vlo[(j)&3]=vtr(vp_+VOFF(FIDX(j))); vhi[(j)&3]=vtr(vp_+(VOFF(FIDX(j))+512)); SBAR(); }while(0)
  #define VFJ(j) (bf16x8){vlo[(j)&3][0],vlo[(j)&3][1],vlo[(j)&3][2],vlo[(j)&3][3],vhi[(j)&3][0],vhi[(j)&3][1],vhi[(j)&3][2],vhi[(j)&3][3]}
  #define PIN(x) asm volatile("":"+v"(x))
  #define MX3(a,b,c) __builtin_fmaxf(__builtin_fmaxf((a),(b)),(c))
  #define GAPA(MF,A0,A1,A2,A3,W0,W1,PW) do{ MF; sacc+=A0; sacc+=A1; sacc+=A2; sacc+=A3; PIN(sacc); W0; W1; PIN(PW); SBAR(); }while(0)
  #define EX(v) __builtin_amdgcn_exp2f(v)
  #define GAPB2(MF,X,B) do{ MF; X[B]=EX(X[B]-mhat); X[B+1]=EX(X[B+1]-mhat); PIN(X); SBAR(); }while(0)
  #define KRD(G,j) do{ if(G){ kload2(kf,kp0+sl_next,j); SBAR(); } }while(0)
  #define STEP(C0,C1,P0,P1,t,GK,GV,GL) do{ SBAR(); \
    const lds_cptr vp_=vp0+2*sl_prev; \
    float sacc=(P0[0]+P0[1]); \
    GAPA(C0=__builtin_amdgcn_mfma_f32_32x32x16_bf16(kf[0],qr[0],zz,0,0,0), P0[2],P0[3],P0[4],P0[5], pw0[0]=PKW(P0,0), pw0[1]=PKW(P0,2), pw0); \
    GAPA(C1=__builtin_amdgcn_mfma_f32_32x32x16_bf16(kf[1],qr[0],zz,0,0,0), P0[6],P0[7],P0[8],P0[9], pw0[2]=PKW(P0,4), pw0[3]=PKW(P0,6), pw0); \
    GAPA(C0=__builtin_amdgcn_mfma_f32_32x32x16_bf16(kf[2],qr[1],C0,0,0,0), P0[10],P0[11],P0[12],P0[13], pw1[0]=PKW(P0,8), pw1[1]=PKW(P0,10), pw1); \
    GAPA(C1=__builtin_amdgcn_mfma_f32_32x32x16_bf16(kf[3],qr[1],C1,0,0,0), P0[14],P0[15],P1[0],P1[1], pw1[2]=PKW(P0,12),pw1[3]=PKW(P0,14), pw1); \
    GAPA(C0=__builtin_amdgcn_mfma_f32_32x32x16_bf16(kf[4],qr[2],C0,0,0,0), P1[2],P1[3],P1[4],P1[5], pw2[0]=PKW(P1,0), pw2[1]=PKW(P1,2), pw2); \
    GAPA(C1=__builtin_amdgcn_mfma_f32_32x32x16_bf16(kf[5],qr[2],C1,0,0,0), P1[6],P1[7],P1[8],P1[9], pw2[2]=PKW(P1,4), pw2[3]=PKW(P1,6), pw2); \
    GAPA(C0=__builtin_amdgcn_mfma_f32_32x32x16_bf16(kf[6],qr[3],C0,0,0,0), P1[10],P1[11],P1[12],P1[13], pw3[0]=PKW(P1,8), pw3[1]=PKW(P1,10), pw3); \
    GAPA(C1=__builtin_amdgcn_mfma_f32_32x32x16_bf16(kf[7],qr[3],C1,0,0,0), P1[14],P1[15],0.f,0.f, pw3[2]=PKW(P1,12),pw3[3]=PKW(P1,14), pw3); \
    l_reg+=sacc; \
    if(GK){DMA_K((t)+3,sl_cur);} if(GV){DMA_V((t)+1,sl_next);} \
    VRDJ(0); VRDJ(1); VRDJ(2); \
    CMASK(C0,C1,t); \
    { float a=MX3(C0[0],C0[1],C1[0]),b=MX3(C0[2],C0[3],C1[1]); a=MX3(a,C1[2],C1[3]); \
      _Pragma("unroll") for(int r=4;r<16;r+=4){a=MX3(a,C0[r],C0[r+1]);b=MX3(b,C0[r+2],C0[r+3]);a=MX3(a,C1[r],C1[r+1]);b=MX3(b,C1[r+2],C1[r+3]);} \
      float rm=__builtin_fmaxf(a,b); { auto rr=__builtin_amdgcn_permlane32_swap(__float_as_uint(rm),__float_as_uint(rm),false,false); rm=__builtin_fmaxf(__uint_as_float(rr[0]),__uint_as_float(rr[1])); } \
      resc=false; \
      rm-=mhat; \
      if(__builtin_expect(__any(rm>(float)THRL),0)){ const float dl=__builtin_fmaxf(rm,0.f); mhat+=dl; \
        const float f=__builtin_amdgcn_exp2f(-dl); l_reg*=f; if(hi==0)wsf[r32]=f; resc=true; } } \
    SBAR(); \
    GAPB2(o[0]=__builtin_amdgcn_mfma_f32_32x32x16_bf16(PAF(0),VFJ(0),o[0],0,0,0), C0,0); VRDJ(3); \
    GAPB2(o[1]=__builtin_amdgcn_mfma_f32_32x32x16_bf16(PAF(0),VFJ(1),o[1],0,0,0), C0,2); VRDJ(4); \
    KRD(GL,0); GAPB2(o[0]=__builtin_amdgcn_mfma_f32_32x32x16_bf16(PAF(1),VFJ(2),o[0],0,0,0), C0,4); VRDJ(5); \
    KRD(GL,1); GAPB2(o[1]=__builtin_amdgcn_mfma_f32_32x32x16_bf16(PAF(1),VFJ(3),o[1],0,0,0), C0,6); VRDJ(6); \
    KRD(GL,2); GAPB2(o[0]=__builtin_amdgcn_mfma_f32_32x32x16_bf16(PAF(2),VFJ(4),o[0],0,0,0), C0,8); VRDJ(7); \
    KRD(GL,3); GAPB2(o[1]=__builtin_amdgcn_mfma_f32_32x32x16_bf16(PAF(2),VFJ(5),o[1],0,0,0), C0,10); VRDJ(8); \
    GAPB2(o[0]=__builtin_amdgcn_mfma_f32_32x32x16_bf16(PAF(3),VFJ(6),o[0],0,0,0), C0,12); VRDJ(9); \
    GAPB2(o[1]=__builtin_amdgcn_mfma_f32_32x32x16_bf16(PAF(3),VFJ(7),o[1],0,0,0), C0,14); VRDJ(10); \
    GAPB2(o[2]=__builtin_amdgcn_mfma_f32_32x32x16_bf16(PAF(0),VFJ(8),o[2],0,0,0), C1,0); VRDJ(11); \
    GAPB2(o[3]=__builtin_amdgcn_mfma_f32_32x32x16_bf16(PAF(0),VFJ(9),o[3],0,0,0), C1,2); VRDJ(12); \
    GAPB2(o[2]=__builtin_amdgcn_mfma_f32_32x32x16_bf16(PAF(1),VFJ(10),o[2],0,0,0), C1,4); VRDJ(13); \
    GAPB2(o[3]=__builtin_amdgcn_mfma_f32_32x32x16_bf16(PAF(1),VFJ(11),o[3],0,0,0), C1,6); VRDJ(14); \
    GAPB2(o[2]=__builtin_amdgcn_mfma_f32_32x32x16_bf16(PAF(2),VFJ(12),o[2],0,0,0), C1,8); VRDJ(15); \
    GAPB2(o[3]=__builtin_amdgcn_mfma_f32_32x32x16_bf16(PAF(2),VFJ(13),o[3],0,0,0), C1,10); \
    GAPB2(o[2]=__builtin_amdgcn_mfma_f32_32x32x16_bf16(PAF(3),VFJ(14),o[2],0,0,0), C1,12); \
    GAPB2(o[3]=__builtin_amdgcn_mfma_f32_32x32x16_bf16(PAF(3),VFJ(15),o[3],0,0,0), C1,14); \
    }while(0)
  int t=1;
  #undef CMASK
  #define CMASK(P0,P1,t) do{}while(0)
  for(;t+5<NT;t+=2){
    STEP(pB0,pB1,pA0,pA1,t,true,true,true);     WAIT_BAR(3); RESC(); ROT();
    STEP(pA0,pA1,pB0,pB1,t+1,true,true,true);   WAIT_BAR(3); RESC(); ROT();
  }
  #undef CMASK
  #define CMASK(P0,P1,t) do{int jb_=(t)-(NT-4); if(jb_>=0)cmask(P0,P1,jb_,qrel,hi);}while(0)
  #define ENDW(tt) do{ if((tt)+3<NT){WAIT_BAR(3);} else if((tt)+2<NT){WAIT_BAR(2);} else {WAIT_BAR(0);} }while(0)
  for(;t+1<NT;t+=2){
    STEP(pB0,pB1,pA0,pA1,t,(t+3<NT),(t+1<NT),(t+1<NT));       ENDW(t);   RESC(); ROT();
    STEP(pA0,pA1,pB0,pB1,t+1,(t+4<NT),(t+2<NT),(t+2<NT));     ENDW(t+1); RESC(); ROT();
  }
  STEP(pB0,pB1,pA0,pA1,NT-1,false,false,false); RESC();
  { float sacc=pB0[0]+pB0[1]; _Pragma("unroll") for(int r=2;r<16;++r)sacc+=pB0[r]; _Pragma("unroll") for(int r=0;r<16;++r)sacc+=pB1[r]; l_reg+=sacc;
    pw0=(u32x4){PKW(pB0,0),PKW(pB0,2),PKW(pB0,4),PKW(pB0,6)};pw1=(u32x4){PKW(pB0,8),PKW(pB0,10),PKW(pB0,12),PKW(pB0,14)};pw2=(u32x4){PKW(pB1,0),PKW(pB1,2),PKW(pB1,4),PKW(pB1,6)};pw3=(u32x4){PKW(pB1,8),PKW(pB1,10),PKW(pB1,12),PKW(pB1,14)};
    SBAR(); pv128(o,(int)(unsigned)(uintptr_t)vp0+2*sl_cur,PAF(0),PAF(1),PAF(2),PAF(3)); }
  #undef PKW
  #undef PAF
  #undef PIN
  #undef MX3
  #undef GAPA
  #undef EX
  #undef VRDJ
  #undef VFJ
  #undef FIDX
  #undef VOFF
  #undef GAPB2
  #undef KRD
  #undef STEP
  #undef ENDW
  int lane_e=lane; asm volatile("":"+v"(lane_e)); const int r32e=lane_e&31,hie=lane_e>>5;
  {auto rr=__builtin_amdgcn_permlane32_swap(__float_as_uint(l_reg),__float_as_uint(l_reg),false,false);l_reg=__uint_as_float(rr[0])+__uint_as_float(rr[1]);}
  if(hie==0)wsf[32+r32e]=l_reg;asm volatile("s_waitcnt lgkmcnt(0)":::"memory");
  float rli[16];
  #pragma unroll
  for(int r=0;r<16;++r)rli[r]=__builtin_amdgcn_rcpf(wsf[32+crow(r,hie)]);
  bf16*Ow=O+(rowbase+q0+wid*QBLK)*PO;
  { bf16*stg=(bf16*)(shm+LDS2_OST)+wid*4096;
    #pragma unroll
    for(int r=0;r<16;++r){const int orow=crow(r,hie);
      #pragma unroll
      for(int d0=0;d0<4;++d0)stg[orow*128+d0*32+r32e]=__float2bfloat16(o[d0][r]*rli[r]);}
    asm volatile("s_waitcnt lgkmcnt(0)":::"memory");
    #pragma unroll
    for(int i=0;i<8;++i){const int row=i*4+(lane_e>>4),ch=lane_e&15; const u32x4 v=*(const u32x4*)(stg+row*128+ch*8); ATTN_STORE16(Ow+(long)row*PO+ch*8,v);} }
  asm volatile("s_waitcnt lgkmcnt(0)\n\ts_barrier":::"memory");
  #undef DMA_K
  #undef DMA_V
  #undef CMASK
  #undef START
  #undef RESC
  #undef ROT
}
constexpr int ATTN_LDS_BYTES=LDS2_BYTES;
#undef SBAR
#undef WAIT_BAR
}
#define GAS __attribute__((address_space(1)))
#define LAS __attribute__((address_space(3)))
typedef unsigned short bf16;
typedef unsigned v4u __attribute__((ext_vector_type(4)));
typedef float f32x4 __attribute__((ext_vector_type(4)));
typedef short bf16x8 __attribute__((ext_vector_type(8)));
typedef GAS unsigned gu32;
typedef GAS unsigned long long gu64;
#define RLX_AGENT __ATOMIC_RELAXED, __HIP_MEMORY_SCOPE_AGENT
#define LDS_WAIT() asm volatile("s_waitcnt lgkmcnt(0)" ::: "memory")
#define VM_WAIT() asm volatile("s_waitcnt vmcnt(0)" ::: "memory")
__device__ __forceinline__ unsigned long long rt() { return __builtin_amdgcn_s_memrealtime(); }
__device__ __forceinline__ unsigned f2bf(float f) { unsigned u = __builtin_bit_cast(unsigned, f); return (u + 0x7fffu + ((u >> 16) & 1u)) >> 16; }
__device__ __forceinline__ unsigned pk2(float lo, float hi) { return f2bf(lo) | (f2bf(hi) << 16); }

#define XB_TMO      128
#define XB_XCNT(j)  (256  + 64 * (j))
#define XB_XSUB(j)  (1280 + 64 * (j))
#define XB_XGEN(j)  (2304 + 64 * (j))
#define XB_TOP      3328
#define XB_TOPGEN   3392
#define XCD_BAR_WORDS 3456
#define XB_SPIN_CAP (1u << 18)

__device__ __forceinline__ unsigned xb_ld(unsigned* p)              { return __hip_atomic_load(p, __ATOMIC_RELAXED, __HIP_MEMORY_SCOPE_AGENT); }
__device__ __forceinline__ unsigned xb_add(unsigned* p, unsigned v) { return __hip_atomic_fetch_add(p, v, __ATOMIC_RELAXED, __HIP_MEMORY_SCOPE_AGENT); }
__device__ __forceinline__ unsigned xb_xcc_id() { return (unsigned)__builtin_amdgcn_s_getreg((3 << 11) | 20) & 0xFu; }
#define XB_SPIN(cond, bar) do { unsigned _sp = 0; while (cond) { __builtin_amdgcn_s_sleep(1); \
    if ((++_sp & 255u) == 0u) { if (xb_ld(&(bar)[XB_TMO])) break; if (_sp > XB_SPIN_CAP) { atomicAdd(&(bar)[XB_TMO], 1u); break; } } } } while (0)

struct XcdBarrier {
    unsigned* bar; unsigned x;
    volatile LAS unsigned* st;
};

__device__ __forceinline__ XcdBarrier xcd_barrier_post(unsigned* bar, volatile LAS unsigned* st) {
    XcdBarrier b; b.bar = bar; b.x = xb_xcc_id(); b.st = st;
    if (threadIdx.x == 0) (void)xb_add(&bar[XB_XCNT(b.x)], 1u);
    return b;
}
__device__ __forceinline__ void xcd_barrier_complete(unsigned* bar, unsigned x, unsigned& nloc, unsigned& nx) {
    const unsigned G = gridDim.x * gridDim.y * gridDim.z;
    unsigned sum, cnt, mine, sp = 0u;
    for (;;) {
        sum = 0u; cnt = 0u; mine = 0u;
#pragma unroll
        for (unsigned j = 0; j < 16; ++j) { const unsigned c = xb_ld(&bar[XB_XCNT(j)]); sum += c; cnt += (c > 0u) ? 1u : 0u; mine = (j == x) ? c : mine; }
        if (sum == G) break;
        __builtin_amdgcn_s_sleep(1);
        if ((++sp & 255u) == 0u) { if (xb_ld(&bar[XB_TMO])) break; if (sp > XB_SPIN_CAP) { atomicAdd(&bar[XB_TMO], 1u); break; } }
    }
    nloc = mine > 0u ? mine : 1u; nx = cnt > 0u ? cnt : 1u;
}

__device__ __forceinline__ void xcd_barrier(const XcdBarrier& b) {
    asm volatile("s_waitcnt vmcnt(0)" ::: "memory");
    __syncthreads();
    if (threadIdx.x == 0) {
        unsigned* bar = b.bar;
        __builtin_amdgcn_s_waitcnt(0);
        unsigned nloc = b.st[0], nx = b.st[1];
        if (nloc == 0u) { xcd_barrier_complete(bar, b.x, nloc, nx); b.st[0] = nloc; b.st[1] = nx; }
        const unsigned old = xb_add(&bar[XB_XSUB(b.x)], 1u);
        const unsigned gen = old / nloc;
        if (old + 1u == (gen + 1u) * nloc) {
            __builtin_amdgcn_fence(__ATOMIC_RELEASE, "agent");
            asm volatile("s_waitcnt vmcnt(0)" ::: "memory");
            const unsigned og = xb_add(&bar[XB_TOP], 1u);
            const unsigned tg = og / nx;
            if (og + 1u == (tg + 1u) * nx) xb_add(&bar[XB_TOPGEN], 1u);
            else XB_SPIN(xb_ld(&bar[XB_TOPGEN]) == tg, bar);
            __builtin_amdgcn_fence(__ATOMIC_ACQUIRE, "agent");
            xb_add(&bar[XB_XGEN(b.x)], 1u);
            asm volatile("s_waitcnt vmcnt(0)" ::: "memory");
        } else {
            XB_SPIN(xb_ld(&bar[XB_XGEN(b.x)]) == gen, bar);
            __builtin_amdgcn_fence(__ATOMIC_ACQUIRE, "agent");
            asm volatile("s_waitcnt vmcnt(0)" ::: "memory");
        }
    }
    __syncthreads();
}
constexpr int NWAVES = 8;
constexpr int BATCH = 4, SEQ = 8192, T = BATCH * SEQ, D = 1024;
constexpr int IN_COLS = 3328, RW_OFF = 1536, RWW = 512;
constexpr int NEXP = 32, TOPK = 4;
constexpr int P_MAX = T * TOPK + NEXP * 256, MAX_TILES = P_MAX / 256;
constexpr float NORM_EPS = 1e-5f, GN_EPS = 64e-5f, LAM_INIT = 0.2f;
constexpr size_t MiB = 1u << 20;
constexpr size_t WS_CTL = 0, CTL_ZERO_BYTES = 128 * 1024;
constexpr size_t WS_BS = 1 * MiB;
constexpr size_t WS_TOPI = 2 * MiB, WS_GATE = 2 * MiB + 512 * 1024, WS_POS = 3 * MiB;
constexpr size_t WS_CS = 96 * MiB;
constexpr size_t WS_RGATE = 5 * MiB;
constexpr size_t WS_RSRC = 7 * MiB;
constexpr size_t WS_RWS = 6 * MiB;
constexpr size_t WS_WO = 8 * MiB, WS_WL = 10 * MiB, WS_WIN = 11 * MiB, WS_W1 = 18 * MiB, WS_W2 = 146 * MiB;
constexpr size_t WS_PB = 210 * MiB;
constexpr size_t WS_YB = 418 * MiB;
constexpr size_t WS_LG = 482 * MiB;
constexpr size_t WS_AO = 514 * MiB;
constexpr size_t WS_FR = 706 * MiB;
constexpr size_t WS_XN = 902 * MiB;
constexpr size_t WS_X1 = 210 * MiB;
constexpr size_t WS_H2 = 338 * MiB;
constexpr size_t WS_ACT = 674 * MiB;
constexpr size_t WS_YS = 402 * MiB;
constexpr size_t WS_END = 1024 * MiB;
static_assert(WS_ACT + (size_t)P_MAX * 2048 <= WS_END && WS_YS + (size_t)T * 4 * 2048 <= WS_ACT && WS_XN + (size_t)T * 2048 <= WS_END && WS_FR + (size_t)BATCH * 8 * (SEQ / 16) * 12544 <= WS_XN && WS_AO + (size_t)T * 2048 <= WS_FR, "ws map");
constexpr int CW_TMO = 0, CW_CNT = 64, CW_WQ = 128, CW_DONE5 = 192, CW_AQ = 256, CW_BAR = 4096;
constexpr int RING_OFF = 0, RING_BYTES = 147456;
constexpr int LDSCTL_OFF = RING_BYTES, MISC_OFF = LDSCTL_OFF + 320;
constexpr int HIST_OFF = LDSCTL_OFF + 512, HBASE_OFF = LDSCTL_OFF + 640, PST_OFF = LDSCTL_OFF + 768, TILE_OFF = LDSCTL_OFF + 1024;
constexpr int LDS_BYTES = 163840;
static_assert(TILE_OFF + 4 * (MAX_TILES + 32) <= LDS_BYTES, "LDS map");
struct Args {
    const float* x; const int* positions; const float* attn_norm_w; const float* w_in; const float* shift_mu;
    const float *lq1, *lk1, *lq2, *lk2; const float* subln_w;
    const float *rw_w0, *rw_w2, *rw_a0, *rw_a2, *rw_g2, *rw_k_k, *rw_k_a, *rw_r_k, *rw_lnx_w, *rw_lnx_b;
    const float* w_out; const float* ffn_norm_w; const float* router_w; const float* router_b;
    const float *mlp1_w, *mlp1_b, *mlp2_w, *mlp2_b; const float* final_norm_w;
    float* out; unsigned char* ws; int ph_lo, ph_hi;
};
struct Frame { LAS unsigned char* lds; int tid, lane, wave, vcu, G; };
__device__ __forceinline__ Frame fresh(const Frame& F) { Frame G = F; G.tid = (int)__builtin_amdgcn_workitem_id_x(); asm volatile("" : "+v"(G.tid)); G.lane = G.tid & 63; return G; }
typedef const __attribute__((address_space(4))) Args* KArgs;
__device__ __forceinline__ KArgs get_args() { unsigned long long p = (unsigned long long)__builtin_amdgcn_kernarg_segment_ptr(); asm volatile("" : "+s"(p)); return (KArgs)p; }

__device__ __forceinline__ float wave_sum(float v) {
#pragma unroll
    for (int o = 1; o < 64; o <<= 1) v += __shfl_xor(v, o);
    return v;
}
__device__ __forceinline__ float bf2f(unsigned short h) { return __builtin_bit_cast(float, (unsigned)h << 16); }
__device__ __forceinline__ float bflo(unsigned w) { return __builtin_bit_cast(float, w << 16); }
__device__ __forceinline__ float bfhi(unsigned w) { return __builtin_bit_cast(float, w & 0xffff0000u); }
__device__ __forceinline__ float sigmoidf_(float v) { return 1.0f / (1.0f + __expf(-v)); }
typedef unsigned u32x2 __attribute__((ext_vector_type(2)));
__device__ __forceinline__ unsigned cvtpk(float lo, float hi) { return attn_body::cvtpk_s(lo, hi); }
typedef float f32x16 __attribute__((ext_vector_type(16)));

struct TrItem { f32x4 v[8]; };
__device__ __forceinline__ void tr_load(TrItem& t, const float* W, int N, int item, int lane) {
    const int nblk = N / 32, kb = item / nblk, nb = item % nblk, k0 = 64 * kb, n0 = 32 * nb; const int r = lane >> 3, c4 = (lane & 7) * 4;
#pragma unroll
    for (int p = 0; p < 8; ++p) t.v[p] = *(const f32x4*)(W + (size_t)(k0 + 8 * p + r) * N + n0 + c4);
}
__device__ __forceinline__ void tr_store(const TrItem& t, int K, int N, bf16* WT, LAS float* scr, int item, int lane) {
    LAS unsigned short* T = (LAS unsigned short*)scr; constexpr int PT = 40;
    const int nblk = N / 32, kb = item / nblk, nb = item % nblk, k0 = 64 * kb, n0 = 32 * nb; const int r = lane >> 3, c4 = (lane & 7) * 4;
#pragma unroll
    for (int p = 0; p < 8; ++p) { u32x2 w; w.x = cvtpk(t.v[p][0], t.v[p][1]); w.y = cvtpk(t.v[p][2], t.v[p][3]); *(LAS u32x2*)(T + (8 * p + r) * PT + c4) = w; }
    LDS_WAIT(); asm volatile("" ::: "memory");
    const int gq = lane >> 4, i = lane & 15, q = i >> 2, p4 = (i & 3) * 4, nbk = 16 * (gq & 1);
    const attn_body::lds_cptr tb = (attn_body::lds_cptr)(T + (8 * (gq >> 1) + q) * PT + nbk + p4);
#pragma unroll
    for (int rd = 0; rd < 4; ++rd) {
        const attn_body::s16x4 lo = attn_body::vtr(tb + (16 * rd) * PT * 2), hi = attn_body::vtr(tb + (16 * rd + 4) * PT * 2);
        v4u o; o.x = __builtin_bit_cast(u32x2, lo).x; o.y = __builtin_bit_cast(u32x2, lo).y; o.z = __builtin_bit_cast(u32x2, hi).x; o.w = __builtin_bit_cast(u32x2, hi).y;
        *(GAS v4u*)(WT + (size_t)(n0 + nbk + i) * K + k0 + 16 * rd + 8 * (gq >> 1)) = o; }
    LDS_WAIT(); asm volatile("" ::: "memory");
}
__device__ __forceinline__ void p0_transpose_item(const float* W, int K, int N, bf16* WT, LAS float* scr, int item, int lane) { TrItem t; tr_load(t, W, N, item, lane); tr_store(t, K, N, WT, scr, item, lane); }
__device__ __forceinline__ void tr_store8(const TrItem& t, int K, int N, unsigned char* WT, LAS float* scr, int item, int lane, float scale) {
    constexpr int PT = 36;
    const int nblk = N / 32, kb = item / nblk, nb = item % nblk, k0 = 64 * kb, n0 = 32 * nb; const int r = lane >> 3, c4 = (lane & 7) * 4;
#pragma unroll
    for (int p = 0; p < 8; ++p) *(LAS f32x4*)(scr + (8 * p + r) * PT + c4) = t.v[p] * scale;
    LDS_WAIT(); asm volatile("" ::: "memory");
    const int n = lane & 31, kh = lane >> 5; const LAS float* col = scr + (32 * kh) * PT + n;
    v4u o[2];
#pragma unroll
    for (int q = 0; q < 8; ++q) { const unsigned w = pg8::pk_fp8x4(col[(4 * q) * PT], col[(4 * q + 1) * PT], col[(4 * q + 2) * PT], col[(4 * q + 3) * PT]);
        if ((q & 3) == 0) o[q >> 2].x = w; else if ((q & 3) == 1) o[q >> 2].y = w; else if ((q & 3) == 2) o[q >> 2].z = w; else o[q >> 2].w = w; }
    GAS v4u* dst = (GAS v4u*)(WT + (size_t)(n0 + n) * K + k0 + 32 * kh);
    dst[0] = o[0]; dst[1] = o[1];
    LDS_WAIT(); asm volatile("" ::: "memory");
}

__device__ __forceinline__ void p0_prologue(const Frame& F, KArgs A) {
    unsigned char* ws = A->ws;
    LAS float* scr = (LAS float*)(F.lds + RING_OFF + F.wave * 16384);
    const int gw = F.vcu * NWAVES + F.wave, NGW = F.G * NWAVES;
    bf16* Win_t = (bf16*)(ws + WS_WIN); bf16* Wo_t = (bf16*)(ws + WS_WO); bf16* Wl_t = (bf16*)(ws + WS_WL);
    constexpr int I_IN = (D / 64) * (IN_COLS / 32), I_O = (D / 64) * (D / 32);
    constexpr int NITEMS = I_IN + I_O;
    for (int it = gw; it < NITEMS; it += NGW) {
        int r = it;
        if (r < I_IN) { p0_transpose_item(A->w_in, D, IN_COLS, Win_t, scr, r, F.lane); continue; } r -= I_IN;
        p0_transpose_item(A->w_out, D, D, Wo_t, scr, r, F.lane);
    }
    const int gt = F.vcu * (NWAVES * 64) + F.tid, NGT = F.G * NWAVES * 64;
    for (int idx = gt; idx < 1536 * 256; idx += NGT) { const int n = idx >> 8, k = idx & 255; float v = 0.f;
        if (n < 512) { if (k < 64) v = A->rw_w2[k * 512 + n]; }
        else if (n < 1024) { if (k >= 64 && k < 128) v = A->rw_a2[(k - 64) * 512 + (n - 512)]; }
        else { if (k >= 128) v = A->rw_g2[(k - 128) * 512 + (n - 1024)]; }
        Wl_t[idx] = (bf16)f2bf(v); }
    float* RWS = (float*)(ws + WS_RWS);
    for (int idx = gt; idx < D * NEXP; idx += NGT) RWS[idx] = A->router_w[idx] * A->ffn_norm_w[idx >> 5];
    float* RGATE0 = (float*)(ws + WS_RGATE);
    int* RSRC = (int*)(ws + WS_RSRC);
    for (int idx = gt; idx < P_MAX; idx += NGT) { RGATE0[idx] = 0.f; RSRC[idx] = 0; }
    bf16* XN = (bf16*)(ws + WS_XN);
    f32x4 nw[4];
#pragma unroll
    for (int j = 0; j < 4; ++j) nw[j] = *((const f32x4*)A->attn_norm_w + F.lane + 64 * j);
    float* CS = (float*)(ws + WS_CS); const float invf_l = exp2f(-(float)(F.lane & 31) * (13.287712379549449f / 32.0f));
    for (int m = gw; m < T; m += NGW) {
        {
            const float ang = (float)A->positions[m] * invf_l; double rev = (double)ang * 0.15915494309189535; rev -= floor(rev); const float rf = (float)rev;
            CS[(size_t)m * 64 + F.lane] = F.lane < 32 ? __builtin_amdgcn_cosf(rf) : __builtin_amdgcn_sinf(rf); }
        const GAS f32x4* xr = (const GAS f32x4*)(A->x + (size_t)m * D) + F.lane;
        f32x4 v[4]; float s2 = 0.f;
#pragma unroll
        for (int j = 0; j < 4; ++j) { v[j] = xr[64 * j]; s2 += (v[j].x * v[j].x + v[j].y * v[j].y) + (v[j].z * v[j].z + v[j].w * v[j].w); }
        const float rstd = 1.f / sqrtf(wave_sum(s2) * (1.f / D) + NORM_EPS);
        GAS unsigned long long* o8 = (GAS unsigned long long*)(XN + (size_t)m * D) + F.lane;
#pragma unroll
        for (int j = 0; j < 4; ++j) o8[64 * j] = (unsigned long long)pk2(v[j].x * rstd * nw[j].x, v[j].y * rstd * nw[j].y) | ((unsigned long long)pk2(v[j].z * rstd * nw[j].z, v[j].w * rstd * nw[j].w) << 32);
    }
}

template <bool STOP> __device__ __forceinline__ void moe_weight_queue(const Frame& F, KArgs A, gu32* ctl, unsigned stop_at) {
    unsigned char* ws = A->ws;
    LAS float* scr = (LAS float*)(F.lds + RING_OFF + F.wave * 16384);
    unsigned char* W1_t = ws + WS_W1; unsigned char* W2_t = ws + WS_W2;
    constexpr int I_1E = (D / 64) * (2048 / 32), I_2E = (D / 64) * (D / 32), NITEMS = NEXP * I_1E + NEXP * I_2E, GRAB = 4;
    for (;;) {
        if (STOP) { if ((unsigned)__builtin_amdgcn_readfirstlane((int)__hip_atomic_load(ctl + CW_DONE5, __ATOMIC_RELAXED, __HIP_MEMORY_SCOPE_AGENT)) >= stop_at) break; }
        unsigned base = 0u; if (F.lane == 0) base = __hip_atomic_fetch_add(ctl + CW_WQ, (unsigned)GRAB, __ATOMIC_RELAXED, __HIP_MEMORY_SCOPE_AGENT);
        base = (unsigned)__builtin_amdgcn_readfirstlane((int)base);
        if (base >= (unsigned)NITEMS) break;
        for (int k = 0; k < GRAB; ++k) { int r = (int)base + k; if (r >= NITEMS) break;
            TrItem ti;
            if (r < NEXP * I_1E) { const int e = r / I_1E; tr_load(ti, A->mlp1_w + (size_t)e * D * 2048, 2048, r % I_1E, F.lane); tr_store8(ti, D, 2048, W1_t + (size_t)e * 2048 * D, scr, r % I_1E, F.lane, pg8::MOE_WSCALE); }
            else { r -= NEXP * I_1E; const int e = r / I_2E; tr_load(ti, A->mlp2_w + (size_t)e * D * D, D, r % I_2E, F.lane); tr_store8(ti, D, D, W2_t + (size_t)e * D * D, scr, r % I_2E, F.lane, pg8::MOE_WSCALE); } }
    }
}

__device__ __forceinline__ void moe_weight_queue_scan(const Frame& F, KArgs A, gu32* ctl, int stop_word, unsigned stop_at) {
    unsigned char* ws = A->ws;
    LAS float* scr = (LAS float*)(F.lds + RING_OFF + F.wave * 16384);
    unsigned char* W1_t = ws + WS_W1; unsigned char* W2_t = ws + WS_W2;
    constexpr int I_1E = (D / 64) * (2048 / 32), I_2E = (D / 64) * (D / 32), NITEMS = NEXP * I_1E + NEXP * I_2E, GRAB = 4;
    static_assert(I_1E % GRAB == 0 && I_2E % GRAB == 0, "a grab stays inside one expert matrix");
    for (;;) {
        if ((unsigned)__builtin_amdgcn_readfirstlane((int)__hip_atomic_load(ctl + stop_word, __ATOMIC_RELAXED, __HIP_MEMORY_SCOPE_AGENT)) >= stop_at) break;
        unsigned base = 0u; if (F.lane == 0) base = __hip_atomic_fetch_add(ctl + CW_WQ, (unsigned)GRAB, __ATOMIC_RELAXED, __HIP_MEMORY_SCOPE_AGENT);
        base = (unsigned)__builtin_amdgcn_readfirstlane((int)base);
        if (base >= (unsigned)NITEMS) break;
        const int r0 = (int)base; const bool first = r0 < NEXP * I_1E; const int rr = first ? r0 : r0 - NEXP * I_1E, ipe = first ? I_1E : I_2E, e = rr / ipe, it0 = rr % ipe, Nn = first ? 2048 : D;
        const float* Wsrc = first ? A->mlp1_w + (size_t)e * D * 2048 : A->mlp2_w + (size_t)e * D * D; unsigned char* Wdst = first ? W1_t + (size_t)e * 2048 * D : W2_t + (size_t)e * D * D;
#pragma unroll 1
        for (int k = 0; k < GRAB; k += 2) { TrItem ta, tb; tr_load(ta, Wsrc, Nn, it0 + k, F.lane); tr_load(tb, Wsrc, Nn, it0 + k + 1, F.lane);
            tr_store8(ta, D, Nn, Wdst, scr, it0 + k, F.lane, pg8::MOE_WSCALE); tr_store8(tb, D, Nn, Wdst, scr, it0 + k + 1, F.lane, pg8::MOE_WSCALE); }
    }
}

__device__ __forceinline__ void p2_prep(const Frame& F, KArgs A) {
    unsigned char* ws = A->ws;
    bf16* PB = (bf16*)(ws + WS_PB); bf16* LA = (bf16*)(ws + WS_XN);
    const int gw = F.vcu * NWAVES + F.wave, NGW = F.G * NWAVES, lane = F.lane;
    for (int t = gw; t < T; t += NGW) {
        const int s = t & (SEQ - 1);
        bf16* row = PB + (size_t)t * IN_COLS;
        {
            const int c4 = lane * 4; const bf16* pc = row + RW_OFF + 1536 + c4;
            const u32x2 cu = *(const u32x2*)pc; u32x2 pu = *(const u32x2*)(pc - (s > 0 ? IN_COLS : 0)); pu.x = s > 0 ? pu.x : 0u; pu.y = s > 0 ? pu.y : 0u;
            const f32x4 mu = *(const f32x4*)(A->shift_mu + 1536 + c4);
            const float cur[4] = {bflo(cu.x), bfhi(cu.x), bflo(cu.y), bfhi(cu.y)}, prv[4] = {bflo(pu.x), bfhi(pu.x), bflo(pu.y), bfhi(pu.y)};
            f32x4 v, o;
#pragma unroll
            for (int i = 0; i < 4; ++i) v[i] = cur[i] + mu[i] * (prv[i] - cur[i]);
            if (c4 < 64) { for (int i = 0; i < 4; ++i) { const float e2 = __expf(2.0f * v[i]); o[i] = 1.0f - 2.0f * __builtin_amdgcn_rcpf(e2 + 1.0f); } }
            else if (c4 < 128) o = v;
            else { for (int i = 0; i < 4; ++i) o[i] = __builtin_amdgcn_rcpf(1.0f + __expf(-v[i])); }
            u32x2 w; w.x = pk2(o[0], o[1]); w.y = pk2(o[2], o[3]);
            *(u32x2*)(LA + (size_t)t * 256 + c4) = w;
        }
    }
}

constexpr int FR_KA = 0, FR_RT = 2048, FR_AU = 4096, FR_AY = 5120, FR_AS = 6144, FR_VT = 10240, FR_GC = 12288, FR_BYTES = 12544, NCHUNK = SEQ / 16;
#define SC_MFMA(a, b, c) __builtin_amdgcn_mfma_f32_16x16x32_bf16(__builtin_bit_cast(bf16x8, a), __builtin_bit_cast(bf16x8, b), c, 0, 0, 0)
template <int CTRL> __device__ __forceinline__ float dpp_f(float v) { return __builtin_bit_cast(float, __builtin_amdgcn_update_dpp(0, __builtin_bit_cast(int, v), CTRL, 0xF, 0xF, true)); }
__device__ __forceinline__ f32x4 mm16(const f32x4& XT, const f32x4& Y) {
    f32x4 o = {0.f, 0.f, 0.f, 0.f};
#pragma unroll
    for (int s = 0; s < 4; ++s) o = __builtin_amdgcn_mfma_f32_16x16x4f32(XT[s], Y[s], o, 0, 0, 0);
    return o;
}
__device__ __forceinline__ v4u pack8(const float* x) { v4u o; o.x = cvtpk(x[0], x[1]); o.y = cvtpk(x[2], x[3]); o.z = cvtpk(x[4], x[5]); o.w = cvtpk(x[6], x[7]); return o; }
__device__ __forceinline__ f32x4 shift4(const bf16* pc, bool has_prev, const float* mu) {
    const u32x2 cu = *(const u32x2*)pc; u32x2 pu = *(const u32x2*)(pc - (has_prev ? IN_COLS : 0));
    pu.x = has_prev ? pu.x : 0u; pu.y = has_prev ? pu.y : 0u;
    const f32x4 m = *(const f32x4*)mu;
    const float cur[4] = {bflo(cu.x), bfhi(cu.x), bflo(cu.y), bfhi(cu.y)}, prv[4] = {bflo(pu.x), bfhi(pu.x), bflo(pu.y), bfhi(pu.y)};
    f32x4 v;
#pragma unroll
    for (int i = 0; i < 4; ++i) v[i] = cur[i] + m[i] * (prv[i] - cur[i]);
    return v;
}
struct PrepRaw { v4u lab[8]; u32x2 rc[4], rp[4], kc[4], kp[4], vc[4], vp[4]; };
__device__ __forceinline__ void prep_load_la(PrepRaw& R, const bf16* LA, int ci, int i, int g) {
    const int bh = ci / NCHUNK, chk = ci % NCHUNK, b = bh >> 3;
    const bf16* pla = LA + ((size_t)b * SEQ + chk * 16 + i) * 256 + 8 * g;
#pragma unroll
    for (int sx = 0; sx < 8; ++sx) R.lab[sx] = *(const v4u*)(pla + 32 * sx);
}
__device__ __forceinline__ void prep_load_rkv(PrepRaw& R, const bf16* PB, int ci, int i, int g) {
    const int bh = ci / NCHUNK, chk = ci % NCHUNK, b = bh >> 3, h = bh & 7;
    const size_t t = (size_t)b * SEQ + chk * 16 + i; const bool hp = (chk * 16 + i) > 0;
    const bf16* prow = PB + t * IN_COLS + RW_OFF + h * 64 + 4 * g; const bf16* pprev = prow - (hp ? IN_COLS : 0);
#pragma unroll
    for (int q = 0; q < 4; ++q) {
        R.rc[q] = *(const u32x2*)(prow + 16 * q); R.rp[q] = *(const u32x2*)(pprev + 16 * q);
        R.kc[q] = *(const u32x2*)(prow + 512 + 16 * q); R.kp[q] = *(const u32x2*)(pprev + 512 + 16 * q);
        R.vc[q] = *(const u32x2*)(prow + 1024 + 16 * q); R.vp[q] = *(const u32x2*)(pprev + 1024 + 16 * q); }
}
__device__ __forceinline__ f32x4 shiftr(const u32x2 cu, u32x2 pu, bool hp, const f32x4 m) {
    pu.x = hp ? pu.x : 0u; pu.y = hp ? pu.y : 0u;
    const float cur[4] = {bflo(cu.x), bfhi(cu.x), bflo(cu.y), bfhi(cu.y)}, prv[4] = {bflo(pu.x), bfhi(pu.x), bflo(pu.y), bfhi(pu.y)};
    f32x4 v;
#pragma unroll
    for (int k = 0; k < 4; ++k) v[k] = cur[k] + m[k] * (prv[k] - cur[k]);
    return v;
}
__device__ __forceinline__ void prep_body(PrepRaw& R, int ci, int ci_next, const bf16* LA, const bf16* PB, bf16* LG, const LAS unsigned char* WLF, int lane_in, LAS unsigned short* TB, const LAS float* CST, float* BS, unsigned char* FR) {
    int lane = lane_in; asm volatile("" : "+v"(lane));
    const int i = lane & 15, g = lane >> 4;
    LAS unsigned short* TK = TB + 1024; LAS unsigned short* TV = TB + 2048;
    {
        const int bh = ci / NCHUNK, chk = ci % NCHUNK, b = bh >> 3, h = bh & 7;
        const size_t t0 = (size_t)b * SEQ + chk * 16, t = t0 + i;
        const bool hp = (chk * 16 + i) > 0;
        float nlw[16], av[16], kkv[16], km[16], rr[16], vs[16]; float ss = 0.f, bsum = 0.f;
#pragma unroll
        for (int q = 0; q < 4; ++q) {
            const LAS f32x4* cq = (const LAS f32x4*)(CST + 16 * q + 4 * g);
            const f32x4 r4 = shiftr(R.rc[q], R.rp[q], hp, cq[0]), ks4 = shiftr(R.kc[q], R.kp[q], hp, cq[16]), v4 = shiftr(R.vc[q], R.vp[q], hp, cq[32]);
            const f32x4 w04 = cq[48], a04 = cq[64], kk4 = cq[80], ka4 = cq[96], rk4 = cq[112];
            const LAS v4u* wq = (const LAS v4u*)(WLF + (q * 8) * 1024) + lane; const f32x4 zl = {0.f, 0.f, 0.f, 0.f};
            const f32x4 lw = SC_MFMA(wq[64], R.lab[1], SC_MFMA(wq[0], R.lab[0], zl)), la = SC_MFMA(wq[192], R.lab[3], SC_MFMA(wq[128], R.lab[2], zl));
            const f32x4 gg = SC_MFMA(wq[448], R.lab[7], SC_MFMA(wq[384], R.lab[6], SC_MFMA(wq[320], R.lab[5], SC_MFMA(wq[256], R.lab[4], zl))));
            { u32x2 go; go.x = cvtpk(gg[0], gg[1]); go.y = cvtpk(gg[2], gg[3]); *(u32x2*)(LG + t * RWW + h * 64 + 16 * q + 4 * g) = go; }
#pragma unroll
            for (int j = 0; j < 4; ++j) { const int x = q * 4 + j;
                const float u = fminf(-(w04[j] + lw[j]), 60.f);
                nlw[x] = -0.6065306597126334f * __builtin_amdgcn_rcpf(1.0f + __expf(u));
                av[x] = __builtin_amdgcn_rcpf(1.0f + __expf(-(a04[j] + la[j])));
                kkv[x] = ks4[j] * kk4[j]; ss += kkv[x] * kkv[x];
                km[x] = ks4[j] * (1.0f + (av[x] - 1.0f) * ka4[j]);
                rr[x] = r4[j]; vs[x] = v4[j]; bsum += r4[j] * km[x] * rk4[j]; }
        }
        ss += __shfl_xor(ss, 16); ss += __shfl_xor(ss, 32); bsum += __shfl_xor(bsum, 16); bsum += __shfl_xor(bsum, 32);
        const float rn = fminf(__builtin_amdgcn_rsqf(ss), 1e12f);
        if (g == 0) BS[t * 8 + h] = bsum;
        float Ka[16], Bt[16], Kt[16], Rt[16], gam[16];
#pragma unroll
        for (int x = 0; x < 16; ++x) {
            float c = nlw[x];
            c += dpp_f<0x111>(c); c += dpp_f<0x112>(c); c += dpp_f<0x114>(c); c += dpp_f<0x118>(c);
            const float gm = __expf(c), ig = __builtin_amdgcn_rcpf(gm), kk = kkv[x] * rn; float gm1 = dpp_f<0x111>(gm); gm1 = i == 0 ? 1.0f : gm1;
            gam[x] = gm; Ka[x] = gm1 * kk; Bt[x] = kk * av[x] * ig; Kt[x] = km[x] * ig; Rt[x] = gm * rr[x];
        }
        const v4u pKa0 = pack8(Ka), pKa1 = pack8(Ka + 8), pRt0 = pack8(Rt), pRt1 = pack8(Rt + 8), pBt0 = pack8(Bt), pBt1 = pack8(Bt + 8), pKt0 = pack8(Kt), pKt1 = pack8(Kt + 8);
#pragma unroll
        for (int x = 0; x < 16; ++x) { const int k = 16 * (x >> 2) + 4 * g + (x & 3); const unsigned bk = cvtpk(Bt[x], Kt[x]), vv = cvtpk(vs[x], 0.f);
            TB[k * 16 + i] = (unsigned short)bk; TK[k * 16 + i] = (unsigned short)(bk >> 16); TV[k * 16 + i] = (unsigned short)vv; }
        if (ci_next >= 0) prep_load_rkv(R, PB, ci_next, i, g);
        const f32x4 z4 = {0.f, 0.f, 0.f, 0.f};
        f32x4 N = SC_MFMA(pBt1, pKa1, SC_MFMA(pBt0, pKa0, z4)), NT = SC_MFMA(pKa1, pBt1, SC_MFMA(pKa0, pBt0, z4)), MkT = SC_MFMA(pKa1, pKt1, SC_MFMA(pKa0, pKt0, z4));
        f32x4 Rb = SC_MFMA(pBt1, pRt1, SC_MFMA(pBt0, pRt0, z4)), Rk = SC_MFMA(pKt1, pRt1, SC_MFMA(pKt0, pRt0, z4));
        f32x4 I1, IN2T, IN4T, IN8;
#pragma unroll
        for (int r = 0; r < 4; ++r) { const int row = 4 * g + r; I1[r] = row == i ? 1.f : 0.f;
            N[r] = row < i ? N[r] : 0.f; NT[r] = i < row ? NT[r] : 0.f; MkT[r] = i < row ? MkT[r] : 0.f; Rb[r] = row <= i ? Rb[r] : 0.f; Rk[r] = row <= i ? Rk[r] : 0.f; }
        const f32x4 N2 = mm16(NT, N), N2T = mm16(N, NT), N4 = mm16(N2T, N2), N4T = mm16(N2, N2T), N8 = mm16(N4T, N4);
        IN2T = I1 + N2T; IN4T = I1 + N4T; IN8 = I1 + N8;
        const f32x4 H1 = mm16(IN4T, IN8), H2 = mm16(IN2T, H1); const f32x4 F1T = I1 - NT; const f32x4 Tinv = mm16(F1T, H2), Wm = mm16(MkT, Tinv);
        unsigned char* fb = FR + (size_t)ci * FR_BYTES + lane * 16;
        *(v4u*)(fb + FR_KA) = pKa0; *(v4u*)(fb + FR_KA + 1024) = pKa1;
        *(v4u*)(fb + FR_RT) = pRt0; *(v4u*)(fb + FR_RT + 1024) = pRt1;
        { const float au[8] = {-Tinv[0], -Tinv[1], -Tinv[2], -Tinv[3], -Wm[0], -Wm[1], -Wm[2], -Wm[3]}; *(v4u*)(fb + FR_AU) = pack8(au);
          const float ay[8] = {Rb[0], Rb[1], Rb[2], Rb[3], Rk[0], Rk[1], Rk[2], Rk[3]}; *(v4u*)(fb + FR_AY) = pack8(ay); }
        if (ci_next >= 0) prep_load_la(R, LA, ci_next, i, g);
        LDS_WAIT(); asm volatile("" ::: "memory");
#pragma unroll
        for (int i4 = 0; i4 < 4; ++i4) { const u32x2 bq = *(const LAS u32x2*)(TB + (16 * i4 + i) * 16 + 4 * g), kq = *(const LAS u32x2*)(TK + (16 * i4 + i) * 16 + 4 * g);
            v4u o; o.x = bq.x; o.y = bq.y; o.z = kq.x; o.w = kq.y; *(v4u*)(fb + FR_AS + i4 * 1024) = o;
            const u32x2 vq = *(const LAS u32x2*)(TV + (16 * i4 + i) * 16 + 4 * g);
            *(u32x2*)(FR + (size_t)ci * FR_BYTES + FR_VT + i4 * 512 + lane * 8) = vq; }
        LDS_WAIT(); asm volatile("" ::: "memory");
        if (i == 15) { float* gc = (float*)(FR + (size_t)ci * FR_BYTES + FR_GC) + g * 16;
#pragma unroll
            for (int q = 0; q < 4; ++q) *(f32x4*)(gc + 4 * q) = (f32x4){gam[4 * q], gam[4 * q + 1], gam[4 * q + 2], gam[4 * q + 3]}; }
    }
}
__device__ __forceinline__ void p4_chunk_prep(const Frame& F, KArgs A) {
    unsigned char* ws = A->ws;
    const bf16* LA = (const bf16*)(ws + WS_XN); const bf16* PB = (const bf16*)(ws + WS_PB); bf16* LG = (bf16*)(ws + WS_LG); const bf16* Wl_t = (const bf16*)(ws + WS_WL);
    float* BS = (float*)(ws + WS_BS); unsigned char* FR = ws + WS_FR;
    const int gw = F.vcu * NWAVES + F.wave, lane = F.lane, i = lane & 15, g = lane >> 4;
    LAS unsigned short* TB = (LAS unsigned short*)(F.lds + RING_OFF + F.wave * 8192); LAS float* CST = (LAS float*)(TB + 3072);
    LAS unsigned char* WLF = F.lds + RING_OFF + 65536;
    constexpr int CPW = (BATCH * 8 * NCHUNK) / (256 * NWAVES);
    static_assert(CPW == 8 && NCHUNK % (CPW * NWAVES) == 0, "a workgroup's chunks share one head");
    const int ci0 = gw * CPW;
    { const int h = ((F.vcu * NWAVES * CPW) / NCHUNK) & 7;
#pragma unroll
      for (int k = 0; k < 4; ++k) { const int e = F.tid + 512 * k, q = e >> 9, sx = (e >> 6) & 7, l = e & 63;
          const int n = (sx < 2 ? 0 : sx < 4 ? 512 : 1024) + h * 64 + 16 * q + (l & 15);
          *(LAS v4u*)(WLF + (size_t)e * 16) = *(const v4u*)(Wl_t + (size_t)n * 256 + 32 * sx + 8 * (l >> 4)); }
      const int c = h * 64 + lane;
      CST[lane] = A->shift_mu[c]; CST[64 + lane] = A->shift_mu[512 + c]; CST[128 + lane] = A->shift_mu[1024 + c];
      CST[192 + lane] = A->rw_w0[c]; CST[256 + lane] = A->rw_a0[c]; CST[320 + lane] = A->rw_k_k[c]; CST[384 + lane] = A->rw_k_a[c]; CST[448 + lane] = A->rw_r_k[c];
      __syncthreads(); }
    if (ci0 >= BATCH * 8 * NCHUNK) return;
    PrepRaw ra;
    prep_load_la(ra, LA, ci0, i, g); prep_load_rkv(ra, PB, ci0, i, g);
#pragma unroll 1
    for (int cj = 0; cj < CPW; ++cj) prep_body(ra, ci0 + cj, cj + 1 < CPW ? ci0 + cj + 1 : -1, LA, PB, LG, WLF, lane, TB, CST, BS, FR);
}

__device__ __forceinline__ void scan_phase3(const Frame& F, KArgs A, int bh) {
    constexpr int GRP = 4, NGRP = NCHUNK / GRP, SLOT = 13312, FBUF = GRP * SLOT, YOFF = 2 * FBUF, YBUF = GRP * 16 * 64 * 4;
    static_assert(YOFF + 2 * YBUF <= RING_BYTES, "scan rings fit the LDS ring region");
    LAS unsigned char* L = F.lds + RING_OFF;
    const unsigned char* fr = A->ws + WS_FR + (size_t)bh * NCHUNK * FR_BYTES;
    const int lane = F.lane, b = bh >> 3, h = bh & 7;
    if (F.wave >= 4) {
        const int io = F.wave - 4;
        bf16* yb = (bf16*)(A->ws + WS_YB) + (size_t)b * SEQ * RWW + h * 64;
#define SC_ISSUE(n) do { const unsigned char* src_ = fr + (size_t)(n) * GRP * FR_BYTES + lane * 16; const int bo_ = ((n) & 1) * FBUF; \
        _Pragma("unroll") for (int k_ = 0; k_ < 13; ++k_) { const int p_ = io + 4 * k_, ci_ = p_ / 13, pc_ = p_ % 13; \
            __builtin_amdgcn_global_load_lds((const unsigned*)(src_ + (size_t)ci_ * FR_BYTES + pc_ * 1024), (LAS unsigned*)(L + bo_ + ci_ * SLOT + pc_ * 1024), 16, 0, 0); } } while (0)
#define SC_YOUT(n) do { const LAS float* ys_ = (const LAS float*)(L + YOFF + ((n) & 1) * YBUF); \
        _Pragma("unroll") for (int k_ = 0; k_ < 4; ++k_) { const int i4_ = io * 64 + lane + 256 * k_, ci_ = i4_ >> 8, t_ = (i4_ >> 4) & 15, v4_ = i4_ & 15; \
            const f32x4 y_ = *(const LAS f32x4*)(ys_ + i4_ * 4); u32x2 w_; w_.x = cvtpk(y_[0], y_[1]); w_.y = cvtpk(y_[2], y_[3]); *(u32x2*)(yb + ((size_t)((n) * GRP + ci_) * 16 + t_) * RWW + v4_ * 4) = w_; } } while (0)
        SC_ISSUE(0);
        __syncthreads();
        for (int n = 0; n < NGRP; ++n) {
            if (n + 1 < NGRP) SC_ISSUE(n + 1);
            if (n > 0) SC_YOUT(n - 1);
            __syncthreads();
        }
        SC_YOUT(NGRP - 1);
#undef SC_ISSUE
#undef SC_YOUT
    } else {
        const int wv = F.wave, vl = lane & 15, g = lane >> 4;
        f32x4 s0 = {0.f, 0.f, 0.f, 0.f}, s1 = s0, s2 = s0, s3 = s0; const f32x4 zero = {0.f, 0.f, 0.f, 0.f};
        __syncthreads();
        for (int n = 0; n < NGRP; ++n) {
            const LAS unsigned char* fbuf = L + (n & 1) * FBUF; LAS float* ybuf = (LAS float*)(L + YOFF + (n & 1) * YBUF) + (4 * g) * 64 + 16 * wv + vl;
#pragma unroll
            for (int ci = 0; ci < GRP; ++ci) {
                const LAS unsigned char* p = fbuf + ci * SLOT; const LAS unsigned char* q = p + lane * 16;
                const v4u ka0 = *(const LAS v4u*)(q + FR_KA), ka1 = *(const LAS v4u*)(q + FR_KA + 1024), rt0 = *(const LAS v4u*)(q + FR_RT), rt1 = *(const LAS v4u*)(q + FR_RT + 1024);
                const v4u au = *(const LAS v4u*)(q + FR_AU), ay = *(const LAS v4u*)(q + FR_AY);
                const v4u as0 = *(const LAS v4u*)(q + FR_AS), as1 = *(const LAS v4u*)(q + FR_AS + 1024), as2 = *(const LAS v4u*)(q + FR_AS + 2048), as3 = *(const LAS v4u*)(q + FR_AS + 3072);
                const LAS f32x4* gc = (const LAS f32x4*)(p + FR_GC) + g * 4; const f32x4 gc0 = gc[0], gc1 = gc[1], gc2 = gc[2], gc3 = gc[3];
                const u32x2 vt = *(const LAS u32x2*)(p + FR_VT + wv * 512 + lane * 8);
                v4u bS0, bS1; bS0.x = cvtpk(s0[0], s0[1]); bS0.y = cvtpk(s0[2], s0[3]); bS0.z = cvtpk(s1[0], s1[1]); bS0.w = cvtpk(s1[2], s1[3]);
                bS1.x = cvtpk(s2[0], s2[1]); bS1.y = cvtpk(s2[2], s2[3]); bS1.z = cvtpk(s3[0], s3[1]); bS1.w = cvtpk(s3[2], s3[3]);
                f32x4 PT = SC_MFMA(ka0, bS0, zero); PT = SC_MFMA(ka1, bS1, PT);
                f32x4 YT = SC_MFMA(rt0, bS0, zero); YT = SC_MFMA(rt1, bS1, YT);
                v4u bU; bU.x = cvtpk(PT[0], PT[1]); bU.y = cvtpk(PT[2], PT[3]); bU.z = vt.x; bU.w = vt.y;
                const f32x4 UT = SC_MFMA(au, bU, zero);
                bU.x = cvtpk(UT[0], UT[1]); bU.y = cvtpk(UT[2], UT[3]);
                YT = SC_MFMA(ay, bU, YT);
                s0 = SC_MFMA(as0, bU, s0) * gc0; s1 = SC_MFMA(as1, bU, s1) * gc1; s2 = SC_MFMA(as2, bU, s2) * gc2; s3 = SC_MFMA(as3, bU, s3) * gc3;
                LAS float* yo = ybuf + ci * 1024;
                yo[0] = YT[0]; yo[64] = YT[1]; yo[128] = YT[2]; yo[192] = YT[3];
            }
            __syncthreads();
        }
    }
    __syncthreads();
}

__device__ __forceinline__ void attn_queue(const Frame& F, KArgs A, gu32* ctl) {
    const attn_body::bf16* PB = (const attn_body::bf16*)(A->ws + WS_PB); attn_body::bf16* OA = (attn_body::bf16*)(A->ws + WS_XN);
    char* shm = (char*)(F.lds + RING_OFF);
    volatile LAS unsigned* slot = (volatile LAS unsigned*)(F.lds + MISC_OFF) + 16;
    const int x = (int)(blockIdx.x & 7);
    for (;;) {
        if (F.tid == 0) slot[0] = __hip_atomic_fetch_add(ctl + CW_AQ + 64 * x, 1u, __ATOMIC_RELAXED, __HIP_MEMORY_SCOPE_AGENT);
        __syncthreads();
        const int u = __builtin_amdgcn_readfirstlane((int)slot[0]);
        __syncthreads();
        if (u >= 128) break;
        int cb = x + 8 * (u & 3); asm volatile("" : "+s"(cb));
        const int qb = 31 - (u >> 2), b = cb >> 3, h = (cb >> 1) & 3, c = cb & 1;
        const attn_body::bf16* Q = PB + h * 128 + c * 64; const attn_body::bf16* K = PB + 512 + h * 128 + c * 64; const attn_body::bf16* V = PB + 1024 + h * 128;
        attn_body::attn_unit128<8>(b, qb, Q, K, V, OA + h * 256 + c * 128, shm);
    }
}

__device__ __forceinline__ void p6_combine(const Frame& F, KArgs A) {
    unsigned char* ws = A->ws;
    const bf16* OA = (const bf16*)(ws + WS_XN); const bf16* YB = (const bf16*)(ws + WS_YB); const bf16* LG = (const bf16*)(ws + WS_LG);
    const bf16* PB = (const bf16*)(ws + WS_PB); const float* BS = (const float*)(ws + WS_BS);
    bf16* AO = (bf16*)(ws + WS_AO);
    const int gw = F.vcu * NWAVES + F.wave, NGW = F.G * NWAVES, lane = F.lane;
    const float lam = __expf(wave_sum(A->lq1[lane] * A->lk1[lane])) - __expf(wave_sum(A->lq2[lane] * A->lk2[lane])) + LAM_INIT;
    const int hd = lane >> 4, dv = (lane & 15) * 8, c8 = lane * 8, hr = lane >> 3;
    float sw[8], lw[8], lb[8];
#pragma unroll
    for (int i = 0; i < 8; ++i) { sw[i] = A->subln_w[dv + i] * (1.0f - LAM_INIT); lw[i] = A->rw_lnx_w[c8 + i]; lb[i] = A->rw_lnx_b[c8 + i]; }
    for (int t = gw; t < T; t += NGW) {
        const v4u p0 = *(const v4u*)(OA + (size_t)t * 1024 + hd * 256 + dv), p1 = *(const v4u*)(OA + (size_t)t * 1024 + hd * 256 + 128 + dv);
        const float o0[8] = {bflo(p0.x), bfhi(p0.x), bflo(p0.y), bfhi(p0.y), bflo(p0.z), bfhi(p0.z), bflo(p0.w), bfhi(p0.w)};
        const float o1[8] = {bflo(p1.x), bfhi(p1.x), bflo(p1.y), bfhi(p1.y), bflo(p1.z), bfhi(p1.z), bflo(p1.w), bfhi(p1.w)};
        float d[8]; float ss = 0.f;
#pragma unroll
        for (int i = 0; i < 8; ++i) { d[i] = o0[i] - lam * o1[i]; ss += d[i] * d[i]; }
        ss += __shfl_xor(ss, 1); ss += __shfl_xor(ss, 2); ss += __shfl_xor(ss, 4); ss += __shfl_xor(ss, 8);
        const float rs = 1.0f / sqrtf(ss * (1.0f / 128.0f) + NORM_EPS);
        v4u w; w.x = pk2(d[0] * rs * sw[0], d[1] * rs * sw[1]); w.y = pk2(d[2] * rs * sw[2], d[3] * rs * sw[3]); w.z = pk2(d[4] * rs * sw[4], d[5] * rs * sw[5]); w.w = pk2(d[6] * rs * sw[6], d[7] * rs * sw[7]);
        *(v4u*)(AO + (size_t)t * 1024 + hd * 128 + dv) = w;
        const size_t o = (size_t)t * RWW + c8;
        const v4u yp = *(const v4u*)(YB + o); const f32x4 y0 = {bflo(yp.x), bfhi(yp.x), bflo(yp.y), bfhi(yp.y)}, y1 = {bflo(yp.z), bfhi(yp.z), bflo(yp.w), bfhi(yp.w)};
        const bf16* pv = PB + (size_t)t * IN_COLS + RW_OFF + 1024 + c8; const bool hp = (t & (SEQ - 1)) > 0;
        const f32x4 v0 = shift4(pv, hp, A->shift_mu + 1024 + c8), v1 = shift4(pv + 4, hp, A->shift_mu + 1024 + c8 + 4);
        const v4u gp = *(const v4u*)(LG + o);
        const float g[8] = {bflo(gp.x), bfhi(gp.x), bflo(gp.y), bfhi(gp.y), bflo(gp.z), bfhi(gp.z), bflo(gp.w), bfhi(gp.w)};
        const float y[8] = {y0[0], y0[1], y0[2], y0[3], y1[0], y1[1], y1[2], y1[3]}, vv[8] = {v0[0], v0[1], v0[2], v0[3], v1[0], v1[1], v1[2], v1[3]};
        float sm = 0.f;
#pragma unroll
        for (int i = 0; i < 8; ++i) sm += y[i];
        sm += __shfl_xor(sm, 1); sm += __shfl_xor(sm, 2); sm += __shfl_xor(sm, 4);
        const float mean = sm * (1.0f / 64.0f); float sq = 0.f;
#pragma unroll
        for (int i = 0; i < 8; ++i) { const float dd = y[i] - mean; sq += dd * dd; }
        sq += __shfl_xor(sq, 1); sq += __shfl_xor(sq, 2); sq += __shfl_xor(sq, 4);
        const float rg = 1.0f / sqrtf(sq * (1.0f / 64.0f) + GN_EPS), bsc = BS[(size_t)t * 8 + hr];
        float r[8];
#pragma unroll
        for (int i = 0; i < 8; ++i) r[i] = ((y[i] - mean) * rg * lw[i] + lb[i] + bsc * vv[i]) * g[i];
        w.x = pk2(r[0], r[1]); w.y = pk2(r[2], r[3]); w.z = pk2(r[4], r[5]); w.w = pk2(r[6], r[7]);
        *(v4u*)(AO + (size_t)t * 1024 + 512 + c8) = w;
    }
}

__device__ __forceinline__ void p8_router(const Frame& F, KArgs A, gu32* ctl) {
    unsigned char* ws = A->ws;
    const float* X1 = (const float*)(ws + WS_X1); const float* RWS = (const float*)(ws + WS_RWS); unsigned char* H2 = ws + WS_H2;
    int* TOPI = (int*)(ws + WS_TOPI); int* POS = (int*)(ws + WS_POS); float* GATE = (float*)(ws + WS_GATE);
    LAS int* hist = (LAS int*)(F.lds + HIST_OFF); LAS int* hbase = (LAS int*)(F.lds + HBASE_OFF);
    const int lane = F.lane, tile = F.wave * F.G + F.vcu;
    const bool has = tile < T / 32;
    const int r0 = tile * 32, hi = lane >> 5, l31 = lane & 31;
    int sel[4] = {0, 0, 0, 0}, lr[4] = {0, 0, 0, 0}; float gate[4] = {0.f, 0.f, 0.f, 0.f}; float rstd = 0.f;
    if (has) {
        f32x16 acc;
#pragma unroll
        for (int r = 0; r < 16; ++r) acc[r] = 0.f;
        float ssq = 0.f;
        const float* xa = X1 + (size_t)(r0 + l31) * D + 4 * hi; const float* wb = RWS + hi * 128 + l31;
        f32x4 aA[8], aB[8]; float bA[8][4], bB[8][4];
#define P8_LOAD(AS, BS, grp) do { _Pragma("unroll") for (int mm = 0; mm < 8; ++mm) { const int m = (grp) * 8 + mm; AS[mm] = *(const f32x4*)(xa + 8 * m); \
            BS[mm][0] = wb[(8 * m) * 32]; BS[mm][1] = wb[(8 * m + 1) * 32]; BS[mm][2] = wb[(8 * m + 2) * 32]; BS[mm][3] = wb[(8 * m + 3) * 32]; } } while (0)
#define P8_COMP(AS, BS) do { _Pragma("unroll") for (int mm = 0; mm < 8; ++mm) { const f32x4 a = AS[mm]; ssq += (a[0] * a[0] + a[1] * a[1]) + (a[2] * a[2] + a[3] * a[3]); \
            acc = __builtin_amdgcn_mfma_f32_32x32x2f32(a[0], BS[mm][0], acc, 0, 0, 0); acc = __builtin_amdgcn_mfma_f32_32x32x2f32(a[1], BS[mm][1], acc, 0, 0, 0); \
            acc = __builtin_amdgcn_mfma_f32_32x32x2f32(a[2], BS[mm][2], acc, 0, 0, 0); acc = __builtin_amdgcn_mfma_f32_32x32x2f32(a[3], BS[mm][3], acc, 0, 0, 0); } } while (0)
        P8_LOAD(aA, bA, 0);
        for (int gp = 0; gp < 16; gp += 2) {
            P8_LOAD(aB, bB, gp + 1);
            P8_COMP(aA, bA);
            if (gp + 2 < 16) P8_LOAD(aA, bA, gp + 2);
            P8_COMP(aB, bB);
        }
#undef P8_LOAD
#undef P8_COMP
        ssq += __shfl_xor(ssq, 32);
        rstd = 1.0f / sqrtf(ssq * (1.0f / D) + NORM_EPS);
        LAS float* Lw = (LAS float*)(F.lds + RING_OFF + F.wave * 16384 + 8704);
#pragma unroll
        for (int r = 0; r < 16; ++r) Lw[((r & 3) + 8 * (r >> 2) + 4 * hi) * 36 + l31] = acc[r];
        LDS_WAIT(); asm volatile("" ::: "memory");
        if (lane < 32) {
            float val[32];
#pragma unroll
            for (int j = 0; j < 8; ++j) { const f32x4 q = *(const LAS f32x4*)(Lw + lane * 36 + 4 * j); const f32x4 bb = *(const f32x4*)(A->router_b + 4 * j);
                val[4 * j] = q[0] * rstd + bb[0]; val[4 * j + 1] = q[1] * rstd + bb[1]; val[4 * j + 2] = q[2] * rstd + bb[2]; val[4 * j + 3] = q[3] * rstd + bb[3]; }
            unsigned used = 0u; float sv[4];
#pragma unroll
            for (int s = 0; s < 4; ++s) { float best = -INFINITY; int bi = 0;
#pragma unroll
                for (int e = 0; e < 32; ++e) { const bool ok = (((used >> e) & 1u) == 0u) && (val[e] > best); best = ok ? val[e] : best; bi = ok ? e : bi; }
                used |= 1u << bi; sel[s] = bi; sv[s] = best; }
            float ex[4], se = 0.f;
#pragma unroll
            for (int s = 0; s < 4; ++s) { ex[s] = __expf(sv[s] - sv[0]); se += ex[s]; }
            const float inv = 1.0f / se;
#pragma unroll
            for (int s = 0; s < 4; ++s) { gate[s] = ex[s] * inv; lr[s] = __hip_atomic_fetch_add(hist + sel[s], 1, __ATOMIC_RELAXED, __HIP_MEMORY_SCOPE_WORKGROUP); }
        }
    }
    __syncthreads();
    if (F.tid < NEXP) hbase[F.tid] = (int)__hip_atomic_fetch_add(ctl + CW_CNT + F.tid, (unsigned)hist[F.tid], __ATOMIC_RELAXED, __HIP_MEMORY_SCOPE_AGENT);
    __syncthreads();
    if (has) {
        if (lane < 32) { const size_t t4 = (size_t)(r0 + lane) * 4;
#pragma unroll
            for (int s = 0; s < 4; ++s) { TOPI[t4 + s] = sel[s]; POS[t4 + s] = hbase[sel[s]] + lr[s]; GATE[t4 + s] = gate[s]; } }
        f32x4 nw[4];
#pragma unroll
        for (int j = 0; j < 4; ++j) nw[j] = *((const f32x4*)A->ffn_norm_w + lane + 64 * j);
        for (int r4 = 0; r4 < 32; r4 += 4) {
            f32x4 v[4][4];
#pragma unroll
            for (int q = 0; q < 4; ++q) { const f32x4* xr = (const f32x4*)(X1 + (size_t)(r0 + r4 + q) * D) + lane;
#pragma unroll
                for (int j = 0; j < 4; ++j) v[q][j] = xr[64 * j]; }
#pragma unroll
            for (int q = 0; q < 4; ++q) {
                const float rs = __builtin_bit_cast(float, __builtin_amdgcn_readlane(__builtin_bit_cast(int, rstd), r4 + q));
                unsigned* o4 = (unsigned*)(H2 + (size_t)(r0 + r4 + q) * D) + lane;
#pragma unroll
                for (int j = 0; j < 4; ++j) o4[64 * j] = pg8::pk_fp8x4(v[q][j][0] * rs * nw[j][0], v[q][j][1] * rs * nw[j][1], v[q][j][2] * rs * nw[j][2], v[q][j][3] * rs * nw[j][3]);
            }
        }
    }
}

__device__ __forceinline__ void moe_tables(const Frame& F, gu32* ctl) {
    LAS int* pst = (LAS int*)(F.lds + PST_OFF); LAS int* te = (LAS int*)(F.lds + TILE_OFF);
    __syncthreads();
    if (F.tid == 0) { int acc = 0;
        for (int e = 0; e < NEXP; ++e) { pst[e] = acc; const int c = (int)__hip_atomic_load(ctl + CW_CNT + e, __ATOMIC_RELAXED, __HIP_MEMORY_SCOPE_AGENT); acc += ((c + 255) >> 8) << 8; }
        pst[32] = acc; pst[33] = acc >> 8; }
    __syncthreads();
    if (F.tid < NEXP) { for (int tl = pst[F.tid] >> 8; tl < (pst[F.tid + 1] >> 8); ++tl) te[tl] = F.tid; }
    __syncthreads();
}

__device__ __forceinline__ void p9_gather(const Frame& F, KArgs A) {
    unsigned char* ws = A->ws;
    int* RSRC = (int*)(ws + WS_RSRC);
    const int* TOPI = (const int*)(ws + WS_TOPI); const int* POS = (const int*)(ws + WS_POS); const float* GATE = (const float*)(ws + WS_GATE);
    float* RGATE = (float*)(ws + WS_RGATE);
    const LAS int* pst = (const LAS int*)(F.lds + PST_OFF);
    const int gt = F.vcu * (NWAVES * 64) + F.tid, NGT = F.G * NWAVES * 64;
    for (int idx = gt; idx < T * TOPK; idx += NGT) { const int dest = pst[TOPI[idx]] + POS[idx]; RSRC[dest] = idx >> 2; RGATE[dest] = GATE[idx]; }
}

__device__ __forceinline__ void p12_final(const Frame& F, KArgs A) {
    unsigned char* ws = A->ws;
    const float* X1 = (const float*)(ws + WS_X1); const unsigned char* YS = ws + WS_YS;
    const int* TOPI = (const int*)(ws + WS_TOPI); const int* POS = (const int*)(ws + WS_POS); const LAS int* pst = (const LAS int*)(F.lds + PST_OFF);
    const int gw = F.vcu * NWAVES + F.wave, NGW = F.G * NWAVES, lane = F.lane;
    f32x4 nw[4];
#pragma unroll
    for (int j = 0; j < 4; ++j) nw[j] = *((const f32x4*)A->final_norm_w + lane + 64 * j);
    for (int t = gw; t < T; t += NGW) {
        f32x4 v[4]; float ss = 0.f;
#pragma unroll
        for (int j = 0; j < 4; ++j) v[j] = *((const f32x4*)(X1 + (size_t)t * D) + lane + 64 * j);
#pragma unroll
        for (int s = 0; s < 4; ++s) { const unsigned* yr = (const unsigned*)(YS + (size_t)(pst[TOPI[t * 4 + s]] + POS[t * 4 + s]) * D) + lane;
#pragma unroll
            for (int j = 0; j < 4; ++j) { const unsigned p = yr[64 * j]; const attn_body::f32x2_t lo = __builtin_amdgcn_cvt_pk_f32_fp8((int)p, false), hi = __builtin_amdgcn_cvt_pk_f32_fp8((int)p, true);
                v[j][0] += lo[0] * pg8::MOE_YSCALE_INV; v[j][1] += lo[1] * pg8::MOE_YSCALE_INV; v[j][2] += hi[0] * pg8::MOE_YSCALE_INV; v[j][3] += hi[1] * pg8::MOE_YSCALE_INV; } }
#pragma unroll
        for (int j = 0; j < 4; ++j) ss += (v[j][0] * v[j][0] + v[j][1] * v[j][1]) + (v[j][2] * v[j][2] + v[j][3] * v[j][3]);
        const float rs = 1.0f / sqrtf(wave_sum(ss) * (1.0f / D) + NORM_EPS);
#pragma unroll
        for (int j = 0; j < 4; ++j) *((f32x4*)(A->out + (size_t)t * D) + lane + 64 * j) = v[j] * rs * nw[j];
    }
}
#ifndef MK_N_LAUNCHES
#define MK_N_LAUNCHES 1
#endif
constexpr int N_PHASES = 13;
__global__ void __launch_bounds__(NWAVES * 64, 2) mk_fwd(Args A_by_value_unused) {
    extern __shared__ __attribute__((aligned(16))) unsigned char lds[];
    Frame F;
    F.lds = (LAS unsigned char*)lds;
    volatile LAS unsigned* MISC = (volatile LAS unsigned*)(F.lds + MISC_OFF);
    F.tid = threadIdx.x; F.lane = F.tid & 63; F.wave = __builtin_amdgcn_readfirstlane(F.tid >> 6);
    F.G = gridDim.x; { const int bx = blockIdx.x; F.vcu = (F.G % 8 == 0) ? (bx % 8) * (F.G / 8) + bx / 8 : bx; }
    unsigned char* ws = get_args()->ws;
    gu32* ctl = (gu32*)(ws + WS_CTL);
    for (int u = F.tid; u < (LDS_BYTES - LDSCTL_OFF) / 4; u += NWAVES * 64) ((LAS unsigned*)(F.lds + LDSCTL_OFF))[u] = 0u;
    __syncthreads();
    XcdBarrier bar = xcd_barrier_post((unsigned*)(ctl + CW_BAR), MISC + 8);
    const int lo = get_args()->ph_lo, hi = get_args()->ph_hi;
#if defined(PROBE_A)
#ifndef PROBE_SCALE
#define PROBE_SCALE 0.25f
#endif
    unsigned long long* tsw = (unsigned long long*)(ws + WS_CTL + 65536);
    int n_stamp = 0;
#define STAMP() do { if (blockIdx.x == 0 && F.tid == 0) tsw[n_stamp] = rt(); ++n_stamp; } while (0)
#else
#define STAMP() do { } while (0)
#endif
    STAMP();
#define IN(k) (lo <= (k) && (k) < hi)
#define SEAM(k) do { if (IN(k) && IN((k) + 1)) xcd_barrier(bar); STAMP(); } while (0)
    bf16* XN = (bf16*)(ws + WS_XN); bf16* PB = (bf16*)(ws + WS_PB);

    if (IN(0)) { p0_prologue(fresh(F), get_args()); SEAM(0); }
    if (IN(1)) {
        pg8::Gemm g{XN, (const bf16*)(ws + WS_WIN), T, IN_COLS, D}; pg8::StaticOrder S; S.init(T, IN_COLS, F.G, (int)blockIdx.x);
        pg8::EpiInProj E{PB, IN_COLS, (const float*)(ws + WS_CS), attn_body::C2};
        pg8::gemm_phase<pg8::EpiInProj, pg8::StaticOrder, PG8_ALIGN, PG8_SP2>(F.lds + RING_OFF, g, S, E);
        { constexpr int NU = (T / 256) * (IN_COLS / 256), FULL = NU / 256, REM = NU % 256;
          if (REM != 0 && F.G == 256) { if ((int)blockIdx.x < REM) { if (F.tid == 0) __hip_atomic_fetch_add(ctl + CW_DONE5, 1u, __ATOMIC_RELAXED, __HIP_MEMORY_SCOPE_AGENT); }
                                        else { __syncthreads(); moe_weight_queue_scan(fresh(F), get_args(), ctl, CW_DONE5, (unsigned)(REM - 8)); } } (void)FULL; }
        SEAM(1);
    }
    if (IN(2)) { p2_prep(fresh(F), get_args()); SEAM(2); }
    if (IN(4)) { p4_chunk_prep(fresh(F), get_args()); SEAM(4); }
    if (IN(5)) {
        constexpr int NS = BATCH * 8;
        if ((F.vcu & 7) == 0 && (F.vcu >> 3) < NS) { scan_phase3(fresh(F), get_args(), F.vcu >> 3); moe_weight_queue_scan(fresh(F), get_args(), ctl, CW_AQ + 64 * (int)(blockIdx.x & 7), 128u); }
        attn_queue(fresh(F), get_args(), ctl);
        moe_weight_queue<false>(fresh(F), get_args(), ctl, 0u);
        SEAM(5);
    }
    if (IN(6)) { p6_combine(fresh(F), get_args()); SEAM(6); }
    if (IN(7)) {
        pg8::Gemm g{(const bf16*)(ws + WS_AO), (const bf16*)(ws + WS_WO), T, D, D}; pg8::StaticOrder S; S.init(T, D, F.G, (int)blockIdx.x);
        pg8::EpiResF32 E{get_args()->x, (float*)(ws + WS_X1), D};
        pg8::gemm_phase<pg8::EpiResF32, pg8::StaticOrder, PG8_ALIGN, PG8_SP2>(F.lds + RING_OFF, g, S, E);
        SEAM(7);
    }
    if (IN(8)) { p8_router(fresh(F), get_args(), ctl); moe_weight_queue<false>(fresh(F), get_args(), ctl, 0u); SEAM(8); }
    if (IN(9)) { moe_tables(fresh(F), ctl); p9_gather(fresh(F), get_args()); SEAM(9); }
    if (IN(10)) {
        moe_tables(fresh(F), ctl);
        const LAS int* pst = (const LAS int*)(F.lds + PST_OFF);
        pg8::Gemm g{(const bf16*)(ws + WS_H2), (const bf16*)(ws + WS_W1), P_MAX, NEXP * 2048, D, (const int*)(ws + WS_RSRC)};
        pg8::MoeOrder<8> S{pst[33], (int)blockIdx.x, F.G, (const LAS int*)(F.lds + TILE_OFF)};
        pg8::EpiSwiglu E{ws + WS_ACT, get_args()->mlp1_b};
        pg8::gemm_phase<pg8::EpiSwiglu, pg8::MoeOrder<8>, PG8_ALIGN, PG8_SP2, true, true>(F.lds + RING_OFF, g, S, E);
        SEAM(10);
    }
    if (IN(11)) {
        moe_tables(fresh(F), ctl);
        const LAS int* pst = (const LAS int*)(F.lds + PST_OFF);
        pg8::Gemm g{(const bf16*)(ws + WS_ACT), (const bf16*)(ws + WS_W2), P_MAX, NEXP * D, D};
        pg8::MoeOrder<4> S{pst[33], (int)blockIdx.x, F.G, (const LAS int*)(F.lds + TILE_OFF)};
        pg8::EpiMoeOut E{ws + WS_YS, get_args()->mlp2_b, (const float*)(ws + WS_RGATE)};
        pg8::gemm_phase<pg8::EpiMoeOut, pg8::MoeOrder<4>, PG8_ALIGN, PG8_SP2, false, true>(F.lds + RING_OFF, g, S, E);
        SEAM(11);
    }
    if (IN(12)) { moe_tables(fresh(F), ctl); p12_final(fresh(F), get_args()); }
#if defined(PROBE_A)
    xcd_barrier(bar); STAMP();
    if (blockIdx.x == 0 && F.tid == 0) { asm volatile("s_waitcnt vmcnt(0)" ::: "memory"); const float us = (float)(tsw[PROBE_B] - tsw[PROBE_A]) * 0.01f; get_args()->out[12345] = us * PROBE_SCALE; }
#endif
#undef IN
#undef SEAM
}

extern "C" void kernel_launch(void* const* d_in, const int* in_sizes, int n_in, void* d_out, int out_size, void* d_ws, size_t ws_size, hipStream_t stream) {
    static int grid = 0;
    if (grid == 0) {
        if (n_in != 29 || in_sizes[0] != T * D || out_size != T * D || ws_size < WS_END) { fprintf(stderr, "kernel_launch: built for 29 inputs, x/out of %d floats, >= %zu bytes of workspace; got n_in %d, in0 %d, out %d, ws %zu; nothing launched\n", T * D, (size_t)WS_END, n_in, n_in > 0 ? in_sizes[0] : -1, out_size, ws_size); grid = -1; return; }
        int dev = 0, cus = 0, per_cu = 0;
        if (hipGetDevice(&dev) != hipSuccess || hipDeviceGetAttribute(&cus, hipDeviceAttributeMultiprocessorCount, dev) != hipSuccess) { fprintf(stderr, "kernel_launch: device query failed\n"); grid = -1; return; }
        if (hipFuncSetAttribute((const void*)mk_fwd, hipFuncAttributeMaxDynamicSharedMemorySize, LDS_BYTES) != hipSuccess) { fprintf(stderr, "kernel_launch: hipFuncSetAttribute failed\n"); grid = -1; return; }
        if (hipOccupancyMaxActiveBlocksPerMultiprocessor(&per_cu, (const void*)mk_fwd, NWAVES * 64, LDS_BYTES) != hipSuccess || per_cu < 1)
            fprintf(stderr, "kernel_launch: note: occupancy query reports %d workgroups per CU\n", per_cu);
        (void)hipGetLastError();
        grid = cus;
        if (grid != 256) { fprintf(stderr, "kernel_launch: %d CUs; this kernel is built for 256; nothing launched\n", grid); grid = -1; return; }
    }
    if (grid < 0) return;
    if (hipMemsetAsync((char*)d_ws + WS_CTL, 0, CTL_ZERO_BYTES, stream) != hipSuccess) { fprintf(stderr, "kernel_launch: hipMemsetAsync failed\n"); return; }
    Args a{};
    a.x = (const float*)d_in[0]; a.positions = (const int*)d_in[1]; a.attn_norm_w = (const float*)d_in[2]; a.w_in = (const float*)d_in[3]; a.shift_mu = (const float*)d_in[4];
    a.lq1 = (const float*)d_in[5]; a.lk1 = (const float*)d_in[6]; a.lq2 = (const float*)d_in[7]; a.lk2 = (const float*)d_in[8]; a.subln_w = (const float*)d_in[9];
    a.rw_w0 = (const float*)d_in[10]; a.rw_w2 = (const float*)d_in[11]; a.rw_a0 = (const float*)d_in[12]; a.rw_a2 = (const float*)d_in[13]; a.rw_g2 = (const float*)d_in[14];
    a.rw_k_k = (const float*)d_in[15]; a.rw_k_a = (const float*)d_in[16]; a.rw_r_k = (const float*)d_in[17]; a.rw_lnx_w = (const float*)d_in[18]; a.rw_lnx_b = (const float*)d_in[19];
    a.w_out = (const float*)d_in[20]; a.ffn_norm_w = (const float*)d_in[21]; a.router_w = (const float*)d_in[22]; a.router_b = (const float*)d_in[23];
    a.mlp1_w = (const float*)d_in[24]; a.mlp1_b = (const float*)d_in[25]; a.mlp2_w = (const float*)d_in[26]; a.mlp2_b = (const float*)d_in[27]; a.final_norm_w = (const float*)d_in[28];
    a.out = (float*)d_out; a.ws = (unsigned char*)d_ws;
    if (MK_N_LAUNCHES == 1) { a.ph_lo = 0; a.ph_hi = N_PHASES; hipLaunchKernelGGL(mk_fwd, dim3(grid), dim3(NWAVES * 64), LDS_BYTES, stream, a); }
    else for (int p = 0; p < N_PHASES; ++p) { a.ph_lo = p; a.ph_hi = p + 1; hipLaunchKernelGGL(mk_fwd, dim3(grid), dim3(NWAVES * 64), LDS_BYTES, stream, a); }
    const hipError_t le = hipPeekAtLastError();
    if (le != hipSuccess) fprintf(stderr, "kernel_launch: launch failed: %s\n", hipGetErrorName(le));
}
```

```cpp
#include <hip/hip_runtime.h>
#include <cstdio>
#include <cstdint>
namespace pg8 {
#define PG8_LAS __attribute__((address_space(3)))
typedef unsigned short bf16_t;
typedef short bf16x8 __attribute__((ext_vector_type(8)));
typedef float f32x4 __attribute__((ext_vector_type(4)));
typedef unsigned u32x4 __attribute__((ext_vector_type(4)));
typedef int i32x4 __attribute__((ext_vector_type(4)));
typedef int i32x8 __attribute__((ext_vector_type(8)));
constexpr int BM = 256, BK = 64, HALF = 128, HTB = HALF * BK * 2  , STAGE_BYTES = 8 * HTB, NXCD = 8, WGM = 8;

__host__ __device__ __forceinline__ int lds_byte(int r, int c) { const int st = (r >> 4) * 2 + (c >> 5), rr = r & 15, cc = c & 31, ob = rr * 64 + cc * 2; return st * 1024 + (ob ^ (((ob >> 9) & 1) << 5)); }
__host__ __device__ __forceinline__ void stage_rc(int b, int& R, int& C) { const int st = b / 1024, sb = b % 1024, swz = sb ^ (((sb >> 9) & 1) << 5); R = (st >> 1) * 16 + swz / 64; C = (st & 1) * 32 + (swz % 64) / 2; }
__host__ __device__ __forceinline__ int perm32(int rho) { const int n = rho >> 4, i = rho & 15; return 8 * (i >> 2) + 4 * n + (i & 3); }

struct Unit { int pm, pn, rb; };
struct Gemm { const bf16_t* A; const bf16_t* Bt; int M, N, K; const int* rows; };

struct StaticOrder {
    int nM, nN, nwg, G, c;
    __host__ __device__ void init(int M, int N, int G_, int c_) { nM = M / BM; nN = N / BM; nwg = nM * nN; G = G_; c = c_; }
    __host__ __device__ bool next(int i, Unit& u) const {
        const long L = (long)i * G + c; if (L >= nwg) return false;
        int wgid = (int)L; { const int q = nwg / NXCD, r = nwg % NXCD, xcd = wgid % NXCD, off = wgid / NXCD; wgid = (xcd < r ? xcd * (q + 1) : r * (q + 1) + (xcd - r) * q) + off; }
        const int nig = WGM * nN, gid = wgid / nig, fm = gid * WGM, gsz = (nM - fm) < WGM ? (nM - fm) : WGM;
        u.pm = fm + ((wgid % nig) % gsz); u.pn = (wgid % nig) / gsz; return true;
    }
    __device__ __forceinline__ void a_ready(const Unit&) const {}
    __device__ __forceinline__ void done(const Unit&) const {}
};

__device__ __forceinline__ unsigned pk_fp8x4(float a, float b, float c, float d) { int w = __builtin_amdgcn_cvt_pk_fp8_f32(a, b, 0, false); w = __builtin_amdgcn_cvt_pk_fp8_f32(c, d, w, true); return (unsigned)w; }
constexpr float MOE_WSCALE = 32.0f, MOE_WSCALE_INV = 1.0f / 32.0f;
constexpr float MOE_YSCALE = 8.0f, MOE_YSCALE_INV = 1.0f / 8.0f;
__device__ __forceinline__ unsigned cvt_pk_bf16(float lo, float hi) { unsigned r; asm volatile("v_cvt_pk_bf16_f32 %0, %1, %2" : "=v"(r) : "v"(lo), "v"(hi)); return r; }
typedef float f32x2 __attribute__((ext_vector_type(2)));
__device__ __forceinline__ f32x2 gelu_pk(f32x2 v) {
    const f32x2 av = __builtin_elementwise_abs(v), d = av * 0.2316418882f + 1.0f;
    f32x2 t; t.x = __builtin_amdgcn_rcpf(d.x); t.y = __builtin_amdgcn_rcpf(d.y);
    f32x2 q = t * 0.5307027145f + (-0.7265760135f); q = q * t + 0.7107068705f; q = q * t + (-0.142248368f); q = q * t + 0.127414796f; q = q * t;
    const f32x2 s = (v * v) * (-0.72134752044f);
    f32x2 e; e.x = __builtin_amdgcn_exp2f(s.x); e.y = __builtin_amdgcn_exp2f(s.y);
    const f32x2 m = v * (q * e), r = v - m;
    f32x2 o; o.x = v.x < 0.f ? m.x : r.x; o.y = v.y < 0.f ? m.y : r.y; return o;
}

template <int ACT  > struct EpiBf16 {
    static constexpr bool PERM = true, AFTER_DRAIN = false, PERM16 = false, HAS_PRE = false, GUSPLIT = false, ROPE16 = false; static_assert(ACT == 0 || ACT == 1, "EpiBf16: ACT is 0 (none) or 1 (gelu_pk)");
    bf16_t* O; int ldc; const float* bias; int split_cols; size_t split_stride; float scale0;
    __device__ __forceinline__ void operator()(const f32x4 (&acc)[2][2][4][2], const Unit& u, int wr, int wc, int fr, int fq) const {
        const int row0 = u.pm * BM + wr * 64 + fr; int colt = u.pn * BM; bf16_t* base = O;
        float sc = 1.f; if (split_cols) { const int t = colt / split_cols; base += (size_t)t * split_stride; colt -= t * split_cols; if (t == 0) sc = scale0; }
        const int col0 = colt + wc * 32 + 8 * fq, bcol0 = u.pn * BM + wc * 32 + 8 * fq;
        f32x4 bv[2][2];
#pragma unroll
        for (int bj = 0; bj < 2; ++bj)
#pragma unroll
            for (int n = 0; n < 2; ++n) bv[bj][n] = bias ? *(const f32x4*)(bias + bcol0 + bj * HALF + 4 * n) : (f32x4){0.f, 0.f, 0.f, 0.f};
#pragma unroll
        for (int ai = 0; ai < 2; ++ai)
#pragma unroll
            for (int m = 0; m < 4; ++m) { bf16_t* rowp = base + (size_t)(row0 + ai * HALF + m * 16) * ldc + col0;
#pragma unroll
                for (int bj = 0; bj < 2; ++bj) { f32x4 v0 = acc[ai][bj][m][0] + bv[bj][0], v1 = acc[ai][bj][m][1] + bv[bj][1];
                    if (ACT == 1) { f32x2 a = gelu_pk((f32x2){v0[0], v0[1]}), b = gelu_pk((f32x2){v0[2], v0[3]}), c = gelu_pk((f32x2){v1[0], v1[1]}), d = gelu_pk((f32x2){v1[2], v1[3]});
                        v0 = (f32x4){a.x, a.y, b.x, b.y}; v1 = (f32x4){c.x, c.y, d.x, d.y}; }
                    v0 = v0 * sc; v1 = v1 * sc; u32x4 w; w.x = cvt_pk_bf16(v0[0], v0[1]); w.y = cvt_pk_bf16(v0[2], v0[3]); w.z = cvt_pk_bf16(v1[0], v1[1]); w.w = cvt_pk_bf16(v1[2], v1[3]);
                    *(u32x4*)(rowp + bj * HALF) = w; } }
    }
};
__device__ __forceinline__ void pg8_glds16s(const void* gbase, unsigned voff, unsigned lds_dst) { unsigned keep;
    asm volatile("s_mov_b32 %0, m0\n\ts_mov_b32 m0, %2\n\ts_nop 0\n\tglobal_load_lds_dwordx4 %1, %3\n\ts_mov_b32 m0, %0" : "=&s"(keep) : "v"(voff), "s"(lds_dst), "s"(gbase) : "memory"); }
template <class E, bool H> struct PreOf { struct type {}; };
template <class E> struct PreOf<E, true> { using type = typename E::Pre; };
template <class Epi, class Sched, bool ALIGN_EPI = false, bool SP2 = false, bool GATHER = false, bool FP8 = false>
__device__ __forceinline__ void gemm_phase(PG8_LAS unsigned char* lds, const Gemm g, const Sched& S, const Epi& E) {
    const int tid = threadIdx.x, wid = __builtin_amdgcn_readfirstlane(tid >> 6), lane = tid & 63, wr = wid >> 2, wc = wid & 3, fr = lane & 15, fq = lane >> 4;
    constexpr int EB = FP8 ? 1 : 2;
    int K = g.K; asm volatile("" : "+s"(K));
    const int nt = (K * EB) / (BK * 2);
    unsigned voffA[2], voffB[2]; int Rl[2]; unsigned Cb[2];
#pragma unroll
    for (int i = 0; i < 2; ++i) { int R, C; stage_rc(tid * 16 + i * 8192, R, C); const int Rb = Epi::PERM ? ((R & ~31) + perm32(R & 31)) : R;
        voffA[i] = (unsigned)(R * K) * EB + (unsigned)C * 2u; voffB[i] = (unsigned)(Rb * K) * EB + (unsigned)C * 2u; Rl[i] = R; Cb[i] = (unsigned)C * 2u; }
    unsigned voffB16[2][2];
#pragma unroll
    for (int h_ = 0; h_ < 2; ++h_)
#pragma unroll
        for (int i_ = 0; i_ < 2; ++i_) { const int R = Rl[i_]; voffB16[h_][i_] = (unsigned)((64 * (R >> 5) + 16 * ((R >> 2) & 3) + 8 * h_ + (Epi::GUSPLIT ? 2 * (R & 3) + ((R >> 4) & 1) : 4 * ((R >> 4) & 1) + (R & 3))) * K) * EB + Cb[i_];
            if constexpr (Epi::ROPE16) voffB16[h_][i_] = (unsigned)((64 * (R >> 5) + 32 * ((R >> 4) & 1) + 8 * ((R >> 2) & 3) + 4 * h_ + (R & 3)) * K) * EB + Cb[i_]; }
#define PG8_STAGE_B(bufoff, kptr, h) do { if constexpr (Epi::PERM16) { PG8_STAGE(bufoff, kptr, voffB16[h]); } else { PG8_STAGE(bufoff, (kptr) + (h) * hstep, voffB); } } while (0)
    unsigned gcur[2][2];
    const unsigned rowoff = (unsigned)STAGE_BYTES + (unsigned)wid * 1024u; const unsigned rvoff[2] = {(unsigned)Rl[0] * 4u, (unsigned)Rl[1] * 4u};
#define PG8_GATH(dst, u) do { _Pragma("unroll") for (int h_ = 0; h_ < 2; ++h_) _Pragma("unroll") for (int i_ = 0; i_ < 2; ++i_) \
        dst[h_][i_] = min((unsigned)g.rows[(u).rb + h_ * HALF + Rl[i_]], (unsigned)(S.cap - 1)) * (unsigned)(K * EB) + Cb[i_]; } while (0)
#define PG8_STAGE_A(bufoff, kptr, h, GA) do { if constexpr (GATHER) { PG8_STAGE(bufoff, kptr, GA[h]); } else { PG8_STAGE(bufoff, (kptr) + (h) * hstep, voffA); } } while (0)
#define PG8_STAGE_A2(bufoff, kptr, h) do { if constexpr (GATHER) { PG8_STAGE(bufoff, kptr, gcur[h]); } else { PG8_STAGE(bufoff, (kptr) + (h) * hstep, voffA); } } while (0)
#define PG8_GSWITCH do { if constexpr (GATHER) { if (last && has_next) { \
        _Pragma("unroll") for (int h_ = 0; h_ < 2; ++h_) _Pragma("unroll") for (int i_ = 0; i_ < 2; ++i_) \
            gcur[h_][i_] = min((unsigned)*(const PG8_LAS int*)(lds + rowoff + (h_ * 2 + i_) * 256 + lane * 4), (unsigned)(S.cap - 1)) * (unsigned)(K * EB) + Cb[i_]; } } } while (0)
#define PG8_ROWS_DMA(u) do { const int* rb_ = g.rows + (size_t)__builtin_amdgcn_readfirstlane((u).rb); unsigned keep_; \
        _Pragma("unroll") for (int h_ = 0; h_ < 2; ++h_) _Pragma("unroll") for (int i_ = 0; i_ < 2; ++i_) \
            asm volatile("s_mov_b32 %0, m0\n\ts_mov_b32 m0, %2\n\ts_nop 0\n\tglobal_load_lds_dword %1, %3\n\ts_mov_b32 m0, %0" : "=&s"(keep_) \
                : "v"(rvoff[i_]), "s"((unsigned)__builtin_amdgcn_readfirstlane((int)(lds0 + rowoff + (h_ * 2 + i_) * 256))), "s"(rb_ + h_ * HALF) : "memory"); } while (0)
    const size_t kstep = (size_t)(BK * 2);
    const size_t hstep = (size_t)HALF * K * EB;
    const size_t tstep = 2 * hstep;
    const unsigned lds0 = (unsigned)(uintptr_t)lds;
    const unsigned ldsw = (unsigned)wid * 1024u;
    const int aoff = lds_byte(wr * 64 + fr, fq * 8), boff = lds_byte(wc * 32 + fr, fq * 8);
#define PG8_SA(b, h) (((b) * 2 + (h)) * HTB)
#define PG8_SB(b, h) ((4 + (b) * 2 + (h)) * HTB)
#define PG8_STAGE(bufoff, gbase, voff) do { _Pragma("unroll") for (int _i = 0; _i < 2; ++_i) { \
        if constexpr (FP8) pg8_glds16s((const char*)(gbase), (voff)[_i], (unsigned)__builtin_amdgcn_readfirstlane((int)(lds0 + (unsigned)(bufoff) + ldsw + _i * 8192))); \
        else __builtin_amdgcn_global_load_lds((const unsigned*)((const char*)(gbase) + (voff)[_i]), (PG8_LAS unsigned*)(lds + (bufoff) + ldsw + _i * 8192), 16, 0, 0); } } while (0)
#define PG8_CAT(x, y) __builtin_shufflevector(__builtin_bit_cast(i32x4, x), __builtin_bit_cast(i32x4, y), 0, 1, 2, 3, 4, 5, 6, 7)
#define PG8_LDA(dst, b, h) do { if constexpr (FP8) { _Pragma("unroll") for (int m = 0; m < 4; ++m) dst##8[m] = PG8_CAT(*(const PG8_LAS bf16x8*)(lds + PG8_SA(b, h) + aoff + m * 2048), *(const PG8_LAS bf16x8*)(lds + PG8_SA(b, h) + aoff + m * 2048 + 1024)); } \
        else { _Pragma("unroll") for (int m = 0; m < 4; ++m) _Pragma("unroll") for (int k = 0; k < 2; ++k) dst[m][k] = *(const PG8_LAS bf16x8*)(lds + PG8_SA(b, h) + aoff + m * 2048 + k * 1024); } } while (0)
#define PG8_LDB(dst, b, h) do { if constexpr (FP8) { _Pragma("unroll") for (int n = 0; n < 2; ++n) dst##8[n] = PG8_CAT(*(const PG8_LAS bf16x8*)(lds + PG8_SB(b, h) + boff + n * 2048), *(const PG8_LAS bf16x8*)(lds + PG8_SB(b, h) + boff + n * 2048 + 1024)); } \
        else { _Pragma("unroll") for (int n = 0; n < 2; ++n) _Pragma("unroll") for (int k = 0; k < 2; ++k) dst[n][k] = *(const PG8_LAS bf16x8*)(lds + PG8_SB(b, h) + boff + n * 2048 + k * 1024); } } while (0)
#define PG8_MMA0(ai, bj, At, Bt) do { if (FP8 && t == 0) { __builtin_amdgcn_s_setprio(1);     \
        _Pragma("unroll") for (int m = 0; m < 4; ++m) _Pragma("unroll") for (int n = 0; n < 2; ++n) \
            asm volatile("v_mfma_f32_16x16x128_f8f6f4 %0, %1, %2, 0" : "=&v"(acc[ai][bj][m][n]) : "v"(Bt##8[n]), "v"(At##8[m])); \
        __builtin_amdgcn_s_setprio(0); } else { PG8_MMA(ai, bj, At, Bt); } } while (0)
#define PG8_MMA(ai, bj, At, Bt) do { __builtin_amdgcn_s_setprio(1); _Pragma("unroll") for (int m = 0; m < 4; ++m) _Pragma("unroll") for (int n = 0; n < 2; ++n) { \
        if constexpr (FP8) asm volatile("v_mfma_f32_16x16x128_f8f6f4 %0, %1, %2, %0" : "+v"(acc[ai][bj][m][n]) : "v"(Bt##8[n]), "v"(At##8[m])); \
        else { _Pragma("unroll") for (int k = 0; k < 2; ++k) acc[ai][bj][m][n] = __builtin_amdgcn_mfma_f32_16x16x32_bf16(Bt[n][k], At[m][k], acc[ai][bj][m][n], 0, 0, 0); } } \
        __builtin_amdgcn_s_setprio(0); } while (0)
#define PG8_WAIT_V(n) asm volatile("s_waitcnt vmcnt(" #n ")" ::: "memory")
#define PG8_WAIT_L(n) asm volatile("s_waitcnt lgkmcnt(" #n ")" ::: "memory")
#define PG8_BAR __builtin_amdgcn_s_barrier()
#define PG8_SCHED __builtin_amdgcn_sched_barrier(0)
    Unit cur, nxt; int ui = 0;
    if (!S.next(0, cur)) return;
    typename PreOf<Epi, Epi::HAS_PRE>::type pre;
    f32x4 acc[2][2][4][2];
#pragma unroll
    for (int a = 0; a < 2; ++a)
#pragma unroll
        for (int b = 0; b < 2; ++b)
#pragma unroll
            for (int m = 0; m < 4; ++m)
#pragma unroll
                for (int n = 0; n < 2; ++n) { if constexpr (!FP8) acc[a][b][m][n] = (f32x4){0.f, 0.f, 0.f, 0.f}; }
    bf16x8 At[4][2], B0[2][2], B1[2][2];
    i32x8 At8[4], B08[2], B18[2];
    const char* cA = (const char*)g.A + (GATHER ? (size_t)0 : (size_t)cur.pm * tstep); const char* cB = (const char*)g.Bt + (size_t)cur.pn * tstep;
    if constexpr (GATHER) PG8_GATH(gcur, cur);
    S.a_ready(cur);
    if constexpr (SP2) {
        PG8_STAGE_B(PG8_SB(0, 0), cB, 0); PG8_STAGE_B(PG8_SB(0, 1), cB, 1); PG8_STAGE_A(PG8_SA(0, 0), cA, 0, gcur); PG8_STAGE_A(PG8_SA(0, 1), cA, 1, gcur);
        if (wr == 1) PG8_BAR;
        PG8_WAIT_V(2); PG8_BAR;
        PG8_STAGE_B(PG8_SB(1, 0), cB + kstep, 0); PG8_STAGE_A(PG8_SA(1, 0), cA + kstep, 0, gcur); PG8_STAGE_B(PG8_SB(1, 1), cB + kstep, 1);
        PG8_WAIT_V(6); PG8_BAR;
    } else {
        PG8_STAGE_B(PG8_SB(0, 0), cB, 0); PG8_STAGE_A(PG8_SA(0, 0), cA, 0, gcur); PG8_STAGE_B(PG8_SB(0, 1), cB, 1); PG8_STAGE_A(PG8_SA(0, 1), cA, 1, gcur);
        if (wr == 1) PG8_BAR;
        PG8_WAIT_V(4); PG8_BAR;
        PG8_STAGE_B(PG8_SB(1, 0), cB + kstep, 0); PG8_STAGE_A(PG8_SA(1, 0), cA + kstep, 0, gcur); PG8_STAGE_B(PG8_SB(1, 1), cB + kstep, 1);
        PG8_WAIT_V(6); PG8_BAR;
    }
    for (;;) {
        const bool has_next = S.next(ui + 1, nxt);
        if constexpr (Epi::HAS_PRE) E.prefetch(pre, cur, wr, fr);
        if constexpr (GATHER) { if (has_next) PG8_ROWS_DMA(nxt); }
        const char* nA = (has_next && !GATHER) ? (const char*)g.A + (size_t)nxt.pm * tstep : cA; const char* nB = has_next ? (const char*)g.Bt + (size_t)nxt.pn * tstep : cB;
        for (int t = 0; t < nt; t += 2) {
            const bool last = (t == nt - 2);
            const char* a1 = cA + (size_t)(t + 1) * kstep;
            const char* a2 = last ? nA : cA + (size_t)(t + 2) * kstep; const char* b2 = last ? nB : cB + (size_t)(t + 2) * kstep;
            const char* a3 = a2 + kstep; const char* b3 = b2 + kstep;
            if (last && has_next) S.a_ready(nxt);
            if constexpr (SP2) {
            PG8_LDB(B0, 0, 0); PG8_LDB(B1, 0, 1); PG8_SCHED; PG8_LDA(At, 0, 0); PG8_STAGE_A(PG8_SA(1, 1), a1, 1, gcur); PG8_GSWITCH;
            PG8_WAIT_V(8); PG8_WAIT_L(0); PG8_BAR; PG8_MMA0(0, 0, At, B0); PG8_MMA0(0, 1, At, B1); PG8_BAR; PG8_SCHED;
            PG8_LDA(At, 0, 1); PG8_STAGE_B(PG8_SB(0, 0), b2, 0); PG8_STAGE_B(PG8_SB(0, 1), b2, 1); PG8_STAGE_A2(PG8_SA(0, 0), a2, 0);
            PG8_WAIT_V(8); PG8_WAIT_L(0); PG8_BAR; PG8_MMA0(1, 0, At, B0); PG8_MMA0(1, 1, At, B1); PG8_BAR; PG8_SCHED;
            PG8_LDB(B0, 1, 0); PG8_LDB(B1, 1, 1); PG8_SCHED; PG8_LDA(At, 1, 0); PG8_STAGE_A2(PG8_SA(0, 1), a2, 1);
            PG8_WAIT_V(8); PG8_WAIT_L(0); PG8_BAR; PG8_MMA(0, 0, At, B0); PG8_MMA(0, 1, At, B1); PG8_BAR; PG8_SCHED;
            PG8_LDA(At, 1, 1); PG8_STAGE_B(PG8_SB(1, 0), b3, 0); PG8_STAGE_B(PG8_SB(1, 1), b3, 1); PG8_STAGE_A2(PG8_SA(1, 0), a3, 0);
            PG8_WAIT_V(8); PG8_WAIT_L(0); PG8_BAR; PG8_MMA(1, 0, At, B0); PG8_MMA(1, 1, At, B1); PG8_BAR; PG8_SCHED;
            } else {
            PG8_LDB(B0, 0, 0); PG8_SCHED; PG8_LDA(At, 0, 0); PG8_STAGE_A(PG8_SA(1, 1), a1, 1, gcur); PG8_GSWITCH;
            PG8_WAIT_L(8); PG8_BAR; PG8_WAIT_L(0); PG8_MMA(0, 0, At, B0); PG8_BAR; PG8_SCHED;
            PG8_LDB(B1, 0, 1); PG8_STAGE_B(PG8_SB(0, 0), b2, 0);
            PG8_BAR; PG8_WAIT_L(0); PG8_MMA(0, 1, At, B1); PG8_BAR;
            PG8_LDA(At, 0, 1); PG8_STAGE_A2(PG8_SA(0, 0), a2, 0);
            PG8_BAR; PG8_WAIT_L(0); PG8_MMA(1, 0, At, B0); PG8_BAR; PG8_SCHED;
            PG8_STAGE_B(PG8_SB(0, 1), b2, 1);
            PG8_WAIT_V(6); PG8_BAR; PG8_MMA(1, 1, At, B1); PG8_BAR;
            PG8_LDB(B0, 1, 0); PG8_SCHED; PG8_LDA(At, 1, 0); PG8_STAGE_A2(PG8_SA(0, 1), a2, 1);
            PG8_WAIT_L(8); PG8_BAR; PG8_WAIT_L(0); PG8_MMA(0, 0, At, B0); PG8_BAR; PG8_SCHED;
            PG8_LDB(B1, 1, 1); PG8_STAGE_B(PG8_SB(1, 0), b3, 0);
            PG8_BAR; PG8_WAIT_L(0); PG8_MMA(0, 1, At, B1); PG8_BAR;
            PG8_LDA(At, 1, 1); PG8_STAGE_A2(PG8_SA(1, 0), a3, 0);
            PG8_BAR; PG8_WAIT_L(0); PG8_MMA(1, 0, At, B0); PG8_BAR; PG8_SCHED;
            PG8_STAGE_B(PG8_SB(1, 1), b3, 1);
            PG8_WAIT_V(6); PG8_BAR; PG8_MMA(1, 1, At, B1); PG8_BAR;
            }
        }
        if constexpr (FP8) {
            _Pragma("unroll") for (int a = 0; a < 2; ++a) _Pragma("unroll") for (int b = 0; b < 2; ++b) _Pragma("unroll") for (int m = 0; m < 4; ++m)
                { if (a == 0 && b == 0 && m == 0) asm volatile("s_nop 15\n\ts_nop 7" : "+v"(acc[a][b][m][0]), "+v"(acc[a][b][m][1])); else asm volatile("" : "+v"(acc[a][b][m][0]), "+v"(acc[a][b][m][1])); }
        }
        if constexpr (ALIGN_EPI) { if (wr == 0) PG8_BAR; }
        if constexpr (!Epi::AFTER_DRAIN) { if constexpr (Epi::HAS_PRE) E(acc, cur, wr, wc, fr, fq, pre); else E(acc, cur, wr, wc, fr, fq); S.done(cur); }
        if (!has_next) break;
#pragma unroll
        for (int a = 0; a < 2; ++a)
#pragma unroll
            for (int b = 0; b < 2; ++b)
#pragma unroll
                for (int m = 0; m < 4; ++m)
#pragma unroll
                    for (int n = 0; n < 2; ++n) { if constexpr (!FP8) acc[a][b][m][n] = (f32x4){0.f, 0.f, 0.f, 0.f}; }
        cur = nxt; cA = nA; cB = nB; ++ui;
        if constexpr (ALIGN_EPI) { if (wr == 1) PG8_BAR; }
    }
    PG8_WAIT_V(0);
    if constexpr (!ALIGN_EPI) { if (wr == 0) PG8_BAR; }
    PG8_BAR;
    if constexpr (Epi::AFTER_DRAIN) { E.fused(acc, cur, wr, wc, fr, fq, lds, wid, lane); S.done(cur); }
#undef PG8_SA
#undef PG8_SB
#undef PG8_STAGE
#undef PG8_STAGE_A
#undef PG8_STAGE_A2
#undef PG8_STAGE_B
#undef PG8_GATH
#undef PG8_GSWITCH
#undef PG8_ROWS_DMA
#undef PG8_LDA
#undef PG8_LDB
#undef PG8_MMA
#undef PG8_MMA0
#undef PG8_CAT
#undef PG8_WAIT_V
#undef PG8_WAIT_L
#undef PG8_BAR
#undef PG8_SCHED
}
}

#ifndef PG8_SP2
#define PG8_SP2 true
#endif
#ifndef PG8_ALIGN
#define PG8_ALIGN true
#endif
namespace pg8 {
struct EpiInProj {
    static constexpr bool PERM = true, AFTER_DRAIN = false, PERM16 = true, HAS_PRE = false, GUSPLIT = false, ROPE16 = true;
    bf16_t* O; int ldc; const float* CS; float qscale;
    static __device__ __forceinline__ void put(bf16_t* rowp, const f32x4 (&o1)[2], const f32x4 (&o2)[2]) {
        u32x4 w1, w2;
        w1.x = cvt_pk_bf16(o1[0][0], o1[0][1]); w1.y = cvt_pk_bf16(o1[0][2], o1[0][3]); w1.z = cvt_pk_bf16(o1[1][0], o1[1][1]); w1.w = cvt_pk_bf16(o1[1][2], o1[1][3]);
        w2.x = cvt_pk_bf16(o2[0][0], o2[0][1]); w2.y = cvt_pk_bf16(o2[0][2], o2[0][3]); w2.z = cvt_pk_bf16(o2[1][0], o2[1][1]); w2.w = cvt_pk_bf16(o2[1][2], o2[1][3]);
        *(u32x4*)rowp = w1; *(u32x4*)(rowp + 32) = w2; }
    __device__ __forceinline__ void operator()(const f32x4 (&acc)[2][2][4][2], const Unit& u, int wr, int wc, int fr, int fq) const {
        const int row0 = u.pm * BM + wr * 64 + fr, col0 = u.pn * BM + wc * 64 + 8 * fq;
        if (u.pn < 4) {
            const float sc = u.pn < 2 ? qscale : 1.0f; const float* cs0 = CS + (size_t)row0 * 64 + 8 * fq;
            f32x4 cs[8][2][2];
#define PG8_CS_LD(g) do { const float* p_ = cs0 + (size_t)(((g) >> 2) * HALF + ((g) & 3) * 16) * 64; _Pragma("unroll") for (int bj = 0; bj < 2; ++bj) { cs[g][bj][0] = *(const f32x4*)(p_ + 4 * bj); cs[g][bj][1] = *(const f32x4*)(p_ + 32 + 4 * bj); } } while (0)
            PG8_CS_LD(0); PG8_CS_LD(1); PG8_CS_LD(2);
#pragma unroll
            for (int g = 0; g < 8; ++g) { const int ai = g >> 2, m = g & 3;
                if (g + 3 < 8) PG8_CS_LD(g + 3);
                f32x4 o1[2], o2[2];
#pragma unroll
                for (int bj = 0; bj < 2; ++bj) { const f32x4 c = cs[g][bj][0] * sc, sn = cs[g][bj][1] * sc; const f32x4 x1 = acc[ai][bj][m][0], x2 = acc[ai][bj][m][1];
                    o1[bj] = x1 * c - x2 * sn; o2[bj] = x2 * c + x1 * sn; }
                put(O + (size_t)(row0 + ai * HALF + m * 16) * ldc + col0, o1, o2); }
#undef PG8_CS_LD
        } else {
#pragma unroll
            for (int ai = 0; ai < 2; ++ai)
#pragma unroll
                for (int m = 0; m < 4; ++m) { f32x4 o1[2], o2[2];
#pragma unroll
                    for (int bj = 0; bj < 2; ++bj) { o1[bj] = acc[ai][bj][m][0]; o2[bj] = acc[ai][bj][m][1]; }
                    put(O + (size_t)(row0 + ai * HALF + m * 16) * ldc + col0, o1, o2); }
        }
    }
};
struct EpiResBf16 {
    static constexpr bool PERM = true, AFTER_DRAIN = false, PERM16 = true, HAS_PRE = false, GUSPLIT = false, ROPE16 = false;
    const float* base; bf16_t* out; int ldc;
    __device__ __forceinline__ void operator()(const f32x4 (&acc)[2][2][4][2], const Unit& u, int wr, int wc, int fr, int fq) const {
        const int col0 = u.pn * BM + wc * 64 + 16 * fq;
        const size_t off0 = (size_t)(u.pm * BM + wr * 64 + fr) * ldc + col0;
        f32x4 bs[8][2][2];
#define PG8_RES_LD(g) do { const size_t off_ = off0 + (size_t)(((g) >> 2) * HALF + ((g) & 3) * 16) * ldc; _Pragma("unroll") for (int bj = 0; bj < 2; ++bj) _Pragma("unroll") for (int n = 0; n < 2; ++n) \
            bs[g][bj][n] = *(const f32x4*)(base + off_ + 8 * bj + 4 * n); } while (0)
        PG8_RES_LD(0); PG8_RES_LD(1); PG8_RES_LD(2);
#pragma unroll
        for (int g = 0; g < 8; ++g) { const int ai = g >> 2, m = g & 3; const size_t off = off0 + (size_t)(ai * HALF + m * 16) * ldc;
            if (g + 3 < 8) PG8_RES_LD(g + 3);
#pragma unroll
            for (int bj = 0; bj < 2; ++bj) { const f32x4 v0 = bs[g][bj][0] + acc[ai][bj][m][0], v1 = bs[g][bj][1] + acc[ai][bj][m][1];
                u32x4 w; w.x = cvt_pk_bf16(v0[0], v0[1]); w.y = cvt_pk_bf16(v0[2], v0[3]); w.z = cvt_pk_bf16(v1[0], v1[1]); w.w = cvt_pk_bf16(v1[2], v1[3]);
                *(u32x4*)(out + off + 8 * bj) = w; } }
#undef PG8_RES_LD
    }
};
struct EpiSwiglu {
    static constexpr bool PERM = true, AFTER_DRAIN = false, PERM16 = true, HAS_PRE = true, GUSPLIT = true, ROPE16 = false;
    unsigned char* O; const float* bias;
    struct Pre { f32x4 bv[2][2]; };
    __device__ __forceinline__ void prefetch(Pre& p, const Unit& u, int wr, int fr) const {
        const int tid = threadIdx.x, wc = __builtin_amdgcn_readfirstlane(tid >> 6) & 3, fq = (tid & 63) >> 4;
        const int e = u.pn >> 3, pnl = u.pn & 7, bcol0 = pnl * BM + wc * 64 + 16 * fq;
        const float* bp = bias + (size_t)e * 2048 + bcol0;
#pragma unroll
        for (int bj = 0; bj < 2; ++bj)
#pragma unroll
            for (int n = 0; n < 2; ++n) p.bv[bj][n] = *(const f32x4*)(bp + 8 * bj + 4 * n);
    }
    typedef float f2 __attribute__((ext_vector_type(2)));
    static __device__ __forceinline__ f2 pkmul(f2 a, f2 b) { f2 r; asm("v_pk_mul_f32 %0, %1, %2" : "=v"(r) : "v"(a), "v"(b)); return r; }
    static __device__ __forceinline__ f2 pkadd1(f2 a) { f2 r; asm("s_nop 0\n\tv_pk_add_f32 %0, %1, 1.0 op_sel_hi:[1,0]" : "=v"(r) : "v"(a)); return r; }
    static __device__ __forceinline__ f2 pkmul_t(f2 a, f2 b) { f2 r; asm("s_nop 0\n\tv_pk_mul_f32 %0, %1, %2" : "=v"(r) : "v"(a), "v"(b)); return r; }
    static __device__ __forceinline__ f2 pkfma(f2 a, f2 b, f2 c) { f2 r; asm("v_pk_fma_f32 %0, %1, %2, %3" : "=v"(r) : "v"(a), "v"(b), "v"(c)); return r; }
    __device__ __forceinline__ void operator()(const f32x4 (&acc)[2][2][4][2], const Unit& u, int wr, int wc, int fr, int fq, const Pre& p) const {
        const int pnl = u.pn & 7;
        const int row0 = u.pm * BM + wr * 64 + fr, bcol0 = pnl * BM + wc * 64 + 16 * fq;
        f32x4 bg[2], bu[2];
#pragma unroll
        for (int bj = 0; bj < 2; ++bj) { bg[bj] = (f32x4){p.bv[bj][0][0], p.bv[bj][0][2], p.bv[bj][1][0], p.bv[bj][1][2]}; bu[bj] = (f32x4){p.bv[bj][0][1], p.bv[bj][0][3], p.bv[bj][1][1], p.bv[bj][1][3]}; }
        const f2 kk = {-1.702f * 1.4426950408889634f, -1.702f * 1.4426950408889634f};
#pragma unroll
        for (int ai = 0; ai < 2; ++ai)
#pragma unroll
            for (int m = 0; m < 4; ++m) { unsigned char* rowp = O + (size_t)(row0 + ai * HALF + m * 16) * 1024 + (bcol0 >> 1);
                f2 a[4];
#pragma unroll
                for (int bj = 0; bj < 2; ++bj) { const f32x4 G = acc[ai][bj][m][0] * MOE_WSCALE_INV + bg[bj], U = acc[ai][bj][m][1] * MOE_WSCALE_INV + bu[bj];
#pragma unroll
                    for (int h = 0; h < 2; ++h) {
                        const f2 gc = {fminf(G[2 * h], 7.0f), fminf(G[2 * h + 1], 7.0f)}, uc = {fminf(fmaxf(U[2 * h], -7.0f), 7.0f), fminf(fmaxf(U[2 * h + 1], -7.0f), 7.0f)};
                        const f2 t = pkmul(gc, kk); const f2 e = {__builtin_amdgcn_exp2f(t[0]), __builtin_amdgcn_exp2f(t[1])};
                        const f2 d = pkadd1(e); const f2 r = {__builtin_amdgcn_rcpf(d[0]), __builtin_amdgcn_rcpf(d[1])};
                        a[2 * bj + h] = pkmul_t(pkfma(uc, gc, gc), r); } }
                typedef unsigned u32x2 __attribute__((ext_vector_type(2)));
                u32x2 w; w.x = pk_fp8x4(a[0][0], a[0][1], a[1][0], a[1][1]); w.y = pk_fp8x4(a[2][0], a[2][1], a[3][0], a[3][1]);
                *(u32x2*)rowp = w; }
    }
};
struct EpiMoeOut {
    static constexpr bool PERM = true, AFTER_DRAIN = false, PERM16 = true, HAS_PRE = true, GUSPLIT = false, ROPE16 = false;
    unsigned char* YS; const float* bias; const float* rgate;
    struct Pre { float g[8]; f32x4 bv[2][2]; };
    __device__ __forceinline__ void prefetch(Pre& p, const Unit& u, int wr, int fr) const {
        const int row0 = u.rb + wr * 64 + fr;
#pragma unroll
        for (int ai = 0; ai < 2; ++ai)
#pragma unroll
            for (int m = 0; m < 4; ++m) p.g[ai * 4 + m] = rgate[row0 + ai * HALF + m * 16];
        const int tid = threadIdx.x, wc = __builtin_amdgcn_readfirstlane(tid >> 6) & 3, fq = (tid & 63) >> 4;
        const float* bp = bias + (size_t)(u.pn >> 2) * 1024 + (u.pn & 3) * BM + wc * 64 + 16 * fq;
#pragma unroll
        for (int bj = 0; bj < 2; ++bj)
#pragma unroll
            for (int n = 0; n < 2; ++n) p.bv[bj][n] = *(const f32x4*)(bp + 8 * bj + 4 * n);
    }
    __device__ __forceinline__ void operator()(const f32x4 (&acc)[2][2][4][2], const Unit& u, int wr, int wc, int fr, int fq, const Pre& p) const {
        const int pnl = u.pn & 3;
        const int col0 = pnl * BM + wc * 64 + 16 * fq;
        const int row0 = u.pm * BM + wr * 64 + fr;
        const f32x4 (&bv)[2][2] = p.bv;
#pragma unroll
        for (int ai = 0; ai < 2; ++ai)
#pragma unroll
            for (int m = 0; m < 4; ++m) { const float gt = p.g[ai * 4 + m] * MOE_YSCALE; u32x4 w;
                { const f32x4 v0 = (acc[ai][0][m][0] * MOE_WSCALE_INV + bv[0][0]) * gt, v1 = (acc[ai][0][m][1] * MOE_WSCALE_INV + bv[0][1]) * gt; w.x = pk_fp8x4(v0[0], v0[1], v0[2], v0[3]); w.y = pk_fp8x4(v1[0], v1[1], v1[2], v1[3]); }
                { const f32x4 v0 = (acc[ai][1][m][0] * MOE_WSCALE_INV + bv[1][0]) * gt, v1 = (acc[ai][1][m][1] * MOE_WSCALE_INV + bv[1][1]) * gt; w.z = pk_fp8x4(v0[0], v0[1], v0[2], v0[3]); w.w = pk_fp8x4(v1[0], v1[1], v1[2], v1[3]); }
                *(u32x4*)(YS + (size_t)(row0 + ai * HALF + m * 16) * 1024 + col0) = w; }
    }
};
template <int NTN> struct MoeOrder {
    int ntiles, c, G; const PG8_LAS int* te; const PG8_LAS int* pst; int cap;
    __device__ __forceinline__ bool next(int i, Unit& u) const {
        int pm, pnl; constexpr int RT = 32 / NTN;
        if (G == 256) { const int x = c & 7, j = c >> 3, gidx = i * 8 + x; pm = RT * gidx + (j % RT); pnl = j / RT; }
        else { const long L = (long)i * G + c; pm = (int)(L / NTN); pnl = (int)(L % NTN); }
        if (pm >= ntiles) return false;
        const int e = te[pm]; u.pm = pm; u.pn = e * NTN + pnl; u.rb = e * cap + (pm - (pst[e] >> 8)) * BM; return true;
    }
    __device__ __forceinline__ void a_ready(const Unit&) const {}
    __device__ __forceinline__ void done(const Unit&) const {}
};
}
#include <hip/hip_bf16.h>
#include <cmath>
namespace attn_body {
using bf16=__hip_bfloat16;
using bf16x8=__attribute__((ext_vector_type(8)))short;
using s16x4=__attribute__((ext_vector_type(4)))short;
using f32x16=__attribute__((ext_vector_type(16)))float;
using u32x4=__attribute__((ext_vector_type(4)))unsigned;
constexpr int SEQ=8192,D=64,PQ=3328,PO=1024;
constexpr int NW=8,QBLK=32,QB=QBLK*NW,KVBLK=64,NQB=SEQ/QB;
constexpr int ATTN_UNIT_ROWS=QB;
__device__ __forceinline__ int crow(int r,int hi){return (r&3)+8*(r>>2)+4*hi;}
#define SBAR() __builtin_amdgcn_sched_barrier(0)
__device__ __forceinline__ void cmask(f32x16&p0,f32x16&p1,int jb,int qrel,int hi){
  const float NEG=-INFINITY; int kb=64*jb+4*hi;
  #pragma unroll
  for(int r=0;r<16;++r){int kv=kb+(r&3)+8*(r>>2); if(kv>qrel)p0[r]=NEG; if(kv+32>qrel)p1[r]=NEG;}
}

constexpr int NSLOT=3, SLOTB=8192;
constexpr int LDS_K=0, LDS_V=NSLOT*SLOTB, LDS_WS=2*NSLOT*SLOTB, LDS_OST=LDS_WS+NW*64*4, LDS_BYTES=LDS_OST+NW*4096;
constexpr float C2=0.125f*1.4426950408889634f;
__device__ __forceinline__ void glds16(const void*gsrc,unsigned lds_dst){unsigned keep;
  asm volatile("s_mov_b32 %0, m0\n\ts_mov_b32 m0, %2\n\ts_nop 0\n\tglobal_load_lds_dwordx4 %1, off\n\ts_mov_b32 m0, %0":"=&s"(keep):"v"(gsrc),"s"(lds_dst):"memory");}
__device__ __forceinline__ void glds16s(const void*gbase,unsigned voff,unsigned lds_dst){unsigned keep;
  asm volatile("s_mov_b32 %0, m0\n\ts_mov_b32 m0, %2\n\ts_nop 0\n\tglobal_load_lds_dwordx4 %1, %3\n\ts_mov_b32 m0, %0":"=&s"(keep):"v"(voff),"s"(lds_dst),"s"(gbase):"memory");}
__device__ __forceinline__ float max3f(float a,float b,float c){float r;asm("v_max3_f32 %0, %1, %2, %3":"=v"(r):"v"(a),"v"(b),"v"(c));return r;}
__device__ __forceinline__ float max2f(float a,float b){float r;asm("v_max_f32_e32 %0, %1, %2":"=v"(r):"v"(a),"v"(b));return r;}
__device__ __forceinline__ float fadd_s(float a,float b){float r;asm("v_add_f32_e32 %0, %1, %2":"=v"(r):"v"(a),"v"(b));return r;}
__device__ __forceinline__ float fsub_s(float a,float b){float r;asm("v_sub_f32_e32 %0, %1, %2":"=v"(r):"v"(a),"v"(b));return r;}
typedef float f32x2_t __attribute__((ext_vector_type(2))); typedef __bf16 bf16x2_t __attribute__((ext_vector_type(2)));
__device__ __forceinline__ unsigned cvtpk_s(float lo,float hi){f32x2_t v={lo,hi};bf16x2_t b=__builtin_convertvector(v,bf16x2_t);return __builtin_bit_cast(unsigned,b);}
#define WAIT_BAR(N) asm volatile("s_waitcnt vmcnt(" #N ") lgkmcnt(0)\n\ts_barrier":::"memory")

__device__ __forceinline__ void qkt(f32x16&p0,f32x16&p1,const char*Kslot,const bf16x8*qr,const f32x16&negm,int r32,int hi){
  const char*kb=Kslot+hi*1024+r32*16;
  #pragma unroll
  for(int d0=0;d0<4;++d0){
    const bf16x8 b0=*reinterpret_cast<const bf16x8*>(kb+d0*2048);
    const bf16x8 b1=*reinterpret_cast<const bf16x8*>(kb+d0*2048+512);
    if(d0==0){p0=__builtin_amdgcn_mfma_f32_32x32x16_bf16(b0,qr[0],negm,0,0,0);p1=__builtin_amdgcn_mfma_f32_32x32x16_bf16(b1,qr[0],negm,0,0,0);}
    else{p0=__builtin_amdgcn_mfma_f32_32x32x16_bf16(b0,qr[d0],p0,0,0,0);p1=__builtin_amdgcn_mfma_f32_32x32x16_bf16(b1,qr[d0],p1,0,0,0);}}
}
typedef __attribute__((address_space(3))) const char* lds_cptr;
typedef short v4i16_t __attribute__((ext_vector_type(4)));
__device__ __forceinline__ void kload8(bf16x8*kf,lds_cptr kp){
  kf[0]=*(const __attribute__((address_space(3))) bf16x8*)(kp);      kf[1]=*(const __attribute__((address_space(3))) bf16x8*)(kp+512);
  kf[2]=*(const __attribute__((address_space(3))) bf16x8*)(kp+2048); kf[3]=*(const __attribute__((address_space(3))) bf16x8*)(kp+2560);
  kf[4]=*(const __attribute__((address_space(3))) bf16x8*)(kp+4096); kf[5]=*(const __attribute__((address_space(3))) bf16x8*)(kp+4608);
  kf[6]=*(const __attribute__((address_space(3))) bf16x8*)(kp+6144); kf[7]=*(const __attribute__((address_space(3))) bf16x8*)(kp+6656);
}
__device__ __forceinline__ void kload2(bf16x8*kf,lds_cptr kp,int j){ kf[2*j]=*(const __attribute__((address_space(3))) bf16x8*)(kp+j*2048); kf[2*j+1]=*(const __attribute__((address_space(3))) bf16x8*)(kp+j*2048+512); }
__device__ __forceinline__ s16x4 vtr(lds_cptr p){ return __builtin_bit_cast(s16x4,__builtin_amdgcn_ds_read_tr16_b64_v4i16((__attribute__((address_space(3))) v4i16_t*)p)); }
__device__ __forceinline__ float rowmax(const f32x16&p0,const f32x16&p1){
  float a=max3f(p0[0],p0[1],p1[0]),b=max3f(p0[2],p0[3],p1[1]);a=max3f(a,p1[2],p1[3]);
  #pragma unroll
  for(int r=4;r<16;r+=4){a=max3f(a,p0[r],p0[r+1]);b=max3f(b,p0[r+2],p0[r+3]);a=max3f(a,p1[r],p1[r+1]);b=max3f(b,p1[r+2],p1[r+3]);}
  const float m=max2f(a,b);
  auto rr=__builtin_amdgcn_permlane32_swap(__float_as_uint(m),__float_as_uint(m),false,false);
  return max2f(__uint_as_float(rr[0]),__uint_as_float(rr[1]));
}
#ifndef ATTN_STORE16
#define ATTN_STORE16(p,v) (*(u32x4*)(p)=(v))
#endif
constexpr int VSLOTB=16384, LDS2_V=NSLOT*SLOTB, LDS2_WS=LDS2_V+NSLOT*VSLOTB, LDS2_OST=LDS2_WS+NW*64*4, LDS2_BYTES=LDS2_OST+NW*8192;
__device__ __forceinline__ void pv128(f32x16*o,int vb,bf16x8 pa0,bf16x8 pa1,bf16x8 pa2,bf16x8 pa3){
  #pragma unroll
  for(int d0=0;d0<4;++d0){s16x4 lo[4],hi[4];
    #pragma unroll
    for(int ks=0;ks<4;++ks){
      asm volatile("ds_read_b64_tr_b16 %0,%1 offset:%c2":"=&v"(lo[ks]):"v"(vb),"i"(d0*4096+ks*1024):"memory");
      asm volatile("ds_read_b64_tr_b16 %0,%1 offset:%c2":"=&v"(hi[ks]):"v"(vb),"i"(d0*4096+ks*1024+512):"memory");}
    asm volatile("s_waitcnt lgkmcnt(0)":::"memory");SBAR();
    #define PK(k) (bf16x8){lo[k][0],lo[k][1],lo[k][2],lo[k][3],hi[k][0],hi[k][1],hi[k][2],hi[k][3]}
    o[d0]=__builtin_amdgcn_mfma_f32_32x32x16_bf16(pa0,PK(0),o[d0],0,0,0);
    o[d0]=__builtin_amdgcn_mfma_f32_32x32x16_bf16(pa1,PK(1),o[d0],0,0,0);
    o[d0]=__builtin_amdgcn_mfma_f32_32x32x16_bf16(pa2,PK(2),o[d0],0,0,0);
    o[d0]=__builtin_amdgcn_mfma_f32_32x32x16_bf16(pa3,PK(3),o[d0],0,0,0);
    #undef PK
  }
}
template<int THRL> __device__ __forceinline__ void attn_unit128(int b,int qb,const bf16*Q,const bf16*__restrict__ K,const bf16*__restrict__ V,bf16*O,char*shm){
  const int tid=threadIdx.x,lane=tid&63,r32=lane&31,hi=lane>>5; const int wid=__builtin_amdgcn_readfirstlane(tid>>6);
  const long rowbase=(long)b*SEQ; const int q0=qb*QB;
  const bf16*Qw=Q+(rowbase+q0+wid*QBLK)*PQ;
  const bf16*Kh=K+rowbase*PQ,*Vh=V+rowbase*PQ;
  const unsigned lds0=(unsigned)(uintptr_t)shm;
  float*wsf=(float*)(shm+LDS2_WS)+wid*64;
  const bf16*ksrc=Kh+wid*8; const unsigned koff=(unsigned)lane*(PQ*2);
  const bf16*vsrc=Vh+(long)(16*(wid&3))*PQ+(wid>>2)*32; const unsigned voff=(unsigned)(lane>>2)*(PQ*2)+(unsigned)(lane&3)*16;
  const unsigned kdst=lds0+LDS_K+wid*1024, vdst=lds0+LDS2_V+wid*1024;
  #define DMA_K(t,slot) glds16s(ksrc+(long)(t)*KVBLK*PQ,koff,(unsigned)__builtin_amdgcn_readfirstlane(kdst+(slot)))
  #define DMA_V(t,slot) do{ glds16s(vsrc+(long)(t)*KVBLK*PQ,voff,(unsigned)__builtin_amdgcn_readfirstlane(vdst+2*(slot))); glds16s(vsrc+(long)(t)*KVBLK*PQ+64,voff,(unsigned)__builtin_amdgcn_readfirstlane(vdst+2*(slot)+8192)); }while(0)
  const char*Kbase=shm+LDS_K; bf16x8 kf[8];
  const lds_cptr shm3=(lds_cptr)shm; const lds_cptr kp0=shm3+LDS_K+hi*1024+r32*16; const lds_cptr vp0=shm3+LDS2_V+((lane>>4)&1)*32+(lane&3)*8+(4*hi+((lane&15)>>2))*64;
  const int NT=(q0+QB)/KVBLK;
  DMA_K(0,0);DMA_V(0,0);DMA_K(1,SLOTB);
  bf16x8 qr[4];
  #pragma unroll
  for(int d0=0;d0<4;++d0)qr[d0]=*reinterpret_cast<const bf16x8*>(&Qw[(long)r32*PQ+d0*16+hi*8]);
  float mhat=0.f,l_reg=0.f;f32x16 o[4];o[0]=f32x16{};o[1]=f32x16{};o[2]=f32x16{};o[3]=f32x16{};const f32x16 zz=f32x16{};
  const int qrel=wid*QBLK+r32;
  #define CMASK(P0,P1,t) do{int jb_=(t)-(NT-4); if(jb_>=0)cmask(P0,P1,jb_,qrel,hi);}while(0)
  bool resc=false;
  #define START(P0,P1) do{ const float rm=rowmax(P0,P1); resc=false; \
    mhat=rm; \
    _Pragma("unroll") for(int r=0;r<16;++r)P0[r]=__builtin_amdgcn_exp2f(P0[r]-mhat); }while(0)
  #define RESC() do{ if(resc){ asm volatile("s_waitcnt lgkmcnt(0)":::"memory"); \
      _Pragma("unroll") for(int d_=0;d_<4;++d_) _Pragma("unroll") for(int r=0;r<16;++r)o[d_][r]*=wsf[crow(r,hi)]; } }while(0)
  f32x16 pA0,pA1,pB0,pB1;
  int sl_prev=0,sl_cur=0,sl_next=SLOTB;
  #define ROT() do{sl_prev=sl_cur;sl_cur=sl_next;sl_next=(sl_next==(NSLOT-1)*SLOTB)?0:sl_next+SLOTB;}while(0)
  DMA_K(2,2*SLOTB);
  WAIT_BAR(3);
  qkt(pA0,pA1,Kbase,qr,zz,r32,hi);asm volatile("s_nop 15\n\ts_nop 7":"+v"(pA0),"+v"(pA1));CMASK(pA0,pA1,0);
  START(pA0,pA1);
  _Pragma("unroll") for(int r=0;r<16;++r)pA1[r]=__builtin_amdgcn_exp2f(pA1[r]-mhat);
  WAIT_BAR(0);
  DMA_K(3,0);DMA_V(1,SLOTB);
  ROT();
  kload8(kf,kp0+sl_cur);
  WAIT_BAR(3);
  s16x4 vlo[4],vhi[4]; u32x4 pw0,pw1,pw2,pw3;
  #define PKW(P,B) cvtpk_s(P[B],P[B+1])
  #define PAF(k) __builtin_bit_cast(bf16x8,pw##k)
  #define FIDX(j) ((((j)&7)>>1)+4*((j)&1)+8*((j)>>3))
  #define VOFF(f) (((f)>>2)*4096+((f)&3)*1024)
  #define VRDJ(j) do{ vlo[(j)&3]=vtr(vp_+VOFF(FIDX(j))); vhi[(j)&3]=vtr(vp_+(VOFF(FIDX(j))+512)); SBAR(); }while(0)
  #define VFJ(j) (bf16x8){vlo[(j)&3][0],vlo[(j)&3][1],vlo[(j)&3][2],vlo[(j)&3][3],vhi[(j)&3][0],vhi[(j)&3][1],vhi[(j)&3][2],vhi[(j)&3][3]}
  #define PIN(x) asm volatile("":"+v"(x))
  #define MX3(a,b,c) __builtin_fmaxf(__builtin_fmaxf((a),(b)),(c))
  #define GAPA(MF,A0,A1,A2,A3,W0,W1,PW) do{ MF; sacc+=A0; sacc+=A1; sacc+=A2; sacc+=A3; PIN(sacc); W0; W1; PIN(PW); SBAR(); }while(0)
  #define EX(v) __builtin_amdgcn_exp2f(v)
  #define GAPB2(MF,X,B) do{ MF; X[B]=EX(X[B]-mhat); X[B+1]=EX(X[B+1]-mhat); PIN(X); SBAR(); }while(0)
  #define KRD(G,j) do{ if(G){ kload2(kf,kp0+sl_next,j); SBAR(); } }while(0)
  #define STEP(C0,C1,P0,P1,t,GK,GV,GL) do{ SBAR(); \
    const lds_cptr vp_=vp0+2*sl_prev; \
    float sacc=(P0[0]+P0[1]); \
    GAPA(C0=__builtin_amdgcn_mfma_f32_32x32x16_bf16(kf[0],qr[0],zz,0,0,0), P0[2],P0[3],P0[4],P0[5], pw0[0]=PKW(P0,0), pw0[1]=PKW(P0,2), pw0); \
    GAPA(C1=__builtin_amdgcn_mfma_f32_32x32x16_bf16(kf[1],qr[0],zz,0,0,0), P0[6],P0[7],P0[8],P0[9], pw0[2]=PKW(P0,4), pw0[3]=PKW(P0,6), pw0); \
    GAPA(C0=__builtin_amdgcn_mfma_f32_32x32x16_bf16(kf[2],qr[1],C0,0,0,0), P0[10],P0[11],P0[12],P0[13], pw1[0]=PKW(P0,8), pw1[1]=PKW(P0,10), pw1); \
    GAPA(C1=__builtin_amdgcn_mfma_f32_32x32x16_bf16(kf[3],qr[1],C1,0,0,0), P0[14],P0[15],P1[0],P1[1], pw1[2]=PKW(P0,12),pw1[3]=PKW(P0,14), pw1); \
    GAPA(C0=__builtin_amdgcn_mfma_f32_32x32x16_bf16(kf[4],qr[2],C0,0,0,0), P1[2],P1[3],P1[4],P1[5], pw2[0]=PKW(P1,0), pw2[1]=PKW(P1,2), pw2); \
    GAPA(C1=__builtin_amdgcn_mfma_f32_32x32x16_bf16(kf[5],qr[2],C1,0,0,0), P1[6],P1[7],P1[8],P1[9], pw2[2]=PKW(P1,4), pw2[3]=PKW(P1,6), pw2); \
    GAPA(C0=__builtin_amdgcn_mfma_f32_32x32x16_bf16(kf[6],qr[3],C0,0,0,0), P1[10],P1[11],P1[12],P1[13], pw3[0]=PKW(P1,8), pw3[1]=PKW(P1,10), pw3); \
    GAPA(C1=__builtin_amdgcn_mfma_f32_32x32x16_bf16(kf[7],qr[3],C1,0,0,0), P1[14],P1[15],0.f,0.f, pw3[2]=PKW(P1,12),pw3[3]=PKW(P1,14), pw3); \
    l_reg+=sacc; \
    if(GK){DMA_K((t)+3,sl_cur);} if(GV){DMA_V((t)+1,sl_next);} \
    VRDJ(0); VRDJ(1); VRDJ(2); \
    CMASK(C0,C1,t); \
    { float a=MX3(C0[0],C0[1],C1[0]),b=MX3(C0[2],C0[3],C1[1]); a=MX3(a,C1[2],C1[3]); \
      _Pragma("unroll") for(int r=4;r<16;r+=4){a=MX3(a,C0[r],C0[r+1]);b=MX3(b,C0[r+2],C0[r+3]);a=MX3(a,C1[r],C1[r+1]);b=MX3(b,C1[r+2],C1[r+3]);} \
      float rm=__builtin_fmaxf(a,b); { auto rr=__builtin_amdgcn_permlane32_swap(__float_as_uint(rm),__float_as_uint(rm),false,false); rm=__builtin_fmaxf(__uint_as_float(rr[0]),__uint_as_float(rr[1])); } \
      resc=false; \
      rm-=mhat; \
      if(__builtin_expect(__any(rm>(float)THRL),0)){ const float dl=__builtin_fmaxf(rm,0.f); mhat+=dl; \
        const float f=__builtin_amdgcn_exp2f(-dl); l_reg*=f; if(hi==0)wsf[r32]=f; resc=true; } } \
    SBAR(); \
    GAPB2(o[0]=__builtin_amdgcn_mfma_f32_32x32x16_bf16(PAF(0),VFJ(0),o[0],0,0,0), C0,0); VRDJ(3); \
    GAPB2(o[1]=__builtin_amdgcn_mfma_f32_32x32x16_bf16(PAF(0),VFJ(1),o[1],0,0,0), C0,2); VRDJ(4); \
    KRD(GL,0); GAPB2(o[0]=__builtin_amdgcn_mfma_f32_32x32x16_bf16(PAF(1),VFJ(2),o[0],0,0,0), C0,4); VRDJ(5); \
    KRD(GL,1); GAPB2(o[1]=__builtin_amdgcn_mfma_f32_32x32x16_bf16(PAF(1),VFJ(3),o[1],0,0,0), C0,6); VRDJ(6); \
    KRD(GL,2); GAPB2(o[0]=__builtin_amdgcn_mfma_f32_32x32x16_bf16(PAF(2),VFJ(4),o[0],0,0,0), C0,8); VRDJ(7); \
    KRD(GL,3); GAPB2(o[1]=__builtin_amdgcn_mfma_f32_32x32x16_bf16(PAF(2),VFJ(5),o[1],0,0,0), C0,10); VRDJ(8); \
    GAPB2(o[0]=__builtin_amdgcn_mfma_f32_32x32x16_bf16(PAF(3),VFJ(6),o[0],0,0,0), C0,12); VRDJ(9); \
    GAPB2(o[1]=__builtin_amdgcn_mfma_f32_32x32x16_bf16(PAF(3),VFJ(7),o[1],0,0,0), C0,14); VRDJ(10); \
    GAPB2(o[2]=__builtin_amdgcn_mfma_f32_32x32x16_bf16(PAF(0),VFJ(8),o[2],0,0,0), C1,0); VRDJ(11); \
    GAPB2(o[3]=__builtin_amdgcn_mfma_f32_32x32x16_bf16(PAF(0),VFJ(9),o[3],0,0,0), C1,2); VRDJ(12); \
    GAPB2(o[2]=__builtin_amdgcn_mfma_f32_32x32x16_bf16(PAF(1),VFJ(10),o[2],0,0,0), C1,4); VRDJ(13); \
    GAPB2(o[3]=__builtin_amdgcn_mfma_f32_32x32x16_bf16(PAF(1),VFJ(11),o[3],0,0,0), C1,6); VRDJ(14); \
    GAPB2(o[2]=__builtin_amdgcn_mfma_f32_32x32x16_bf16(PAF(2),VFJ(12),o[2],0,0,0), C1,8); VRDJ(15); \
    GAPB2(o[3]=__builtin_amdgcn_mfma_f32_32x32x16_bf16(PAF(2),VFJ(13),o[3],0,0,0), C1,10); \
    GAPB2(o[2]=__builtin_amdgcn_mfma_f32_32x32x16_bf16(PAF(3),VFJ(14),o[2],0,0,0), C1,12); \
    GAPB2(o[3]=__builtin_amdgcn_mfma_f32_32x32x16_bf16(PAF(3),VFJ(15),o[3],0,0,0), C1,14); \
    }while(0)
  int t=1;
  #undef CMASK
  #define CMASK(P0,P1,t) do{}while(0)
  for(;t+5<NT;t+=2){
    STEP(pB0,pB1,pA0,pA1,t,true,true,true);     WAIT_BAR(3); RESC(); ROT();
    STEP(pA0,pA1,pB0,pB1,t+1,true,true,true);   WAIT_BAR(3); RESC(); ROT();
  }
  #undef CMASK
  #define CMASK(P0,P1,t) do{int jb_=(t)-(NT-4); if(jb_>=0)cmask(P0,P1,jb_,qrel,hi);}while(0)
  #define ENDW(tt) do{ if((tt)+3<NT){WAIT_BAR(3);} else if((tt)+2<NT){WAIT_BAR(2);} else {WAIT_BAR(0);} }while(0)
  for(;t+1<NT;t+=2){
    STEP(pB0,pB1,pA0,pA1,t,(t+3<NT),(t+1<NT),(t+1<NT));       ENDW(t);   RESC(); ROT();
    STEP(pA0,pA1,pB0,pB1,t+1,(t+4<NT),(t+2<NT),(t+2<NT));     ENDW(t+1); RESC(); ROT();
  }
  STEP(pB0,pB1,pA0,pA1,NT-1,false,false,false); RESC();
  { float sacc=pB0[0]+pB0[1]; _Pragma("unroll") for(int r=2;r<16;++r)sacc+=pB0[r]; _Pragma("unroll") for(int r=0;r<16;++r)sacc+=pB1[r]; l_reg+=sacc;
    pw0=(u32x4){PKW(pB0,0),PKW(pB0,2),PKW(pB0,4),PKW(pB0,6)};pw1=(u32x4){PKW(pB0,8),PKW(pB0,10),PKW(pB0,12),PKW(pB0,14)};pw2=(u32x4){PKW(pB1,0),PKW(pB1,2),PKW(pB1,4),PKW(pB1,6)};pw3=(u32x4){PKW(pB1,8),PKW(pB1,10),PKW(pB1,12),PKW(pB1,14)};
    SBAR(); pv128(o,(int)(unsigned)(uintptr_t)vp0+2*sl_cur,PAF(0),PAF(1),PAF(2),PAF(3)); }
  #undef PKW
  #undef PAF
  #undef PIN
  #undef MX3
  #undef GAPA
  #undef EX
  #undef VRDJ
  #undef VFJ
  #undef FIDX
  #undef VOFF
  #undef GAPB2
  #undef KRD
  #undef STEP
  #undef ENDW
  int lane_e=lane; asm volatile("":"+v"(lane_e)); const int r32e=lane_e&31,hie=lane_e>>5;
  {auto rr=__builtin_amdgcn_permlane32_swap(__float_as_uint(l_reg),__float_as_uint(l_reg),false,false);l_reg=__uint_as_float(rr[0])+__uint_as_float(rr[1]);}
  if(hie==0)wsf[32+r32e]=l_reg;asm volatile("s_waitcnt lgkmcnt(0)":::"memory");
  float rli[16];
  #pragma unroll
  for(int r=0;r<16;++r)rli[r]=__builtin_amdgcn_rcpf(wsf[32+crow(r,hie)]);
  bf16*Ow=O+(rowbase+q0+wid*QBLK)*PO;
  { bf16*stg=(bf16*)(shm+LDS2_OST)+wid*4096;
    #pragma unroll
    for(int r=0;r<16;++r){const int orow=crow(r,hie);
      #pragma unroll
      for(int d0=0;d0<4;++d0)stg[orow*128+d0*32+r32e]=__float2bfloat16(o[d0][r]*rli[r]);}
    asm volatile("s_waitcnt lgkmcnt(0)":::"memory");
    #pragma unroll
    for(int i=0;i<8;++i){const int row=i*4+(lane_e>>4),ch=lane_e&15; const u32x4 v=*(const u32x4*)(stg+row*128+ch*8); ATTN_STORE16(Ow+(long)row*PO+ch*8,v);} }
  asm volatile("s_waitcnt lgkmcnt(0)\n\ts_barrier":::"memory");
  #undef DMA_K
  #undef DMA_V
  #undef CMASK
  #undef START
  #undef RESC
  #undef ROT
}
constexpr int ATTN_LDS_BYTES=LDS2_BYTES;
#undef SBAR
#undef WAIT_BAR
}
#define GAS __attribute__((address_space(1)))
#define LAS __attribute__((address_space(3)))
typedef unsigned short bf16;
typedef unsigned v4u __attribute__((ext_vector_type(4)));
typedef float f32x4 __attribute__((ext_vector_type(4)));
typedef short bf16x8 __attribute__((ext_vector_type(8)));
typedef GAS unsigned gu32;
typedef GAS unsigned long long gu64;
#define RLX_AGENT __ATOMIC_RELAXED, __HIP_MEMORY_SCOPE_AGENT
#define LDS_WAIT() asm volatile("s_waitcnt lgkmcnt(0)" ::: "memory")
#define VM_WAIT() asm volatile("s_waitcnt vmcnt(0)" ::: "memory")
__device__ __forceinline__ unsigned long long rt() { return __builtin_amdgcn_s_memrealtime(); }
__device__ __forceinline__ unsigned f2bf(float f) { unsigned u = __builtin_bit_cast(unsigned, f); return (u + 0x7fffu + ((u >> 16) & 1u)) >> 16; }
__device__ __forceinline__ unsigned pk2(float lo, float hi) { return f2bf(lo) | (f2bf(hi) << 16); }

#define XB_TMO      128
#define XB_XCNT(j)  (256  + 64 * (j))
#define XB_XSUB(j)  (1280 + 64 * (j))
#define XB_XGEN(j)  (2304 + 64 * (j))
#define XB_TOP      3328
#define XB_TOPGEN   3392
#define XCD_BAR_WORDS 3456
#define XB_SPIN_CAP (1u << 18)

__device__ __forceinline__ unsigned xb_ld(unsigned* p)              { return __hip_atomic_load(p, __ATOMIC_RELAXED, __HIP_MEMORY_SCOPE_AGENT); }
__device__ __forceinline__ unsigned xb_add(unsigned* p, unsigned v) { return __hip_atomic_fetch_add(p, v, __ATOMIC_RELAXED, __HIP_MEMORY_SCOPE_AGENT); }
__device__ __forceinline__ unsigned xb_xcc_id() { return (unsigned)__builtin_amdgcn_s_getreg((3 << 11) | 20) & 0xFu; }
#define XB_SPIN(cond, bar) do { unsigned _sp = 0; while (cond) { __builtin_amdgcn_s_sleep(1); \
    if ((++_sp & 255u) == 0u) { if (xb_ld(&(bar)[XB_TMO])) break; if (_sp > XB_SPIN_CAP) { atomicAdd(&(bar)[XB_TMO], 1u); break; } } } } while (0)

struct XcdBarrier {
    unsigned* bar; unsigned x;
    volatile LAS unsigned* st;
};

__device__ __forceinline__ XcdBarrier xcd_barrier_post(unsigned* bar, volatile LAS unsigned* st) {
    XcdBarrier b; b.bar = bar; b.x = xb_xcc_id(); b.st = st;
    if (threadIdx.x == 0) (void)xb_add(&bar[XB_XCNT(b.x)], 1u);
    return b;
}
__device__ __forceinline__ void xcd_barrier_complete(unsigned* bar, unsigned x, unsigned& nloc, unsigned& nx) {
    const unsigned G = gridDim.x * gridDim.y * gridDim.z;
    unsigned sum, cnt, mine, sp = 0u;
    for (;;) {
        sum = 0u; cnt = 0u; mine = 0u;
#pragma unroll
        for (unsigned j = 0; j < 16; ++j) { const unsigned c = xb_ld(&bar[XB_XCNT(j)]); sum += c; cnt += (c > 0u) ? 1u : 0u; mine = (j == x) ? c : mine; }
        if (sum == G) break;
        __builtin_amdgcn_s_sleep(1);
        if ((++sp & 255u) == 0u) { if (xb_ld(&bar[XB_TMO])) break; if (sp > XB_SPIN_CAP) { atomicAdd(&bar[XB_TMO], 1u); break; } }
    }
    nloc = mine > 0u ? mine : 1u; nx = cnt > 0u ? cnt : 1u;
}

__device__ __forceinline__ void xcd_barrier(const XcdBarrier& b) {
    asm volatile("s_waitcnt vmcnt(0)" ::: "memory");
    __syncthreads();
    if (threadIdx.x == 0) {
        unsigned* bar = b.bar;
        __builtin_amdgcn_s_waitcnt(0);
        unsigned nloc = b.st[0], nx = b.st[1];
        if (nloc == 0u) { xcd_barrier_complete(bar, b.x, nloc, nx); b.st[0] = nloc; b.st[1] = nx; }
        const unsigned kgen = b.st[2]; b.st[2] = kgen + 1u;
        const unsigned old = xb_add(&bar[XB_XSUB(b.x)], 1u);
        const unsigned gen = old / nloc;
        if (old + 1u == (gen + 1u) * nloc) {
            __builtin_amdgcn_fence(__ATOMIC_RELEASE, "agent");
            asm volatile("s_waitcnt vmcnt(0)" ::: "memory");
            const unsigned og = xb_add(&bar[XB_TOP], 1u);
            const unsigned tg = og / nx;
            if (og + 1u == (tg + 1u) * nx) xb_add(&bar[XB_TOPGEN], 1u);
            else XB_SPIN(xb_ld(&bar[XB_TOPGEN]) == tg, bar);
            __builtin_amdgcn_fence(__ATOMIC_ACQUIRE, "agent");
            asm volatile("s_waitcnt vmcnt(0)" ::: "memory");
        } else {
            XB_SPIN(xb_ld(&bar[XB_TOPGEN]) == kgen, bar);
            __builtin_amdgcn_fence(__ATOMIC_ACQUIRE, "agent");
            asm volatile("s_waitcnt vmcnt(0)" ::: "memory");
        }
    }
    __syncthreads();
}
constexpr int NWAVES = 8;
constexpr int BATCH = 4, SEQ = 8192, T = BATCH * SEQ, D = 1024;
constexpr int IN_COLS = 3328, RW_OFF = 1536, RWW = 512;
constexpr int NEXP = 32, TOPK = 4;
constexpr int P_MAX = T * TOPK + NEXP * 256, MAX_TILES = P_MAX / 256;
constexpr float NORM_EPS = 1e-5f, GN_EPS = 64e-5f, LAM_INIT = 0.2f;
constexpr size_t MiB = 1u << 20;
constexpr size_t WS_CTL = 0, CTL_ZERO_BYTES = 128 * 1024;
constexpr size_t WS_BS = 1 * MiB;
constexpr size_t WS_TOPI = 2 * MiB, WS_GATE = 2 * MiB + 512 * 1024, WS_POS = 3 * MiB;
constexpr size_t WS_CS = 96 * MiB;
constexpr size_t WS_RSRC = 104 * MiB, WS_RGATE = 108 * MiB;
constexpr size_t WS_RWS = 6 * MiB;
constexpr size_t WS_WO = 8 * MiB, WS_WL = 10 * MiB, WS_WIN = 11 * MiB, WS_W1 = 18 * MiB, WS_W2 = 146 * MiB;
constexpr size_t WS_PB = 210 * MiB;
constexpr size_t WS_YB = 418 * MiB;
constexpr size_t WS_LG = 482 * MiB;
constexpr size_t WS_AO = 514 * MiB;
constexpr size_t WS_FR = 706 * MiB;
constexpr size_t WS_XN = 902 * MiB;
constexpr size_t WS_X1 = 210 * MiB;
constexpr size_t WS_H2 = 338 * MiB;
constexpr size_t WS_ACT = 674 * MiB;
constexpr size_t WS_YS = 402 * MiB;
constexpr size_t WS_END = 1024 * MiB;
static_assert(WS_ACT + (size_t)P_MAX * 2048 <= WS_END && WS_YS + (size_t)T * 4 * 2048 <= WS_ACT && WS_XN + (size_t)T * 2048 <= WS_END && WS_FR + (size_t)BATCH * 8 * (SEQ / 16) * 12544 <= WS_XN && WS_AO + (size_t)T * 2048 <= WS_FR, "ws map");
constexpr int CW_TMO = 0, CW_CNT = 64, CW_WQ = 128, CW_DONE5 = 192, CW_AQ = 256, CW_BAR = 4096;
constexpr int RING_OFF = 0, RING_BYTES = 147456;
constexpr int LDSCTL_OFF = RING_BYTES, MISC_OFF = LDSCTL_OFF + 320;
constexpr int HIST_OFF = LDSCTL_OFF + 512, HBASE_OFF = LDSCTL_OFF + 640, PST_OFF = LDSCTL_OFF + 768, TILE_OFF = LDSCTL_OFF + 1024;
constexpr int LDS_BYTES = 163840;
static_assert(TILE_OFF + 4 * (MAX_TILES + 32) <= LDS_BYTES, "LDS map");
struct Args {
    const float* x; const int* positions; const float* attn_norm_w; const float* w_in; const float* shift_mu;
    const float *lq1, *lk1, *lq2, *lk2; const float* subln_w;
    const float *rw_w0, *rw_w2, *rw_a0, *rw_a2, *rw_g2, *rw_k_k, *rw_k_a, *rw_r_k, *rw_lnx_w, *rw_lnx_b;
    const float* w_out; const float* ffn_norm_w; const float* router_w; const float* router_b;
    const float *mlp1_w, *mlp1_b, *mlp2_w, *mlp2_b; const float* final_norm_w;
    float* out; unsigned char* ws; int ph_lo, ph_hi;
};
struct Frame { LAS unsigned char* lds; int tid, lane, wave, vcu, G; };
__device__ __forceinline__ Frame fresh(const Frame& F) { Frame G = F; G.tid = (int)__builtin_amdgcn_workitem_id_x(); asm volatile("" : "+v"(G.tid)); G.lane = G.tid & 63; return G; }
typedef const __attribute__((address_space(4))) Args* KArgs;
__device__ __forceinline__ KArgs get_args() { unsigned long long p = (unsigned long long)__builtin_amdgcn_kernarg_segment_ptr(); asm volatile("" : "+s"(p)); return (KArgs)p; }

__device__ __forceinline__ float wave_sum(float v) {
#pragma unroll
    for (int o = 1; o < 64; o <<= 1) v += __shfl_xor(v, o);
    return v;
}
__device__ __forceinline__ float bf2f(unsigned short h) { return __builtin_bit_cast(float, (unsigned)h << 16); }
__device__ __forceinline__ float bflo(unsigned w) { return __builtin_bit_cast(float, w << 16); }
__device__ __forceinline__ float bfhi(unsigned w) { return __builtin_bit_cast(float, w & 0xffff0000u); }
__device__ __forceinline__ float sigmoidf_(float v) { return 1.0f / (1.0f + __expf(-v)); }
typedef unsigned u32x2 __attribute__((ext_vector_type(2)));
__device__ __forceinline__ unsigned cvtpk(float lo, float hi) { return attn_body::cvtpk_s(lo, hi); }
typedef float f32x16 __attribute__((ext_vector_type(16)));

struct TrItem { f32x4 v[8]; };
__device__ __forceinline__ void tr_load(TrItem& t, const float* W, int N, int item, int lane) {
    const int nblk = N / 32, kb = item / nblk, nb = item % nblk, k0 = 64 * kb, n0 = 32 * nb; const int r = lane >> 3, c4 = (lane & 7) * 4;
#pragma unroll
    for (int p = 0; p < 8; ++p) t.v[p] = *(const f32x4*)(W + (size_t)(k0 + 8 * p + r) * N + n0 + c4);
}
__device__ __forceinline__ void tr_store(const TrItem& t, int K, int N, bf16* WT, LAS float* scr, int item, int lane) {
    LAS unsigned short* T = (LAS unsigned short*)scr; constexpr int PT = 40;
    const int nblk = N / 32, kb = item / nblk, nb = item % nblk, k0 = 64 * kb, n0 = 32 * nb; const int r = lane >> 3, c4 = (lane & 7) * 4;
#pragma unroll
    for (int p = 0; p < 8; ++p) { u32x2 w; w.x = cvtpk(t.v[p][0], t.v[p][1]); w.y = cvtpk(t.v[p][2], t.v[p][3]); *(LAS u32x2*)(T + (8 * p + r) * PT + c4) = w; }
    LDS_WAIT(); asm volatile("" ::: "memory");
    const int gq = lane >> 4, i = lane & 15, q = i >> 2, p4 = (i & 3) * 4, nbk = 16 * (gq & 1);
    const attn_body::lds_cptr tb = (attn_body::lds_cptr)(T + (8 * (gq >> 1) + q) * PT + nbk + p4);
#pragma unroll
    for (int rd = 0; rd < 4; ++rd) {
        const attn_body::s16x4 lo = attn_body::vtr(tb + (16 * rd) * PT * 2), hi = attn_body::vtr(tb + (16 * rd + 4) * PT * 2);
        v4u o; o.x = __builtin_bit_cast(u32x2, lo).x; o.y = __builtin_bit_cast(u32x2, lo).y; o.z = __builtin_bit_cast(u32x2, hi).x; o.w = __builtin_bit_cast(u32x2, hi).y;
        *(GAS v4u*)(WT + (size_t)(n0 + nbk + i) * K + k0 + 16 * rd + 8 * (gq >> 1)) = o; }
    LDS_WAIT(); asm volatile("" ::: "memory");
}
__device__ __forceinline__ void p0_transpose_item(const float* W, int K, int N, bf16* WT, LAS float* scr, int item, int lane) { TrItem t; tr_load(t, W, N, item, lane); tr_store(t, K, N, WT, scr, item, lane); }
__device__ __forceinline__ void tr_store8(const TrItem& t, int K, int N, unsigned char* WT, LAS float* scr, int item, int lane, float scale) {
    constexpr int PT = 36;
    const int nblk = N / 32, kb = item / nblk, nb = item % nblk, k0 = 64 * kb, n0 = 32 * nb; const int r = lane >> 3, c4 = (lane & 7) * 4;
#pragma unroll
    for (int p = 0; p < 8; ++p) *(LAS f32x4*)(scr + (8 * p + r) * PT + c4) = t.v[p] * scale;
    LDS_WAIT(); asm volatile("" ::: "memory");
    const int n = lane & 31, kh = lane >> 5; const LAS float* col = scr + (32 * kh) * PT + n;
    v4u o[2];
#pragma unroll
    for (int q = 0; q < 8; ++q) { const unsigned w = pg8::pk_fp8x4(col[(4 * q) * PT], col[(4 * q + 1) * PT], col[(4 * q + 2) * PT], col[(4 * q + 3) * PT]);
        if ((q & 3) == 0) o[q >> 2].x = w; else if ((q & 3) == 1) o[q >> 2].y = w; else if ((q & 3) == 2) o[q >> 2].z = w; else o[q >> 2].w = w; }
    GAS v4u* dst = (GAS v4u*)(WT + (size_t)(n0 + n) * K + k0 + 32 * kh);
    dst[0] = o[0]; dst[1] = o[1];
    LDS_WAIT(); asm volatile("" ::: "memory");
}

__device__ __forceinline__ void p0_prologue(const Frame& F, KArgs A) {
    unsigned char* ws = A->ws;
    LAS float* scr = (LAS float*)(F.lds + RING_OFF + F.wave * 16384);
    const int gw = F.vcu * NWAVES + F.wave, NGW = F.G * NWAVES;
    bf16* Win_t = (bf16*)(ws + WS_WIN); bf16* Wo_t = (bf16*)(ws + WS_WO); bf16* Wl_t = (bf16*)(ws + WS_WL);
    constexpr int I_IN = (D / 64) * (IN_COLS / 32), I_O = (D / 64) * (D / 32);
    constexpr int NITEMS = I_IN + I_O;
    for (int it = gw; it < NITEMS; it += NGW) {
        int r = it;
        if (r < I_IN) { p0_transpose_item(A->w_in, D, IN_COLS, Win_t, scr, r, F.lane); continue; } r -= I_IN;
        p0_transpose_item(A->w_out, D, D, Wo_t, scr, r, F.lane);
    }
    const int gt = F.vcu * (NWAVES * 64) + F.tid, NGT = F.G * NWAVES * 64;
    for (int idx = gt; idx < 1536 * 256; idx += NGT) { const int n = idx >> 8, k = idx & 255; float v = 0.f;
        if (n < 512) { if (k < 64) v = A->rw_w2[k * 512 + n]; }
        else if (n < 1024) { if (k >= 64 && k < 128) v = A->rw_a2[(k - 64) * 512 + (n - 512)]; }
        else { if (k >= 128) v = A->rw_g2[(k - 128) * 512 + (n - 1024)]; }
        Wl_t[idx] = (bf16)f2bf(v); }
    bf16* RWS = (bf16*)(ws + WS_RWS);
    for (int idx = gt; idx < D * NEXP; idx += NGT) { const float w = A->router_w[idx] * A->ffn_norm_w[idx >> 5]; const int k = idx >> 5, e = idx & 31;
        const unsigned h0 = f2bf(w); const float r1 = w - __builtin_bit_cast(float, h0 << 16);
        const unsigned h1 = f2bf(r1); const float r2 = r1 - __builtin_bit_cast(float, h1 << 16); const unsigned h2 = f2bf(r2);
        const int dst = ((k >> 3) * 32 + e) * 8 + (k & 7);
        RWS[dst] = (bf16)h0; RWS[NEXP * D + dst] = (bf16)h1; RWS[2 * NEXP * D + dst] = (bf16)h2; }
    bf16* XN = (bf16*)(ws + WS_XN);
    f32x4 nw[4];
#pragma unroll
    for (int j = 0; j < 4; ++j) nw[j] = *((const f32x4*)A->attn_norm_w + F.lane + 64 * j);
    float* CS = (float*)(ws + WS_CS); const float invf_l = exp2f(-(float)(F.lane & 31) * (13.287712379549449f / 32.0f));
    for (int mt = gw; mt < T; mt += 2 * NGW) {
#pragma unroll
      for (int u_ = 0; u_ < 2; ++u_) { const int m = mt + u_ * NGW;
        {
            const float ang = (float)A->positions[m] * invf_l; double rev = (double)ang * 0.15915494309189535; rev -= floor(rev); const float rf = (float)rev;
            CS[(size_t)m * 64 + F.lane] = F.lane < 32 ? __builtin_amdgcn_cosf(rf) : __builtin_amdgcn_sinf(rf); }
        const GAS f32x4* xr = (const GAS f32x4*)(A->x + (size_t)m * D) + F.lane;
        f32x4 v[4]; float s2 = 0.f;
#pragma unroll
        for (int j = 0; j < 4; ++j) { v[j] = xr[64 * j]; s2 += (v[j].x * v[j].x + v[j].y * v[j].y) + (v[j].z * v[j].z + v[j].w * v[j].w); }
        const float rstd = 1.f / sqrtf(wave_sum(s2) * (1.f / D) + NORM_EPS);
        GAS unsigned long long* o8 = (GAS unsigned long long*)(XN + (size_t)m * D) + F.lane;
#pragma unroll
        for (int j = 0; j < 4; ++j) o8[64 * j] = (unsigned long long)pk2(v[j].x * rstd * nw[j].x, v[j].y * rstd * nw[j].y) | ((unsigned long long)pk2(v[j].z * rstd * nw[j].z, v[j].w * rstd * nw[j].w) << 32);
      }
    }
}

template <bool STOP, bool LOOK = false> __device__ __forceinline__ void moe_weight_queue(const Frame& F, KArgs A, gu32* ctl, unsigned stop_at) {
    unsigned char* ws = A->ws;
    LAS float* scr = (LAS float*)(F.lds + RING_OFF + F.wave * 16384);
    unsigned char* W1_t = ws + WS_W1; unsigned char* W2_t = ws + WS_W2;
    constexpr int I_1E = (D / 64) * (2048 / 32), I_2E = (D / 64) * (D / 32), NITEMS = NEXP * I_1E + NEXP * I_2E, GRAB = 4;
    bool look = LOOK;
    for (;;) {
        if (STOP) { if ((unsigned)__builtin_amdgcn_readfirstlane((int)__hip_atomic_load(ctl + CW_DONE5, __ATOMIC_RELAXED, __HIP_MEMORY_SCOPE_AGENT)) >= stop_at) break; }
        if (look) { if ((unsigned)__builtin_amdgcn_readfirstlane((int)__hip_atomic_load(ctl + CW_WQ, __ATOMIC_RELAXED, __HIP_MEMORY_SCOPE_AGENT)) >= (unsigned)NITEMS) break; }
        unsigned base = 0u; if (F.lane == 0) base = __hip_atomic_fetch_add(ctl + CW_WQ, (unsigned)GRAB, __ATOMIC_RELAXED, __HIP_MEMORY_SCOPE_AGENT);
        base = (unsigned)__builtin_amdgcn_readfirstlane((int)base);
        if (base >= (unsigned)NITEMS) break;
        look = false;
        for (int k = 0; k < GRAB; ++k) { int r = (int)base + k; if (r >= NITEMS) break;
            TrItem ti;
            if (r < NEXP * I_1E) { const int e = r / I_1E; tr_load(ti, A->mlp1_w + (size_t)e * D * 2048, 2048, r % I_1E, F.lane); tr_store8(ti, D, 2048, W1_t + (size_t)e * 2048 * D, scr, r % I_1E, F.lane, pg8::MOE_WSCALE); }
            else { r -= NEXP * I_1E; const int e = r / I_2E; tr_load(ti, A->mlp2_w + (size_t)e * D * D, D, r % I_2E, F.lane); tr_store8(ti, D, D, W2_t + (size_t)e * D * D, scr, r % I_2E, F.lane, pg8::MOE_WSCALE); } }
    }
}

__device__ __forceinline__ void moe_weight_queue_cu(const Frame& F, KArgs A, gu32* ctl) {
    unsigned char* ws = A->ws;
    LAS float* scr = (LAS float*)(F.lds + RING_OFF + F.wave * 16384);
    unsigned char* W1_t = ws + WS_W1; unsigned char* W2_t = ws + WS_W2;
    constexpr int I_1E = (D / 64) * (2048 / 32), I_2E = (D / 64) * (D / 32), NITEMS = NEXP * I_1E + NEXP * I_2E, GRAB = 4;
    volatile LAS unsigned* slot = (volatile LAS unsigned*)(F.lds + MISC_OFF) + 17;
    for (;;) {
        if (F.tid == 0) slot[0] = __hip_atomic_fetch_add(ctl + CW_WQ, (unsigned)(NWAVES * GRAB), __ATOMIC_RELAXED, __HIP_MEMORY_SCOPE_AGENT);
        __syncthreads();
        const unsigned cb = (unsigned)__builtin_amdgcn_readfirstlane((int)slot[0]);
        __syncthreads();
        if (cb >= (unsigned)NITEMS) break;
        const unsigned base = cb + (unsigned)(F.wave * GRAB);
        for (int k = 0; k < GRAB; ++k) { int r = (int)base + k; if (r >= NITEMS) break;
            TrItem ti;
            if (r < NEXP * I_1E) { const int e = r / I_1E; tr_load(ti, A->mlp1_w + (size_t)e * D * 2048, 2048, r % I_1E, F.lane); tr_store8(ti, D, 2048, W1_t + (size_t)e * 2048 * D, scr, r % I_1E, F.lane, pg8::MOE_WSCALE); }
            else { r -= NEXP * I_1E; const int e = r / I_2E; tr_load(ti, A->mlp2_w + (size_t)e * D * D, D, r % I_2E, F.lane); tr_store8(ti, D, D, W2_t + (size_t)e * D * D, scr, r % I_2E, F.lane, pg8::MOE_WSCALE); } }
    }
}

__device__ __forceinline__ void moe_weight_queue_scan(const Frame& F, KArgs A, gu32* ctl, int stop_word, unsigned stop_at) {
    unsigned char* ws = A->ws;
    LAS float* scr = (LAS float*)(F.lds + RING_OFF + F.wave * 16384);
    unsigned char* W1_t = ws + WS_W1; unsigned char* W2_t = ws + WS_W2;
    constexpr int I_1E = (D / 64) * (2048 / 32), I_2E = (D / 64) * (D / 32), NITEMS = NEXP * I_1E + NEXP * I_2E, GRAB = 4;
    static_assert(I_1E % GRAB == 0 && I_2E % GRAB == 0, "a grab stays inside one expert matrix");
    for (;;) {
        if ((unsigned)__builtin_amdgcn_readfirstlane((int)__hip_atomic_load(ctl + stop_word, __ATOMIC_RELAXED, __HIP_MEMORY_SCOPE_AGENT)) >= stop_at) break;
        unsigned base = 0u; if (F.lane == 0) base = __hip_atomic_fetch_add(ctl + CW_WQ, (unsigned)GRAB, __ATOMIC_RELAXED, __HIP_MEMORY_SCOPE_AGENT);
        base = (unsigned)__builtin_amdgcn_readfirstlane((int)base);
        if (base >= (unsigned)NITEMS) break;
        const int r0 = (int)base; const bool first = r0 < NEXP * I_1E; const int rr = first ? r0 : r0 - NEXP * I_1E, ipe = first ? I_1E : I_2E, e = rr / ipe, it0 = rr % ipe, Nn = first ? 2048 : D;
        const float* Wsrc = first ? A->mlp1_w + (size_t)e * D * 2048 : A->mlp2_w + (size_t)e * D * D; unsigned char* Wdst = first ? W1_t + (size_t)e * 2048 * D : W2_t + (size_t)e * D * D;
#pragma unroll 1
        for (int k = 0; k < GRAB; k += 2) { TrItem ta, tb; tr_load(ta, Wsrc, Nn, it0 + k, F.lane); tr_load(tb, Wsrc, Nn, it0 + k + 1, F.lane);
            tr_store8(ta, D, Nn, Wdst, scr, it0 + k, F.lane, pg8::MOE_WSCALE); tr_store8(tb, D, Nn, Wdst, scr, it0 + k + 1, F.lane, pg8::MOE_WSCALE); }
    }
}

__device__ __forceinline__ void p2_prep(const Frame& F, KArgs A) {
    unsigned char* ws = A->ws;
    const bf16* PB = (const bf16*)(ws + WS_PB); bf16* LA = (bf16*)(ws + WS_XN);
    const int gw = F.vcu * NWAVES + F.wave, NGW = F.G * NWAVES, lane = F.lane;
    const int c4 = lane * 4; const f32x4 mu = *(const f32x4*)(A->shift_mu + 1536 + c4);
    for (int t0 = 4 * gw; t0 < T; t0 += 4 * NGW) {
        const bf16* pc = PB + (size_t)t0 * IN_COLS + RW_OFF + 1536 + c4;
        u32x2 rw[5];
        rw[0] = *(const u32x2*)(pc - ((t0 & (SEQ - 1)) ? IN_COLS : 0));
#pragma unroll
        for (int q = 0; q < 4; ++q) rw[q + 1] = *(const u32x2*)(pc + (size_t)q * IN_COLS);
        if ((t0 & (SEQ - 1)) == 0) { rw[0].x = 0u; rw[0].y = 0u; }
#pragma unroll
        for (int q = 0; q < 4; ++q) { const u32x2 cu = rw[q + 1], pu = rw[q];
            const float cur[4] = {bflo(cu.x), bfhi(cu.x), bflo(cu.y), bfhi(cu.y)}, prv[4] = {bflo(pu.x), bfhi(pu.x), bflo(pu.y), bfhi(pu.y)};
            f32x4 v, o;
#pragma unroll
            for (int i = 0; i < 4; ++i) v[i] = cur[i] + mu[i] * (prv[i] - cur[i]);
            if (c4 < 64) { for (int i = 0; i < 4; ++i) { const float e2 = __expf(2.0f * v[i]); o[i] = 1.0f - 2.0f * __builtin_amdgcn_rcpf(e2 + 1.0f); } }
            else if (c4 < 128) o = v;
            else { for (int i = 0; i < 4; ++i) o[i] = __builtin_amdgcn_rcpf(1.0f + __expf(-v[i])); }
            u32x2 w; w.x = pk2(o[0], o[1]); w.y = pk2(o[2], o[3]);
            *(u32x2*)(LA + (size_t)(t0 + q) * 256 + c4) = w; }
    }
}

constexpr int FR_KA = 0, FR_RT = 2048, FR_AU = 4096, FR_AY = 5120, FR_AS = 6144, FR_VT = 10240, FR_GC = 12288, FR_BYTES = 12544, NCHUNK = SEQ / 16;
#define SC_MFMA(a, b, c) __builtin_amdgcn_mfma_f32_16x16x32_bf16(__builtin_bit_cast(bf16x8, a), __builtin_bit_cast(bf16x8, b), c, 0, 0, 0)
template <int CTRL> __device__ __forceinline__ float dpp_f(float v) { return __builtin_bit_cast(float, __builtin_amdgcn_update_dpp(0, __builtin_bit_cast(int, v), CTRL, 0xF, 0xF, true)); }
__device__ __forceinline__ f32x4 mm16(const f32x4& XT, const f32x4& Y) {
    f32x4 o = {0.f, 0.f, 0.f, 0.f};
#pragma unroll
    for (int s = 0; s < 4; ++s) o = __builtin_amdgcn_mfma_f32_16x16x4f32(XT[s], Y[s], o, 0, 0, 0);
    return o;
}
__device__ __forceinline__ v4u pack8(const float* x) { v4u o; o.x = cvtpk(x[0], x[1]); o.y = cvtpk(x[2], x[3]); o.z = cvtpk(x[4], x[5]); o.w = cvtpk(x[6], x[7]); return o; }
__device__ __forceinline__ f32x4 shift4(const bf16* pc, bool has_prev, const float* mu) {
    const u32x2 cu = *(const u32x2*)pc; u32x2 pu = *(const u32x2*)(pc - (has_prev ? IN_COLS : 0));
    pu.x = has_prev ? pu.x : 0u; pu.y = has_prev ? pu.y : 0u;
    const f32x4 m = *(const f32x4*)mu;
    const float cur[4] = {bflo(cu.x), bfhi(cu.x), bflo(cu.y), bfhi(cu.y)}, prv[4] = {bflo(pu.x), bfhi(pu.x), bflo(pu.y), bfhi(pu.y)};
    f32x4 v;
#pragma unroll
    for (int i = 0; i < 4; ++i) v[i] = cur[i] + m[i] * (prv[i] - cur[i]);
    return v;
}
struct PrepRaw { v4u lab[8]; u32x2 rc[4], rp[4], kc[4], kp[4], vc[4], vp[4]; };
__device__ __forceinline__ void prep_load_la(PrepRaw& R, const bf16* LA, int ci, int i, int g) {
    const int bh = ci / NCHUNK, chk = ci % NCHUNK, b = bh >> 3;
    const bf16* pla = LA + ((size_t)b * SEQ + chk * 16 + i) * 256 + 8 * g;
#pragma unroll
    for (int sx = 0; sx < 8; ++sx) R.lab[sx] = *(const v4u*)(pla + 32 * sx);
}
__device__ __forceinline__ void prep_load_rkv(PrepRaw& R, const bf16* PB, int ci, int i, int g) {
    const int bh = ci / NCHUNK, chk = ci % NCHUNK, b = bh >> 3, h = bh & 7;
    const size_t t = (size_t)b * SEQ + chk * 16 + i; const bool hp = (chk * 16 + i) > 0;
    const bf16* prow = PB + t * IN_COLS + RW_OFF + h * 64 + 4 * g; const bf16* pprev = prow - (hp ? IN_COLS : 0);
#pragma unroll
    for (int q = 0; q < 4; ++q) {
        R.rc[q] = *(const u32x2*)(prow + 16 * q); R.rp[q] = *(const u32x2*)(pprev + 16 * q);
        R.kc[q] = *(const u32x2*)(prow + 512 + 16 * q); R.kp[q] = *(const u32x2*)(pprev + 512 + 16 * q);
        R.vc[q] = *(const u32x2*)(prow + 1024 + 16 * q); R.vp[q] = *(const u32x2*)(pprev + 1024 + 16 * q); }
}
__device__ __forceinline__ f32x4 shiftr(const u32x2 cu, u32x2 pu, bool hp, const f32x4 m) {
    pu.x = hp ? pu.x : 0u; pu.y = hp ? pu.y : 0u;
    const float cur[4] = {bflo(cu.x), bfhi(cu.x), bflo(cu.y), bfhi(cu.y)}, prv[4] = {bflo(pu.x), bfhi(pu.x), bflo(pu.y), bfhi(pu.y)};
    f32x4 v;
#pragma unroll
    for (int k = 0; k < 4; ++k) v[k] = cur[k] + m[k] * (prv[k] - cur[k]);
    return v;
}
__device__ __forceinline__ void prep_body(PrepRaw& R, int ci, int ci_next, const bf16* LA, const bf16* PB, bf16* LG, const LAS unsigned char* WLF, int lane_in, LAS unsigned short* TB, const LAS float* CST, float* BS, unsigned char* FR) {
    int lane = lane_in; asm volatile("" : "+v"(lane));
    const int i = lane & 15, g = lane >> 4;
    LAS unsigned short* TK = TB + 1024; LAS unsigned short* TV = TB + 2048;
    {
        const int bh = ci / NCHUNK, chk = ci % NCHUNK, b = bh >> 3, h = bh & 7;
        const size_t t0 = (size_t)b * SEQ + chk * 16, t = t0 + i;
        const bool hp = (chk * 16 + i) > 0;
        float nlw[16], av[16], kkv[16], km[16], rr[16], vs[16]; float ss = 0.f, bsum = 0.f;
#pragma unroll
        for (int q = 0; q < 4; ++q) {
            const LAS f32x4* cq = (const LAS f32x4*)(CST + 16 * q + 4 * g);
            const f32x4 r4 = shiftr(R.rc[q], R.rp[q], hp, cq[0]), ks4 = shiftr(R.kc[q], R.kp[q], hp, cq[16]), v4 = shiftr(R.vc[q], R.vp[q], hp, cq[32]);
            const f32x4 w04 = cq[48], a04 = cq[64], kk4 = cq[80], ka4 = cq[96], rk4 = cq[112];
            const LAS v4u* wq = (const LAS v4u*)(WLF + (q * 8) * 1024) + lane; const f32x4 zl = {0.f, 0.f, 0.f, 0.f};
            const f32x4 lw = SC_MFMA(wq[64], R.lab[1], SC_MFMA(wq[0], R.lab[0], zl)), la = SC_MFMA(wq[192], R.lab[3], SC_MFMA(wq[128], R.lab[2], zl));
            const f32x4 gg = SC_MFMA(wq[448], R.lab[7], SC_MFMA(wq[384], R.lab[6], SC_MFMA(wq[320], R.lab[5], SC_MFMA(wq[256], R.lab[4], zl))));
            { u32x2 go; go.x = cvtpk(gg[0], gg[1]); go.y = cvtpk(gg[2], gg[3]); *(u32x2*)(LG + t * RWW + h * 64 + 16 * q + 4 * g) = go; }
#pragma unroll
            for (int j = 0; j < 4; ++j) { const int x = q * 4 + j;
                const float u = fminf(-(w04[j] + lw[j]), 60.f);
                nlw[x] = -0.6065306597126334f * __builtin_amdgcn_rcpf(1.0f + __expf(u));
                av[x] = __builtin_amdgcn_rcpf(1.0f + __expf(-(a04[j] + la[j])));
                kkv[x] = ks4[j] * kk4[j]; ss += kkv[x] * kkv[x];
                km[x] = ks4[j] * (1.0f + (av[x] - 1.0f) * ka4[j]);
                rr[x] = r4[j]; vs[x] = v4[j]; bsum += r4[j] * km[x] * rk4[j]; }
        }
        ss += __shfl_xor(ss, 16); ss += __shfl_xor(ss, 32); bsum += __shfl_xor(bsum, 16); bsum += __shfl_xor(bsum, 32);
        const float rn = fminf(__builtin_amdgcn_rsqf(ss), 1e12f);
        if (g == 0) BS[t * 8 + h] = bsum;
        float Ka[16], Bt[16], Kt[16], Rt[16], gam[16];
#pragma unroll
        for (int x = 0; x < 16; ++x) {
            float c = nlw[x];
            c += dpp_f<0x111>(c); c += dpp_f<0x112>(c); c += dpp_f<0x114>(c); c += dpp_f<0x118>(c);
            const float gm = __expf(c), ig = __builtin_amdgcn_rcpf(gm), kk = kkv[x] * rn; float gm1 = dpp_f<0x111>(gm); gm1 = i == 0 ? 1.0f : gm1;
            gam[x] = gm; Ka[x] = gm1 * kk; Bt[x] = kk * av[x] * ig; Kt[x] = km[x] * ig; Rt[x] = gm * rr[x];
        }
        const v4u pKa0 = pack8(Ka), pKa1 = pack8(Ka + 8), pRt0 = pack8(Rt), pRt1 = pack8(Rt + 8), pBt0 = pack8(Bt), pBt1 = pack8(Bt + 8), pKt0 = pack8(Kt), pKt1 = pack8(Kt + 8);
#pragma unroll
        for (int x = 0; x < 16; ++x) { const int k = 16 * (x >> 2) + 4 * g + (x & 3); const unsigned bk = cvtpk(Bt[x], Kt[x]), vv = cvtpk(vs[x], 0.f);
            TB[k * 16 + i] = (unsigned short)bk; TK[k * 16 + i] = (unsigned short)(bk >> 16); TV[k * 16 + i] = (unsigned short)vv; }
        if (ci_next >= 0) prep_load_rkv(R, PB, ci_next, i, g);
        const f32x4 z4 = {0.f, 0.f, 0.f, 0.f};
        f32x4 N = SC_MFMA(pBt1, pKa1, SC_MFMA(pBt0, pKa0, z4)), NT = SC_MFMA(pKa1, pBt1, SC_MFMA(pKa0, pBt0, z4)), MkT = SC_MFMA(pKa1, pKt1, SC_MFMA(pKa0, pKt0, z4));
        f32x4 Rb = SC_MFMA(pBt1, pRt1, SC_MFMA(pBt0, pRt0, z4)), Rk = SC_MFMA(pKt1, pRt1, SC_MFMA(pKt0, pRt0, z4));
        f32x4 I1, IN2T, IN4T, IN8;
#pragma unroll
        for (int r = 0; r < 4; ++r) { const int row = 4 * g + r; I1[r] = row == i ? 1.f : 0.f;
            N[r] = row < i ? N[r] : 0.f; NT[r] = i < row ? NT[r] : 0.f; MkT[r] = i < row ? MkT[r] : 0.f; Rb[r] = row <= i ? Rb[r] : 0.f; Rk[r] = row <= i ? Rk[r] : 0.f; }
        const f32x4 N2 = mm16(NT, N), N2T = mm16(N, NT), N4 = mm16(N2T, N2), N4T = mm16(N2, N2T), N8 = mm16(N4T, N4);
        IN2T = I1 + N2T; IN4T = I1 + N4T; IN8 = I1 + N8;
        const f32x4 H1 = mm16(IN4T, IN8), H2 = mm16(IN2T, H1); const f32x4 F1T = I1 - NT; const f32x4 Tinv = mm16(F1T, H2), Wm = mm16(MkT, Tinv);
        unsigned char* fb = FR + (size_t)ci * FR_BYTES + lane * 16;
        *(v4u*)(fb + FR_KA) = pKa0; *(v4u*)(fb + FR_KA + 1024) = pKa1;
        *(v4u*)(fb + FR_RT) = pRt0; *(v4u*)(fb + FR_RT + 1024) = pRt1;
        { const float au[8] = {-Tinv[0], -Tinv[1], -Tinv[2], -Tinv[3], -Wm[0], -Wm[1], -Wm[2], -Wm[3]}; *(v4u*)(fb + FR_AU) = pack8(au);
          const float ay[8] = {Rb[0], Rb[1], Rb[2], Rb[3], Rk[0], Rk[1], Rk[2], Rk[3]}; *(v4u*)(fb + FR_AY) = pack8(ay); }
        if (ci_next >= 0) prep_load_la(R, LA, ci_next, i, g);
        LDS_WAIT(); asm volatile("" ::: "memory");
#pragma unroll
        for (int i4 = 0; i4 < 4; ++i4) { const u32x2 bq = *(const LAS u32x2*)(TB + (16 * i4 + i) * 16 + 4 * g), kq = *(const LAS u32x2*)(TK + (16 * i4 + i) * 16 + 4 * g);
            v4u o; o.x = bq.x; o.y = bq.y; o.z = kq.x; o.w = kq.y; *(v4u*)(fb + FR_AS + i4 * 1024) = o;
            const u32x2 vq = *(const LAS u32x2*)(TV + (16 * i4 + i) * 16 + 4 * g);
            *(u32x2*)(FR + (size_t)ci * FR_BYTES + FR_VT + i4 * 512 + lane * 8) = vq; }
        LDS_WAIT(); asm volatile("" ::: "memory");
        if (i == 15) { float* gc = (float*)(FR + (size_t)ci * FR_BYTES + FR_GC) + g * 16;
#pragma unroll
            for (int q = 0; q < 4; ++q) *(f32x4*)(gc + 4 * q) = (f32x4){gam[4 * q], gam[4 * q + 1], gam[4 * q + 2], gam[4 * q + 3]}; }
    }
}
__device__ __forceinline__ void p4_chunk_prep(const Frame& F, KArgs A) {
    unsigned char* ws = A->ws;
    const bf16* LA = (const bf16*)(ws + WS_XN); const bf16* PB = (const bf16*)(ws + WS_PB); bf16* LG = (bf16*)(ws + WS_LG); const bf16* Wl_t = (const bf16*)(ws + WS_WL);
    float* BS = (float*)(ws + WS_BS); unsigned char* FR = ws + WS_FR;
    const int gw = F.vcu * NWAVES + F.wave, lane = F.lane, i = lane & 15, g = lane >> 4;
    LAS unsigned short* TB = (LAS unsigned short*)(F.lds + RING_OFF + F.wave * 8192); LAS float* CST = (LAS float*)(TB + 3072);
    LAS unsigned char* WLF = F.lds + RING_OFF + 65536;
    constexpr int CPW = (BATCH * 8 * NCHUNK) / (256 * NWAVES);
    static_assert(CPW == 8 && NCHUNK % (CPW * NWAVES) == 0, "a workgroup's chunks share one head");
    const int ci0 = gw * CPW;
    { const int h = ((F.vcu * NWAVES * CPW) / NCHUNK) & 7;
#pragma unroll
      for (int k = 0; k < 4; ++k) { const int e = F.tid + 512 * k, q = e >> 9, sx = (e >> 6) & 7, l = e & 63;
          const int n = (sx < 2 ? 0 : sx < 4 ? 512 : 1024) + h * 64 + 16 * q + (l & 15);
          *(LAS v4u*)(WLF + (size_t)e * 16) = *(const v4u*)(Wl_t + (size_t)n * 256 + 32 * sx + 8 * (l >> 4)); }
      const int c = h * 64 + lane;
      CST[lane] = A->shift_mu[c]; CST[64 + lane] = A->shift_mu[512 + c]; CST[128 + lane] = A->shift_mu[1024 + c];
      CST[192 + lane] = A->rw_w0[c]; CST[256 + lane] = A->rw_a0[c]; CST[320 + lane] = A->rw_k_k[c]; CST[384 + lane] = A->rw_k_a[c]; CST[448 + lane] = A->rw_r_k[c];
      __syncthreads(); }
    if (ci0 >= BATCH * 8 * NCHUNK) return;
    PrepRaw ra;
    prep_load_la(ra, LA, ci0, i, g); prep_load_rkv(ra, PB, ci0, i, g);
#pragma unroll 1
    for (int cj = 0; cj < CPW; ++cj) prep_body(ra, ci0 + cj, cj + 1 < CPW ? ci0 + cj + 1 : -1, LA, PB, LG, WLF, lane, TB, CST, BS, FR);
}

__device__ __forceinline__ void scan_phase3(const Frame& F, KArgs A, int bh) {
    constexpr int GRP = 4, NGRP = NCHUNK / GRP, SLOT = 13312, FBUF = GRP * SLOT, YOFF = 2 * FBUF, YBUF = GRP * 16 * 64 * 4;
    static_assert(YOFF + 2 * YBUF <= RING_BYTES, "scan rings fit the LDS ring region");
    LAS unsigned char* L = F.lds + RING_OFF;
    const unsigned char* fr = A->ws + WS_FR + (size_t)bh * NCHUNK * FR_BYTES;
    const int lane = F.lane, b = bh >> 3, h = bh & 7;
    if (F.wave >= 4) {
        const int io = F.wave - 4;
        bf16* yb = (bf16*)(A->ws + WS_YB) + (size_t)b * SEQ * RWW + h * 64;
#define SC_ISSUE(n) do { const unsigned char* src_ = fr + (size_t)(n) * GRP * FR_BYTES + lane * 16; const int bo_ = ((n) & 1) * FBUF; \
        _Pragma("unroll") for (int k_ = 0; k_ < 13; ++k_) { const int p_ = io + 4 * k_, ci_ = p_ / 13, pc_ = p_ % 13; \
            __builtin_amdgcn_global_load_lds((const unsigned*)(src_ + (size_t)ci_ * FR_BYTES + pc_ * 1024), (LAS unsigned*)(L + bo_ + ci_ * SLOT + pc_ * 1024), 16, 0, 0); } } while (0)
#define SC_YOUT(n) do { const LAS float* ys_ = (const LAS float*)(L + YOFF + ((n) & 1) * YBUF); \
        _Pragma("unroll") for (int k_ = 0; k_ < 4; ++k_) { const int i4_ = io * 64 + lane + 256 * k_, ci_ = i4_ >> 8, t_ = (i4_ >> 4) & 15, v4_ = i4_ & 15; \
            const f32x4 y_ = *(const LAS f32x4*)(ys_ + i4_ * 4); u32x2 w_; w_.x = cvtpk(y_[0], y_[1]); w_.y = cvtpk(y_[2], y_[3]); *(u32x2*)(yb + ((size_t)((n) * GRP + ci_) * 16 + t_) * RWW + v4_ * 4) = w_; } } while (0)
        SC_ISSUE(0);
        __syncthreads();
        for (int n = 0; n < NGRP; ++n) {
            if (n + 1 < NGRP) SC_ISSUE(n + 1);
            if (n > 0) SC_YOUT(n - 1);
            __syncthreads();
        }
        SC_YOUT(NGRP - 1);
#undef SC_ISSUE
#undef SC_YOUT
    } else {
        const int wv = F.wave, vl = lane & 15, g = lane >> 4;
        f32x4 s0 = {0.f, 0.f, 0.f, 0.f}, s1 = s0, s2 = s0, s3 = s0; const f32x4 zero = {0.f, 0.f, 0.f, 0.f};
        __syncthreads();
        for (int n = 0; n < NGRP; ++n) {
            const LAS unsigned char* fbuf = L + (n & 1) * FBUF; LAS float* ybuf = (LAS float*)(L + YOFF + (n & 1) * YBUF) + (4 * g) * 64 + 16 * wv + vl;
#pragma unroll
            for (int ci = 0; ci < GRP; ++ci) {
                const LAS unsigned char* p = fbuf + ci * SLOT; const LAS unsigned char* q = p + lane * 16;
                const v4u ka0 = *(const LAS v4u*)(q + FR_KA), ka1 = *(const LAS v4u*)(q + FR_KA + 1024), rt0 = *(const LAS v4u*)(q + FR_RT), rt1 = *(const LAS v4u*)(q + FR_RT + 1024);
                const v4u au = *(const LAS v4u*)(q + FR_AU), ay = *(const LAS v4u*)(q + FR_AY);
                const v4u as0 = *(const LAS v4u*)(q + FR_AS), as1 = *(const LAS v4u*)(q + FR_AS + 1024), as2 = *(const LAS v4u*)(q + FR_AS + 2048), as3 = *(const LAS v4u*)(q + FR_AS + 3072);
                const LAS f32x4* gc = (const LAS f32x4*)(p + FR_GC) + g * 4; const f32x4 gc0 = gc[0], gc1 = gc[1], gc2 = gc[2], gc3 = gc[3];
                const u32x2 vt = *(const LAS u32x2*)(p + FR_VT + wv * 512 + lane * 8);
                v4u bS0, bS1; bS0.x = cvtpk(s0[0], s0[1]); bS0.y = cvtpk(s0[2], s0[3]); bS0.z = cvtpk(s1[0], s1[1]); bS0.w = cvtpk(s1[2], s1[3]);
                bS1.x = cvtpk(s2[0], s2[1]); bS1.y = cvtpk(s2[2], s2[3]); bS1.z = cvtpk(s3[0], s3[1]); bS1.w = cvtpk(s3[2], s3[3]);
                f32x4 PT = SC_MFMA(ka0, bS0, zero); PT = SC_MFMA(ka1, bS1, PT);
                f32x4 YT = SC_MFMA(rt0, bS0, zero); YT = SC_MFMA(rt1, bS1, YT);
                v4u bU; bU.x = cvtpk(PT[0], PT[1]); bU.y = cvtpk(PT[2], PT[3]); bU.z = vt.x; bU.w = vt.y;
                const f32x4 UT = SC_MFMA(au, bU, zero);
                bU.x = cvtpk(UT[0], UT[1]); bU.y = cvtpk(UT[2], UT[3]);
                YT = SC_MFMA(ay, bU, YT);
                s0 = SC_MFMA(as0, bU, s0) * gc0; s1 = SC_MFMA(as1, bU, s1) * gc1; s2 = SC_MFMA(as2, bU, s2) * gc2; s3 = SC_MFMA(as3, bU, s3) * gc3;
                LAS float* yo = ybuf + ci * 1024;
                yo[0] = YT[0]; yo[64] = YT[1]; yo[128] = YT[2]; yo[192] = YT[3];
            }
            __syncthreads();
        }
    }
    __syncthreads();
}

__device__ __forceinline__ void attn_queue(const Frame& F, KArgs A, gu32* ctl) {
    const attn_body::bf16* PB = (const attn_body::bf16*)(A->ws + WS_PB); attn_body::bf16* OA = (attn_body::bf16*)(A->ws + WS_XN);
    char* shm = (char*)(F.lds + RING_OFF);
    volatile LAS unsigned* slot = (volatile LAS unsigned*)(F.lds + MISC_OFF) + 16;
    const int x = (int)(blockIdx.x & 7);
    for (;;) {
        if (F.tid == 0) slot[0] = __hip_atomic_fetch_add(ctl + CW_AQ + 64 * x, 1u, __ATOMIC_RELAXED, __HIP_MEMORY_SCOPE_AGENT);
        __syncthreads();
        const int u = __builtin_amdgcn_readfirstlane((int)slot[0]);
        __syncthreads();
        if (u >= 128) break;
        int cb = x + 8 * (u & 3); asm volatile("" : "+s"(cb));
        const int qb = 31 - (u >> 2), b = cb >> 3, h = (cb >> 1) & 3, c = cb & 1;
        const attn_body::bf16* Q = PB + h * 128 + c * 64; const attn_body::bf16* K = PB + 512 + h * 128 + c * 64; const attn_body::bf16* V = PB + 1024 + h * 128;
        attn_body::attn_unit128<8>(b, qb, Q, K, V, OA + h * 256 + c * 128, shm);
    }
}

__device__ __forceinline__ void p6_combine(const Frame& F, KArgs A) {
    unsigned char* ws = A->ws;
    const bf16* OA = (const bf16*)(ws + WS_XN); const bf16* YB = (const bf16*)(ws + WS_YB); const bf16* LG = (const bf16*)(ws + WS_LG);
    const bf16* PB = (const bf16*)(ws + WS_PB); const float* BS = (const float*)(ws + WS_BS);
    bf16* AO = (bf16*)(ws + WS_AO);
    const int gw = F.vcu * NWAVES + F.wave, NGW = F.G * NWAVES, lane = F.lane;
    const float lam = __expf(wave_sum(A->lq1[lane] * A->lk1[lane])) - __expf(wave_sum(A->lq2[lane] * A->lk2[lane])) + LAM_INIT;
    const int hd = lane >> 4, dv = (lane & 15) * 8, c8 = lane * 8, hr = lane >> 3;
    float sw[8], lw[8], lb[8];
#pragma unroll
    for (int i = 0; i < 8; ++i) { sw[i] = A->subln_w[dv + i] * (1.0f - LAM_INIT); lw[i] = A->rw_lnx_w[c8 + i]; lb[i] = A->rw_lnx_b[c8 + i]; }
    static_assert((T / (256 * NWAVES)) % 2 == 0, "two tokens per trip");
    for (int tt = gw; tt < T; tt += 2 * NGW) {
#pragma unroll
      for (int u_ = 0; u_ < 2; ++u_) { const int t = tt + u_ * NGW;
        const v4u p0 = *(const v4u*)(OA + (size_t)t * 1024 + hd * 256 + dv), p1 = *(const v4u*)(OA + (size_t)t * 1024 + hd * 256 + 128 + dv);
        const float o0[8] = {bflo(p0.x), bfhi(p0.x), bflo(p0.y), bfhi(p0.y), bflo(p0.z), bfhi(p0.z), bflo(p0.w), bfhi(p0.w)};
        const float o1[8] = {bflo(p1.x), bfhi(p1.x), bflo(p1.y), bfhi(p1.y), bflo(p1.z), bfhi(p1.z), bflo(p1.w), bfhi(p1.w)};
        float d[8]; float ss = 0.f;
#pragma unroll
        for (int i = 0; i < 8; ++i) { d[i] = o0[i] - lam * o1[i]; ss += d[i] * d[i]; }
        ss += __shfl_xor(ss, 1); ss += __shfl_xor(ss, 2); ss += __shfl_xor(ss, 4); ss += __shfl_xor(ss, 8);
        const float rs = 1.0f / sqrtf(ss * (1.0f / 128.0f) + NORM_EPS);
        v4u w; w.x = pk2(d[0] * rs * sw[0], d[1] * rs * sw[1]); w.y = pk2(d[2] * rs * sw[2], d[3] * rs * sw[3]); w.z = pk2(d[4] * rs * sw[4], d[5] * rs * sw[5]); w.w = pk2(d[6] * rs * sw[6], d[7] * rs * sw[7]);
        *(v4u*)(AO + (size_t)t * 1024 + hd * 128 + dv) = w;
        const size_t o = (size_t)t * RWW + c8;
        const v4u yp = *(const v4u*)(YB + o); const f32x4 y0 = {bflo(yp.x), bfhi(yp.x), bflo(yp.y), bfhi(yp.y)}, y1 = {bflo(yp.z), bfhi(yp.z), bflo(yp.w), bfhi(yp.w)};
        const bf16* pv = PB + (size_t)t * IN_COLS + RW_OFF + 1024 + c8; const bool hp = (t & (SEQ - 1)) > 0;
        const f32x4 v0 = shift4(pv, hp, A->shift_mu + 1024 + c8), v1 = shift4(pv + 4, hp, A->shift_mu + 1024 + c8 + 4);
        const v4u gp = *(const v4u*)(LG + o);
        const float g[8] = {bflo(gp.x), bfhi(gp.x), bflo(gp.y), bfhi(gp.y), bflo(gp.z), bfhi(gp.z), bflo(gp.w), bfhi(gp.w)};
        const float y[8] = {y0[0], y0[1], y0[2], y0[3], y1[0], y1[1], y1[2], y1[3]}, vv[8] = {v0[0], v0[1], v0[2], v0[3], v1[0], v1[1], v1[2], v1[3]};
        float sm = 0.f;
#pragma unroll
        for (int i = 0; i < 8; ++i) sm += y[i];
        sm += __shfl_xor(sm, 1); sm += __shfl_xor(sm, 2); sm += __shfl_xor(sm, 4);
        const float mean = sm * (1.0f / 64.0f); float sq = 0.f;
#pragma unroll
        for (int i = 0; i < 8; ++i) { const float dd = y[i] - mean; sq += dd * dd; }
        sq += __shfl_xor(sq, 1); sq += __shfl_xor(sq, 2); sq += __shfl_xor(sq, 4);
        const float rg = 1.0f / sqrtf(sq * (1.0f / 64.0f) + GN_EPS), bsc = BS[(size_t)t * 8 + hr];
        float r[8];
#pragma unroll
        for (int i = 0; i < 8; ++i) r[i] = ((y[i] - mean) * rg * lw[i] + lb[i] + bsc * vv[i]) * g[i];
        w.x = pk2(r[0], r[1]); w.y = pk2(r[2], r[3]); w.z = pk2(r[4], r[5]); w.w = pk2(r[6], r[7]);
        *(v4u*)(AO + (size_t)t * 1024 + 512 + c8) = w;
      }
    }
}

__device__ __forceinline__ void p8_router(const Frame& F, KArgs A, gu32* ctl) {
    unsigned char* ws = A->ws;
    const bf16* X1 = (const bf16*)(ws + WS_X1); const bf16* RWS = (const bf16*)(ws + WS_RWS); unsigned char* H2 = ws + WS_H2;
    int* TOPI = (int*)(ws + WS_TOPI); int* POS = (int*)(ws + WS_POS); int* RSRC = (int*)(ws + WS_RSRC); float* RGATE = (float*)(ws + WS_RGATE);
    LAS int* hist = (LAS int*)(F.lds + HIST_OFF); LAS int* hbase = (LAS int*)(F.lds + HBASE_OFF);
    const int lane = F.lane, kh = __builtin_amdgcn_readfirstlane(F.wave >> 2), tile = (F.wave & 3) * F.G + F.vcu;
    const bool has = tile < T / 32;
    const int r0 = tile * 32, hi = lane >> 5, l31 = lane & 31;
    int sel[4] = {0, 0, 0, 0}, lr[4] = {0, 0, 0, 0}; float gate[4] = {0.f, 0.f, 0.f, 0.f}; float rstd = 0.f;
    LAS float* Lw = (LAS float*)(F.lds + RING_OFF + F.wave * 16384 + 8704);
    LAS float* Lp = (LAS float*)(F.lds + RING_OFF + (F.wave ^ 4) * 16384 + 8704);
    if (has) {
        f32x16 acc;
#pragma unroll
        for (int r = 0; r < 16; ++r) acc[r] = 0.f;
        float ssq = 0.f;
        const bf16* xa = X1 + (size_t)(r0 + l31) * D + 512 * kh + 8 * hi; const bf16* wb = RWS + 16384 * kh + (hi * 32 + l31) * 8;
        v4u aA[4], aB[4], bA[4][3], bB[4][3];
#define P8_LOAD(AS, BS, grp) do { _Pragma("unroll") for (int mm = 0; mm < 4; ++mm) { const int m = (grp) * 4 + mm; AS[mm] = *(const v4u*)(xa + 16 * m); \
            _Pragma("unroll") for (int j = 0; j < 3; ++j) BS[mm][j] = *(const v4u*)(wb + (size_t)j * NEXP * D + 512 * m); } } while (0)
#define P8_COMP(AS, BS) do { _Pragma("unroll") for (int mm = 0; mm < 4; ++mm) { const v4u q = AS[mm]; \
            const float a[8] = {bflo(q.x), bfhi(q.x), bflo(q.y), bfhi(q.y), bflo(q.z), bfhi(q.z), bflo(q.w), bfhi(q.w)}; \
            ssq += ((a[0] * a[0] + a[1] * a[1]) + (a[2] * a[2] + a[3] * a[3])) + ((a[4] * a[4] + a[5] * a[5]) + (a[6] * a[6] + a[7] * a[7])); \
            _Pragma("unroll") for (int j = 0; j < 3; ++j) acc = __builtin_amdgcn_mfma_f32_32x32x16_bf16(__builtin_bit_cast(bf16x8, q), __builtin_bit_cast(bf16x8, BS[mm][j]), acc, 0, 0, 0); } } while (0)
        P8_LOAD(aA, bA, 0);
#pragma unroll 1
        for (int gp = 0; gp < 8; gp += 2) {
            P8_LOAD(aB, bB, gp + 1);
            P8_COMP(aA, bA);
            if (gp + 2 < 8) P8_LOAD(aA, bA, gp + 2);
            P8_COMP(aB, bB);
        }
#undef P8_LOAD
#undef P8_COMP
        ssq += __shfl_xor(ssq, 32);
#pragma unroll
        for (int r = 0; r < 16; ++r) Lw[((r & 3) + 8 * (r >> 2) + 4 * hi) * 36 + l31] = acc[r];
        if (lane < 32) Lw[32 * 36 + lane] = ssq;
    }
    __syncthreads();
    if (has && kh == 0) {
        if (lane < 32) {
            rstd = 1.0f / sqrtf((Lw[32 * 36 + lane] + Lp[32 * 36 + lane]) * (1.0f / D) + NORM_EPS);
            Lw[33 * 36 + lane] = rstd;
            float val[32];
#pragma unroll
            for (int j = 0; j < 8; ++j) { const f32x4 q = *(const LAS f32x4*)(Lw + lane * 36 + 4 * j) + *(const LAS f32x4*)(Lp + lane * 36 + 4 * j); const f32x4 bb = *(const f32x4*)(A->router_b + 4 * j);
                val[4 * j] = q[0] * rstd + bb[0]; val[4 * j + 1] = q[1] * rstd + bb[1]; val[4 * j + 2] = q[2] * rstd + bb[2]; val[4 * j + 3] = q[3] * rstd + bb[3]; }
            unsigned used = 0u; float sv[4];
#pragma unroll
            for (int s = 0; s < 4; ++s) { float best = -INFINITY; int bi = 0;
#pragma unroll
                for (int e = 0; e < 32; ++e) { const bool ok = (((used >> e) & 1u) == 0u) && (val[e] > best); best = ok ? val[e] : best; bi = ok ? e : bi; }
                used |= 1u << bi; sel[s] = bi; sv[s] = best; }
            float ex[4], se = 0.f;
#pragma unroll
            for (int s = 0; s < 4; ++s) { ex[s] = __expf(sv[s] - sv[0]); se += ex[s]; }
            const float inv = 1.0f / se;
#pragma unroll
            for (int s = 0; s < 4; ++s) { gate[s] = ex[s] * inv; lr[s] = __hip_atomic_fetch_add(hist + sel[s], 1, __ATOMIC_RELAXED, __HIP_MEMORY_SCOPE_WORKGROUP); }
        }
    }
    __syncthreads();
    if (F.tid < NEXP) hbase[F.tid] = (int)__hip_atomic_fetch_add(ctl + CW_CNT + F.tid, (unsigned)hist[F.tid], __ATOMIC_RELAXED, __HIP_MEMORY_SCOPE_AGENT);
    __syncthreads();
    if (has) {
        if (kh == 0 && lane < 32) { const size_t t4 = (size_t)(r0 + lane) * 4;
#pragma unroll
            for (int s = 0; s < 4; ++s) { const int pos = hbase[sel[s]] + lr[s]; TOPI[t4 + s] = sel[s]; POS[t4 + s] = pos;
                RSRC[(size_t)sel[s] * T + pos] = r0 + lane; RGATE[(size_t)sel[s] * T + pos] = gate[s]; } }
        if (kh != 0) rstd = Lp[33 * 36 + l31];
        f32x4 nw[4];
#pragma unroll
        for (int j = 0; j < 4; ++j) nw[j] = *((const f32x4*)A->ffn_norm_w + lane + 64 * j);
        for (int r4 = 16 * kh; r4 < 16 * kh + 16; r4 += 4) {
            f32x4 v[4][4];
#pragma unroll
            for (int q = 0; q < 4; ++q) { const u32x2* xr = (const u32x2*)(X1 + (size_t)(r0 + r4 + q) * D) + lane;
#pragma unroll
                for (int j = 0; j < 4; ++j) { const u32x2 p = xr[64 * j]; v[q][j] = (f32x4){bflo(p.x), bfhi(p.x), bflo(p.y), bfhi(p.y)}; } }
#pragma unroll
            for (int q = 0; q < 4; ++q) {
                const float rs = __builtin_bit_cast(float, __builtin_amdgcn_readlane(__builtin_bit_cast(int, rstd), r4 + q));
                unsigned* o4 = (unsigned*)(H2 + (size_t)(r0 + r4 + q) * D) + lane;
#pragma unroll
                for (int j = 0; j < 4; ++j) o4[64 * j] = pg8::pk_fp8x4(v[q][j][0] * rs * nw[j][0], v[q][j][1] * rs * nw[j][1], v[q][j][2] * rs * nw[j][2], v[q][j][3] * rs * nw[j][3]);
            }
        }
    }
}

__device__ __forceinline__ void moe_tables(const Frame& F, gu32* ctl) {
    LAS int* pst = (LAS int*)(F.lds + PST_OFF); LAS int* te = (LAS int*)(F.lds + TILE_OFF);
    __syncthreads();
    if (F.tid < 64) {
        const int e = F.tid & 31; const int c = (int)__hip_atomic_load(ctl + CW_CNT + e, __ATOMIC_RELAXED, __HIP_MEMORY_SCOPE_AGENT); const int pc = ((c + 255) >> 8) << 8;
        int inc = pc;
#pragma unroll
        for (int d = 1; d < 32; d <<= 1) { const int o = __shfl_up(inc, d, 32); if (e >= d) inc += o; }
        if (F.tid < 32) { pst[e] = inc - pc; if (e == 31) { pst[32] = inc; pst[33] = inc >> 8; } } }
    __syncthreads();
    if (F.tid < NEXP) { for (int tl = pst[F.tid] >> 8; tl < (pst[F.tid + 1] >> 8); ++tl) te[tl] = F.tid; }
    __syncthreads();
}


__device__ __forceinline__ void p12_final(const Frame& F, KArgs A) {
    unsigned char* ws = A->ws;
    const bf16* X1 = (const bf16*)(ws + WS_X1); const unsigned char* YS = ws + WS_YS;
    const int* TOPI = (const int*)(ws + WS_TOPI); const int* POS = (const int*)(ws + WS_POS); const LAS int* pst = (const LAS int*)(F.lds + PST_OFF);
    const int gw = F.vcu * NWAVES + F.wave, NGW = F.G * NWAVES, lane = F.lane;
    f32x4 nw[4];
#pragma unroll
    for (int j = 0; j < 4; ++j) nw[j] = *((const f32x4*)A->final_norm_w + lane + 64 * j);
    for (int tt = gw; tt < T; tt += 2 * NGW) {
#pragma unroll
      for (int u_ = 0; u_ < 2; ++u_) { const int t = tt + u_ * NGW;
        f32x4 v[4]; float ss = 0.f;
#pragma unroll
        for (int j = 0; j < 4; ++j) { const u32x2 p = *((const u32x2*)(X1 + (size_t)t * D) + lane + 64 * j); v[j] = (f32x4){bflo(p.x), bfhi(p.x), bflo(p.y), bfhi(p.y)}; }
#pragma unroll
        for (int s = 0; s < 4; ++s) { const unsigned* yr = (const unsigned*)(YS + (size_t)(pst[TOPI[t * 4 + s]] + POS[t * 4 + s]) * D) + lane;
#pragma unroll
            for (int j = 0; j < 4; ++j) { const unsigned p = yr[64 * j]; const attn_body::f32x2_t lo = __builtin_amdgcn_cvt_pk_f32_fp8((int)p, false), hi = __builtin_amdgcn_cvt_pk_f32_fp8((int)p, true);
                v[j][0] += lo[0] * pg8::MOE_YSCALE_INV; v[j][1] += lo[1] * pg8::MOE_YSCALE_INV; v[j][2] += hi[0] * pg8::MOE_YSCALE_INV; v[j][3] += hi[1] * pg8::MOE_YSCALE_INV; } }
#pragma unroll
        for (int j = 0; j < 4; ++j) ss += (v[j][0] * v[j][0] + v[j][1] * v[j][1]) + (v[j][2] * v[j][2] + v[j][3] * v[j][3]);
        const float rs = 1.0f / sqrtf(wave_sum(ss) * (1.0f / D) + NORM_EPS);
#pragma unroll
        for (int j = 0; j < 4; ++j) *((f32x4*)(A->out + (size_t)t * D) + lane + 64 * j) = v[j] * rs * nw[j];
      }
    }
}
#ifndef MK_N_LAUNCHES
#define MK_N_LAUNCHES 1
#endif
constexpr int N_PHASES = 13;
__global__ void __launch_bounds__(NWAVES * 64, 2) mk_fwd(Args A_by_value_unused) {
    extern __shared__ __attribute__((aligned(16))) unsigned char lds[];
    Frame F;
    F.lds = (LAS unsigned char*)lds;
    volatile LAS unsigned* MISC = (volatile LAS unsigned*)(F.lds + MISC_OFF);
    F.tid = threadIdx.x; F.lane = F.tid & 63; F.wave = __builtin_amdgcn_readfirstlane(F.tid >> 6);
    F.G = gridDim.x; { const int bx = blockIdx.x; F.vcu = (F.G % 8 == 0) ? (bx % 8) * (F.G / 8) + bx / 8 : bx; }
    unsigned char* ws = get_args()->ws;
    gu32* ctl = (gu32*)(ws + WS_CTL);
    for (int u = F.tid; u < (LDS_BYTES - LDSCTL_OFF) / 4; u += NWAVES * 64) ((LAS unsigned*)(F.lds + LDSCTL_OFF))[u] = 0u;
    __syncthreads();
    XcdBarrier bar = xcd_barrier_post((unsigned*)(ctl + CW_BAR), MISC + 8);
    const int lo = get_args()->ph_lo, hi = get_args()->ph_hi;
#if defined(PROBE_A)
#ifndef PROBE_SCALE
#define PROBE_SCALE 0.25f
#endif
    unsigned long long* tsw = (unsigned long long*)(ws + WS_CTL + 65536);
    int n_stamp = 0;
#define STAMP() do { if (blockIdx.x == 0 && F.tid == 0) tsw[n_stamp] = rt(); ++n_stamp; } while (0)
#else
#define STAMP() do { } while (0)
#endif
    STAMP();
#define IN(k) (lo <= (k) && (k) < hi)
#define SEAM(k) do { if (IN(k) && IN((k) + 1)) xcd_barrier(bar); STAMP(); } while (0)
    bf16* XN = (bf16*)(ws + WS_XN); bf16* PB = (bf16*)(ws + WS_PB);

    if (IN(0)) { p0_prologue(fresh(F), get_args()); SEAM(0); }
    if (IN(1)) {
        pg8::Gemm g{XN, (const bf16*)(ws + WS_WIN), T, IN_COLS, D}; pg8::StaticOrder S; S.init(T, IN_COLS, F.G, (int)blockIdx.x);
        pg8::EpiInProj E{PB, IN_COLS, (const float*)(ws + WS_CS), attn_body::C2};
        pg8::gemm_phase<pg8::EpiInProj, pg8::StaticOrder, PG8_ALIGN, PG8_SP2>(F.lds + RING_OFF, g, S, E);
        { constexpr int NU = (T / 256) * (IN_COLS / 256), FULL = NU / 256, REM = NU % 256;
          if (REM != 0 && F.G == 256) { if ((int)blockIdx.x < REM) { if (F.tid == 0) __hip_atomic_fetch_add(ctl + CW_DONE5, 1u, __ATOMIC_RELAXED, __HIP_MEMORY_SCOPE_AGENT); }
                                        else { __syncthreads(); moe_weight_queue_scan(fresh(F), get_args(), ctl, CW_DONE5, (unsigned)(REM - 8)); } } (void)FULL; }
        SEAM(1);
    }
    if (IN(2)) { p2_prep(fresh(F), get_args()); SEAM(2); }
    if (IN(4)) { p4_chunk_prep(fresh(F), get_args()); SEAM(4); }
    if (IN(5)) {
        constexpr int NS = BATCH * 8;
        if ((F.vcu & 7) == 0 && (F.vcu >> 3) < NS) { scan_phase3(fresh(F), get_args(), F.vcu >> 3); moe_weight_queue_scan(fresh(F), get_args(), ctl, CW_AQ + 64 * (int)(blockIdx.x & 7), 128u); }
        attn_queue(fresh(F), get_args(), ctl);
        moe_weight_queue_cu(fresh(F), get_args(), ctl);
        SEAM(5);
    }
    if (IN(6)) { p6_combine(fresh(F), get_args()); SEAM(6); }
    if (IN(7)) {
        pg8::Gemm g{(const bf16*)(ws + WS_AO), (const bf16*)(ws + WS_WO), T, D, D}; pg8::StaticOrder S; S.init(T, D, F.G, (int)blockIdx.x);
        pg8::EpiResBf16 E{get_args()->x, (bf16*)(ws + WS_X1), D};
        pg8::gemm_phase<pg8::EpiResBf16, pg8::StaticOrder, PG8_ALIGN, PG8_SP2>(F.lds + RING_OFF, g, S, E);
        SEAM(7);
    }
    if (IN(8)) { p8_router(fresh(F), get_args(), ctl); moe_weight_queue<false, true>(fresh(F), get_args(), ctl, 0u); SEAM(8); }
    if (IN(10)) {
        moe_tables(fresh(F), ctl);
        const LAS int* pst = (const LAS int*)(F.lds + PST_OFF);
        pg8::Gemm g{(const bf16*)(ws + WS_H2), (const bf16*)(ws + WS_W1), P_MAX, NEXP * 2048, D, (const int*)(ws + WS_RSRC)};
        pg8::MoeOrder<8> S{pst[33], (int)blockIdx.x, F.G, (const LAS int*)(F.lds + TILE_OFF), pst, T};
        pg8::EpiSwiglu E{ws + WS_ACT, get_args()->mlp1_b};
        pg8::gemm_phase<pg8::EpiSwiglu, pg8::MoeOrder<8>, PG8_ALIGN, PG8_SP2, true, true>(F.lds + RING_OFF, g, S, E);
        SEAM(10);
    }
    if (IN(11)) {
        if (!IN(10)) moe_tables(fresh(F), ctl);
        const LAS int* pst = (const LAS int*)(F.lds + PST_OFF);
        pg8::Gemm g{(const bf16*)(ws + WS_ACT), (const bf16*)(ws + WS_W2), P_MAX, NEXP * D, D};
        pg8::MoeOrder<4> S{pst[33], (int)blockIdx.x, F.G, (const LAS int*)(F.lds + TILE_OFF), pst, T};
        pg8::EpiMoeOut E{ws + WS_YS, get_args()->mlp2_b, (const float*)(ws + WS_RGATE)};
        pg8::gemm_phase<pg8::EpiMoeOut, pg8::MoeOrder<4>, PG8_ALIGN, PG8_SP2, false, true>(F.lds + RING_OFF, g, S, E);
        SEAM(11);
    }
    if (IN(12)) { if (!IN(10) && !IN(11)) moe_tables(fresh(F), ctl); p12_final(fresh(F), get_args()); }
#if defined(PROBE_A)
    xcd_barrier(bar); STAMP();
    if (blockIdx.x == 0 && F.tid == 0) { asm volatile("s_waitcnt vmcnt(0)" ::: "memory"); const float us = (float)(tsw[PROBE_B] - tsw[PROBE_A]) * 0.01f; get_args()->out[12345] = us * PROBE_SCALE; }
#endif
#undef IN
#undef SEAM
}

extern "C" void kernel_launch(void* const* d_in, const int* in_sizes, int n_in, void* d_out, int out_size, void* d_ws, size_t ws_size, hipStream_t stream) {
    static int grid = 0;
    if (grid == 0) {
        if (n_in != 29 || in_sizes[0] != T * D || out_size != T * D || ws_size < WS_END) { fprintf(stderr, "kernel_launch: built for 29 inputs, x/out of %d floats, >= %zu bytes of workspace; got n_in %d, in0 %d, out %d, ws %zu; nothing launched\n", T * D, (size_t)WS_END, n_in, n_in > 0 ? in_sizes[0] : -1, out_size, ws_size); grid = -1; return; }
        int dev = 0, cus = 0, per_cu = 0;
        if (hipGetDevice(&dev) != hipSuccess || hipDeviceGetAttribute(&cus, hipDeviceAttributeMultiprocessorCount, dev) != hipSuccess) { fprintf(stderr, "kernel_launch: device query failed\n"); grid = -1; return; }
        if (hipFuncSetAttribute((const void*)mk_fwd, hipFuncAttributeMaxDynamicSharedMemorySize, LDS_BYTES) != hipSuccess) { fprintf(stderr, "kernel_launch: hipFuncSetAttribute failed\n"); grid = -1; return; }
        if (hipOccupancyMaxActiveBlocksPerMultiprocessor(&per_cu, (const void*)mk_fwd, NWAVES * 64, LDS_BYTES) != hipSuccess || per_cu < 1)
            fprintf(stderr, "kernel_launch: note: occupancy query reports %d workgroups per CU\n", per_cu);
        (void)hipGetLastError();
        grid = cus;
        if (grid != 256) { fprintf(stderr, "kernel_launch: %d CUs; this kernel is built for 256; nothing launched\n", grid); grid = -1; return; }
    }
    if (grid < 0) return;
    if (hipMemsetAsync((char*)d_ws + WS_CTL, 0, CTL_ZERO_BYTES, stream) != hipSuccess) { fprintf(stderr, "kernel_launch: hipMemsetAsync failed\n"); return; }
    Args a{};
    a.x = (const float*)d_in[0]; a.positions = (const int*)d_in[1]; a.attn_norm_w = (const float*)d_in[2]; a.w_in = (const float*)d_in[3]; a.shift_mu = (const float*)d_in[4];
    a.lq1 = (const float*)d_in[5]; a.lk1 = (const float*)d_in[6]; a.lq2 = (const float*)d_in[7]; a.lk2 = (const float*)d_in[8]; a.subln_w = (const float*)d_in[9];
    a.rw_w0 = (const float*)d_in[10]; a.rw_w2 = (const float*)d_in[11]; a.rw_a0 = (const float*)d_in[12]; a.rw_a2 = (const float*)d_in[13]; a.rw_g2 = (const float*)d_in[14];
    a.rw_k_k = (const float*)d_in[15]; a.rw_k_a = (const float*)d_in[16]; a.rw_r_k = (const float*)d_in[17]; a.rw_lnx_w = (const float*)d_in[18]; a.rw_lnx_b = (const float*)d_in[19];
    a.w_out = (const float*)d_in[20]; a.ffn_norm_w = (const float*)d_in[21]; a.router_w = (const float*)d_in[22]; a.router_b = (const float*)d_in[23];
    a.mlp1_w = (const float*)d_in[24]; a.mlp1_b = (const float*)d_in[25]; a.mlp2_w = (const float*)d_in[26]; a.mlp2_b = (const float*)d_in[27]; a.final_norm_w = (const float*)d_in[28];
    a.out = (float*)d_out; a.ws = (unsigned char*)d_ws;
    if (MK_N_LAUNCHES == 1) { a.ph_lo = 0; a.ph_hi = N_PHASES; hipLaunchKernelGGL(mk_fwd, dim3(grid), dim3(NWAVES * 64), LDS_BYTES, stream, a); }
    else for (int p = 0; p < N_PHASES; ++p) { a.ph_lo = p; a.ph_hi = p + 1; hipLaunchKernelGGL(mk_fwd, dim3(grid), dim3(NWAVES * 64), LDS_BYTES, stream, a); }
    const hipError_t le = hipPeekAtLastError();
    if (le != hipSuccess) fprintf(stderr, "kernel_launch: launch failed: %s\n", hipGetErrorName(le));
}
```
